# Optimizing an MI355X kernel written in HIP

```python
import math
import jax, jax.numpy as jnp
from jax import lax
import numpy as np

D_MODEL = 1024
BATCH = 8
SEQ = 2048
DEPTH = 2

GRID_W = 64
NA_HEADS = 8
NA_HEAD_DIM = 64
NA_WIN_ROWS = 8
NA_WIN_COLS = 16
NA_QCOL_BLOCK = NA_WIN_COLS
NA_KCOL_BLOCK = 2 * NA_WIN_COLS
SW_HEADS = 8
SW_KV_HEADS = 2
SW_HEAD_DIM = 64
SW_WINDOW = 128
SW_BLOCK = 128
REL_BUCKETS = 32
REL_MAX_DIST = 128
D_FF = 2816
N_BRANCHES = 2
EPS = 1e-6
NEG = -1e30

NA_WIDTH = NA_HEADS * NA_HEAD_DIM
SW_Q_WIDTH = SW_HEADS * SW_HEAD_DIM
SW_KV_WIDTH = SW_KV_HEADS * SW_HEAD_DIM
IN_WIDTH = 3 * NA_WIDTH + SW_Q_WIDTH + 2 * SW_KV_WIDTH + N_BRANCHES * D_MODEL

kernel_name = "hybrid_natten_swa_macaron_encoder"


def rms_norm(x, g):
    xf = x.astype(jnp.float32)
    y = xf * lax.rsqrt(jnp.mean(xf * xf, axis=-1, keepdims=True) + EPS)
    return (y * g.astype(jnp.float32)).astype(x.dtype)


def swiglu(x, w_gate, w_up, w_down):
    return (jax.nn.silu(x @ w_gate) * (x @ w_up)) @ w_down


def t5_bucket(rel):
    nb = REL_BUCKETS // 2
    max_exact = nb // 2
    n = np.abs(rel)
    large = max_exact + (np.log(np.maximum(n, 1) / max_exact)
                         / np.log(REL_MAX_DIST / max_exact) * (nb - max_exact)).astype(np.int32)
    large = np.minimum(large, nb - 1)
    return ((rel > 0) * nb + np.where(n < max_exact, n, large)).astype(np.int32)


def neighbourhood_attention(q, k, v, rpb):
    B, S, H, dh = q.shape
    rows = S // GRID_W
    kr = min(NA_WIN_ROWS, rows)
    ncb = GRID_W // NA_QCOL_BLOCK
    r = np.arange(rows)
    row_start = np.clip(r - kr // 2, 0, rows - kr)
    key_rows = row_start[:, None] + np.arange(kr)
    cb = np.arange(ncb)
    kcol_start = np.clip(cb * NA_QCOL_BLOCK - NA_WIN_COLS // 2, 0, GRID_W - NA_KCOL_BLOCK)
    key_cols = kcol_start[:, None] + np.arange(NA_KCOL_BLOCK)
    key_idx = (key_rows[:, None, :, None] * GRID_W + key_cols[None, :, None, :])
    key_idx = key_idx.reshape(rows, ncb, kr * NA_KCOL_BLOCK)
    kg = k[:, key_idx]
    vg = v[:, key_idx]
    qb = q.reshape(B, rows, ncb, NA_QCOL_BLOCK, H, dh)
    s = jnp.einsum('brcqhd,brckhd->bhrcqk', qb, kg).astype(jnp.float32) / math.sqrt(dh)
    q_cols = cb[:, None] * NA_QCOL_BLOCK + np.arange(NA_QCOL_BLOCK)
    q_col_start = np.clip(q_cols - NA_WIN_COLS // 2, 0, GRID_W - NA_WIN_COLS)
    kc = key_cols[:, None, :]
    col_ok = (kc >= q_col_start[..., None]) & (kc < q_col_start[..., None] + NA_WIN_COLS)
    row_idx = key_rows - r[:, None] + NA_WIN_ROWS - 1
    col_idx = np.clip(kc - q_cols[..., None] + NA_WIN_COLS - 1, 0, 2 * NA_WIN_COLS - 2)
    bias = rpb[:, row_idx[:, None, None, :, None], col_idx[None, :, :, None, :]]
    bias = bias.reshape(H, rows, ncb, NA_QCOL_BLOCK, kr * NA_KCOL_BLOCK)
    mask = np.broadcast_to(col_ok[None, :, :, None, :],
                           (rows, ncb, NA_QCOL_BLOCK, kr, NA_KCOL_BLOCK))
    mask = mask.reshape(rows, ncb, NA_QCOL_BLOCK, kr * NA_KCOL_BLOCK)
    s = jnp.where(mask, s + bias.astype(jnp.float32), NEG)
    p = jax.nn.softmax(s, axis=-1)
    o = jnp.einsum('bhrcqk,brckhd->brcqhd', p.astype(v.dtype), vg)
    return o.reshape(B, S, H * dh)


def sliding_window_gqa(q, k, v, rel_bias, sink):
    B, S, _, dh = q.shape
    nb = S // SW_BLOCK
    rep = SW_HEADS // SW_KV_HEADS
    qb = q.reshape(B, nb, SW_BLOCK, SW_KV_HEADS, rep, dh)
    pad = ((0, 0), (SW_BLOCK, SW_BLOCK), (0, 0), (0, 0))
    kp = jnp.pad(k, pad).reshape(B, nb + 2, SW_BLOCK, SW_KV_HEADS, dh)
    vp = jnp.pad(v, pad).reshape(B, nb + 2, SW_BLOCK, SW_KV_HEADS, dh)
    kb = jnp.concatenate([kp[:, :-2], kp[:, 1:-1], kp[:, 2:]], axis=2)
    vb = jnp.concatenate([vp[:, :-2], vp[:, 1:-1], vp[:, 2:]], axis=2)
    s = jnp.einsum('bnqgrd,bnkgd->bgrnqk', qb, kb).astype(jnp.float32) / math.sqrt(dh)
    a = np.arange(SW_BLOCK)[:, None]
    j = np.arange(3 * SW_BLOCK)[None, :]
    rel = j - SW_BLOCK - a
    kpos = (np.arange(nb)[:, None, None] - 1) * SW_BLOCK + j[None]
    mask = (np.abs(rel)[None] <= SW_WINDOW) & (kpos >= 0) & (kpos < S)
    bias = rel_bias.astype(jnp.float32).reshape(SW_KV_HEADS, rep, 1, SW_BLOCK, 3 * SW_BLOCK)
    s = jnp.where(mask, s + bias, NEG)
    sink_b = sink.astype(jnp.float32).reshape(SW_KV_HEADS, rep, 1, 1, 1)
    m = jnp.maximum(s.max(axis=-1, keepdims=True), sink_b)
    e = jnp.exp(s - m)
    p = e / (e.sum(axis=-1, keepdims=True) + jnp.exp(sink_b - m))
    o = jnp.einsum('bgrnqk,bnkgd->bnqgrd', p.astype(v.dtype), vb)
    return o.reshape(B, S, SW_HEADS * dh)


def setup_inputs(seed: int = 0) -> dict:
    key = jax.random.key(seed)
    ks = jax.random.split(key, 24)
    L, D, F = DEPTH, D_MODEL, D_FF
    nrm = lambda k, shape, fan: jax.random.normal(k, shape, jnp.float32) * fan ** -0.5
    gain = lambda k, shape: 1.0 + 0.05 * jax.random.normal(k, shape, jnp.float32)
    return {
        "x": jax.random.normal(ks[0], (BATCH, SEQ, D), jnp.float32),
        "ffn1_norm": gain(ks[1], (L, D)),
        "ffn1_w_gate": nrm(ks[2], (L, D, F), D),
        "ffn1_w_up": nrm(ks[3], (L, D, F), D),
        "ffn1_w_down": nrm(ks[4], (L, F, D), F),
        "mix_norm": gain(ks[5], (L, D)),
        "w_in": nrm(ks[6], (L, D, IN_WIDTH), D),
        "b_gate": 0.01 * jax.random.normal(ks[7], (L, N_BRANCHES * D), jnp.float32),
        "na_q_norm": gain(ks[8], (L, NA_HEAD_DIM)),
        "na_k_norm": gain(ks[9], (L, NA_HEAD_DIM)),
        "na_rpb": 0.1 * jax.random.normal(ks[10], (L, NA_HEADS, 2 * NA_WIN_ROWS - 1, 2 * NA_WIN_COLS - 1), jnp.float32),
        "sw_q_norm": gain(ks[11], (L, SW_HEAD_DIM)),
        "sw_k_norm": gain(ks[12], (L, SW_HEAD_DIM)),
        "sw_sink": 0.5 * jax.random.normal(ks[13], (L, SW_HEADS), jnp.float32),
        "t5_rel_table": 0.1 * jax.random.normal(ks[14], (REL_BUCKETS, SW_HEADS), jnp.float32),
        "w_branch_na": nrm(ks[15], (L, NA_WIDTH, D), NA_WIDTH),
        "w_branch_sw": nrm(ks[16], (L, SW_Q_WIDTH, D), SW_Q_WIDTH),
        "w_out": nrm(ks[17], (L, D, D), D),
        "ffn2_norm": gain(ks[18], (L, D)),
        "ffn2_w_gate": nrm(ks[19], (L, D, F), D),
        "ffn2_w_up": nrm(ks[20], (L, D, F), D),
        "ffn2_w_down": nrm(ks[21], (L, F, D), F),
    }


def reference(x, ffn1_norm, ffn1_w_gate, ffn1_w_up, ffn1_w_down, mix_norm, w_in, b_gate,
              na_q_norm, na_k_norm, na_rpb, sw_q_norm, sw_k_norm, sw_sink, t5_rel_table,
              w_branch_na, w_branch_sw, w_out, ffn2_norm, ffn2_w_gate, ffn2_w_up, ffn2_w_down):
    B, S, D = x.shape
    rel = np.arange(3 * SW_BLOCK)[None, :] - SW_BLOCK - np.arange(SW_BLOCK)[:, None]
    t5_bias = jnp.transpose(t5_rel_table[t5_bucket(rel)], (2, 0, 1))
    splits = np.cumsum([NA_WIDTH, NA_WIDTH, NA_WIDTH, SW_Q_WIDTH, SW_KV_WIDTH, SW_KV_WIDTH])
    for l in range(DEPTH):
        x = x + 0.5 * swiglu(rms_norm(x, ffn1_norm[l]), ffn1_w_gate[l], ffn1_w_up[l], ffn1_w_down[l])
        h = rms_norm(x, mix_norm[l])
        z = h @ w_in[l]
        qa, ka, va, qs, ks_, vs, zg = jnp.split(z, splits, axis=-1)
        qa = rms_norm(qa.reshape(B, S, NA_HEADS, NA_HEAD_DIM), na_q_norm[l])
        ka = rms_norm(ka.reshape(B, S, NA_HEADS, NA_HEAD_DIM), na_k_norm[l])
        va = va.reshape(B, S, NA_HEADS, NA_HEAD_DIM)
        o_na = neighbourhood_attention(qa, ka, va, na_rpb[l])
        qs = rms_norm(qs.reshape(B, S, SW_HEADS, SW_HEAD_DIM), sw_q_norm[l])
        ks_ = rms_norm(ks_.reshape(B, S, SW_KV_HEADS, SW_HEAD_DIM), sw_k_norm[l])
        vs = vs.reshape(B, S, SW_KV_HEADS, SW_HEAD_DIM)
        o_sw = sliding_window_gqa(qs, ks_, vs, t5_bias, sw_sink[l])
        g = jax.nn.sigmoid((zg + b_gate[l]).astype(jnp.float32)).astype(x.dtype)
        g = g.reshape(B, S, N_BRANCHES, D)
        merged = g[:, :, 0] * (o_na @ w_branch_na[l]) + g[:, :, 1] * (o_sw @ w_branch_sw[l])
        x = x + merged @ w_out[l]
        x = x + 0.5 * swiglu(rms_norm(x, ffn2_norm[l]), ffn2_w_gate[l], ffn2_w_up[l], ffn2_w_down[l])
    return x
```

```cpp
#include <hip/hip_runtime.h>
#include <cstdio>
#include <cstdint>

constexpr int BATCH = 8, SEQ = 2048, DM = 1024, DEPTH = 2, FF = 2816;
constexpr int M = BATCH * SEQ;
constexpr int GRID_W = 64, ROWS = SEQ / GRID_W;
constexpr int NQKV = 2304, NG = 2048, INW = NQKV + NG;
constexpr float EPS = 1e-6f;
constexpr float NEGV = -1e30f;

typedef unsigned short bf16;

constexpr size_t MiB = 1u << 20;
constexpr size_t WS_CTL = 0;
constexpr size_t WS_SS = 512 * 1024;
constexpr size_t CTL_ZERO_BYTES = 1 * MiB;
constexpr size_t WS_W = 1 * MiB;
constexpr size_t WS_XB = 47 * MiB;
constexpr size_t WS_H = 79 * MiB;
constexpr size_t WS_QKV = 79 * MiB;
constexpr size_t WS_T = 79 * MiB;
constexpr size_t WS_MRG = 111 * MiB;
constexpr size_t WS_G = 151 * MiB;
constexpr size_t WS_ONA = 215 * MiB;
constexpr size_t WS_OSW = 231 * MiB;
constexpr size_t WS_END = 247 * MiB;

__device__ __forceinline__ unsigned f2bf(float f) { unsigned u = __builtin_bit_cast(unsigned, f); return (u + 0x7fffu + ((u >> 16) & 1u)) >> 16; }
__device__ __forceinline__ float bf2f(unsigned b) { return __builtin_bit_cast(float, b << 16); }
__device__ __forceinline__ float bfr(float f) { return bf2f(f2bf(f)); }

struct Inputs {
    const float *x, *ffn1_norm, *ffn1_wg, *ffn1_wu, *ffn1_wd, *mix_norm, *w_in, *b_gate, *na_q_norm, *na_k_norm, *na_rpb, *sw_q_norm, *sw_k_norm, *sw_sink, *t5,
                *w_br_na, *w_br_sw, *w_out, *ffn2_norm, *ffn2_wg, *ffn2_wu, *ffn2_wd;
};

namespace slow {
template <class Op> __global__ void __launch_bounds__(256) gemm(Op op) {
    constexpr int NS = Op::NSEL;
    __shared__ float As[NS][16][68];
    __shared__ float Bs[NS][16][68];
    __shared__ float Cs[NS][64][65];
    const int tid = threadIdx.x, tx = tid & 15, ty = tid >> 4;
    const int m0 = blockIdx.y * 64, n0 = blockIdx.x * 64;
    float acc[NS][4][4];
#pragma unroll
    for (int s = 0; s < NS; ++s)
#pragma unroll
        for (int i = 0; i < 4; ++i)
#pragma unroll
            for (int j = 0; j < 4; ++j) acc[s][i][j] = 0.f;
    for (int k0 = 0; k0 < op.K; k0 += 16) {
#pragma unroll
        for (int s = 0; s < NS; ++s) {
#pragma unroll
            for (int e = 0; e < 4; ++e) {
                const int idx = tid + e * 256;
                { const int kk = idx & 15, mm = idx >> 4; As[s][kk][mm] = op.a(s, m0 + mm, k0 + kk); }
                { const int nn = idx & 63, kk = idx >> 6; Bs[s][kk][nn] = op.b(s, k0 + kk, n0 + nn); }
            }
        }
        __syncthreads();
#pragma unroll
        for (int kk = 0; kk < 16; ++kk) {
#pragma unroll
            for (int s = 0; s < NS; ++s) {
                float av[4], bv[4];
#pragma unroll
                for (int i = 0; i < 4; ++i) { av[i] = As[s][kk][ty * 4 + i]; bv[i] = Bs[s][kk][tx * 4 + i]; }
#pragma unroll
                for (int i = 0; i < 4; ++i)
#pragma unroll
                    for (int j = 0; j < 4; ++j) acc[s][i][j] += av[i] * bv[j];
            }
        }
        __syncthreads();
    }
#pragma unroll
    for (int s = 0; s < NS; ++s)
#pragma unroll
        for (int i = 0; i < 4; ++i)
#pragma unroll
            for (int j = 0; j < 4; ++j) Cs[s][ty * 4 + i][tx * 4 + j] = acc[s][i][j];
    __syncthreads();
    op.epi(m0, n0, Cs, tid);
}

struct OpFfnUp {
    static constexpr int NSEL = 2; int K, pad_;
    const bf16* xb; const float *wg, *wu, *gn, *ss; bf16* H;
    __device__ float a(int, int m, int k) const { return bf2f(xb[(size_t)m * DM + k]); }
    __device__ float b(int s, int k, int n) const { return bfr(gn[k] * (s ? wu : wg)[(size_t)k * FF + n]); }
    __device__ void epi(int m0, int n0, float (*Cs)[64][65], int tid) const {
        for (int e = tid; e < 4096; e += 256) { const int i = e >> 6, j = e & 63, m = m0 + i;
            const float r = rsqrtf(ss[m] * (1.f / DM) + EPS), zg = r * Cs[0][i][j], zu = r * Cs[1][i][j];
            const float h = zg / (1.f + __expf(-zg)) * zu;
            H[(size_t)m * FF + n0 + j] = (bf16)f2bf(h); }
    }
};
struct OpResid {
    static constexpr int NSEL = 1; int K; float alpha;
    const bf16* A; const float* w; const float* base; float* out; bf16* xb; float* ss;
    __device__ float a(int, int m, int k) const { return bf2f(A[(size_t)m * K + k]); }
    __device__ float b(int, int k, int n) const { return bfr(w[(size_t)k * DM + n]); }
    __device__ void epi(int m0, int n0, float (*Cs)[64][65], int tid) const {
        for (int e = tid; e < 4096; e += 256) { const int i = e >> 6, j = e & 63; const size_t o = (size_t)(m0 + i) * DM + n0 + j;
            const float v = base[o] + alpha * Cs[0][i][j]; out[o] = v; Cs[0][i][j] = v; if (xb) xb[o] = (bf16)f2bf(v); }
        __syncthreads();
        if (ss && tid < 64) { float s = 0.f; for (int j = 0; j < 64; ++j) s += Cs[0][tid][j] * Cs[0][tid][j]; atomicAdd(ss + m0 + tid, s); }
    }
};
struct OpWin {
    static constexpr int NSEL = 1; int K, pad_;
    const bf16* xb; const float *w, *gn, *ss, *bg, *naq, *nak, *swq, *swk; bf16 *QKV, *G;
    __device__ float a(int, int m, int k) const { return bf2f(xb[(size_t)m * DM + k]); }
    __device__ float b(int, int k, int n) const { return bfr(gn[k] * w[(size_t)k * INW + n]); }
    __device__ void epi(int m0, int n0, float (*Cs)[64][65], int tid) const {
        __shared__ float hn[64];
        const int hg = n0 >> 6;
        const float* gain = hg < 8 ? naq : hg < 16 ? nak : (hg >= 24 && hg < 32) ? swq : (hg >= 32 && hg < 34) ? swk : nullptr;
        const float qs = (hg < 8 || (hg >= 24 && hg < 32)) ? 0.125f : 1.f;
        for (int e = tid; e < 4096; e += 256) { const int i = e >> 6, j = e & 63; Cs[0][i][j] *= rsqrtf(ss[m0 + i] * (1.f / DM) + EPS); }
        __syncthreads();
        if (tid < 64) { float s = 0.f; for (int j = 0; j < 64; ++j) s += Cs[0][tid][j] * Cs[0][tid][j]; hn[tid] = rsqrtf(s * (1.f / 64.f) + EPS); }
        __syncthreads();
        for (int e = tid; e < 4096; e += 256) { const int i = e >> 6, j = e & 63, m = m0 + i; float z = Cs[0][i][j];
            if (hg < 36) { if (gain) z = z * hn[i] * gain[j] * qs; QKV[(size_t)m * NQKV + n0 + j] = (bf16)f2bf(z); }
            else { const int c = n0 - NQKV + j; z = 1.f / (1.f + __expf(-(z + bg[c]))); G[(size_t)m * NG + c] = (bf16)f2bf(z); } }
    }
};
struct OpBranch {
    static constexpr int NSEL = 2; int K, pad_;
    const bf16 *ONA, *OSW, *G; const float *pa, *pb; bf16 *T, *MRG;
    __device__ float a(int s, int m, int k) const { return bf2f((s ? OSW : ONA)[(size_t)m * 512 + k]); }
    __device__ float b(int s, int k, int n) const { return bfr((s ? pb : pa)[(size_t)k * DM + n]); }
    __device__ void epi(int m0, int n0, float (*Cs)[64][65], int tid) const {
        for (int e = tid; e < 4096; e += 256) { const int i = e >> 6, j = e & 63, m = m0 + i, n = n0 + j;
            const float gA = bf2f(G[(size_t)m * NG + n]), gB = bf2f(G[(size_t)m * NG + DM + n]);
            const float t = bfr(gA * Cs[0][i][j]); T[(size_t)m * DM + n] = (bf16)f2bf(t);
            MRG[(size_t)m * DM + n] = (bf16)f2bf(t + gB * Cs[1][i][j]); }
    }
};

__global__ void __launch_bounds__(256) prep_x(const float* x, bf16* xb, float* ss) {
    __shared__ float red[256];
    const int m = blockIdx.x, tid = threadIdx.x; float s = 0.f;
    for (int c = tid; c < DM; c += 256) { const float v = x[(size_t)m * DM + c]; xb[(size_t)m * DM + c] = (bf16)f2bf(v); s += v * v; }
    red[tid] = s; __syncthreads();
    for (int o = 128; o > 0; o >>= 1) { if (tid < o) red[tid] += red[tid + o]; __syncthreads(); }
    if (tid == 0) ss[m] = red[0];
}

__device__ __forceinline__ float wave_sum(float v) {
#pragma unroll
    for (int o = 1; o < 64; o <<= 1) v += __shfl_xor(v, o);
    return v;
}
__device__ __forceinline__ float wave_max(float v) {
#pragma unroll
    for (int o = 1; o < 64; o <<= 1) v = fmaxf(v, __shfl_xor(v, o));
    return v;
}
__global__ void __launch_bounds__(256) attn_na(const bf16* QKV, const float* rpb  , bf16* ONA) {
    __shared__ float sc[4][128];
    const int w = threadIdx.x >> 6, lane = threadIdx.x & 63;
    const int item = blockIdx.x * 4 + w;
    const int h = item & 7, tok = item >> 3, b = tok / SEQ, t = tok % SEQ, r = t / GRID_W, c = t % GRID_W;
    int rs = r - 4; rs = rs < 0 ? 0 : (rs > ROWS - 8 ? ROWS - 8 : rs);
    int cs = c - 8; cs = cs < 0 ? 0 : (cs > GRID_W - 16 ? GRID_W - 16 : cs);
    const float q = bf2f(QKV[(size_t)tok * NQKV + h * 64 + lane]);
    for (int j = 0; j < 128; ++j) { const int kr = rs + (j >> 4), kc = cs + (j & 15); const size_t kt = (size_t)b * SEQ + kr * GRID_W + kc;
        float s = wave_sum(q * bf2f(QKV[kt * NQKV + 512 + h * 64 + lane]));
        s += rpb[(h * 15 + (kr - r + 7)) * 31 + (kc - c + 15)];
        if (lane == 0) sc[w][j] = s; }
    __syncthreads();
    const float s0 = sc[w][lane], s1 = sc[w][lane + 64];
    const float mx = wave_max(fmaxf(s0, s1));
    const float e0 = __expf(s0 - mx), e1 = __expf(s1 - mx);
    const float l = wave_sum(e0 + e1);
    __syncthreads();
    sc[w][lane] = bfr(e0); sc[w][lane + 64] = bfr(e1);
    __syncthreads();
    float o = 0.f;
    for (int j = 0; j < 128; ++j) { const int kr = rs + (j >> 4), kc = cs + (j & 15); const size_t kt = (size_t)b * SEQ + kr * GRID_W + kc;
        o += sc[w][j] * bf2f(QKV[kt * NQKV + 1024 + h * 64 + lane]); }
    ONA[(size_t)tok * 512 + h * 64 + lane] = (bf16)f2bf(o / l);
}
__device__ __forceinline__ int t5_bucket(int rel) {
    const int n = rel < 0 ? -rel : rel; int v;
    if (n < 8) v = n; else { int k = 0; while (64 * (2 << k) <= n * n) ++k; v = 8 + k; v = v > 15 ? 15 : v; }
    return (rel > 0 ? 16 : 0) + v;
}
__global__ void __launch_bounds__(256) attn_sw(const bf16* QKV, const float* t5  , const float* sink  , bf16* OSW) {
    __shared__ float sc[4][320];
    const int w = threadIdx.x >> 6, lane = threadIdx.x & 63;
    const int item = blockIdx.x * 4 + w;
    const int h = item & 7, tok = item >> 3, b = tok / SEQ, t = tok % SEQ, g = h >> 2;
    const int k0 = t - 128 < 0 ? 0 : t - 128, k1 = t + 128 > SEQ - 1 ? SEQ - 1 : t + 128, nk = k1 - k0 + 1;
    const float q = bf2f(QKV[(size_t)tok * NQKV + 1536 + h * 64 + lane]);
    for (int j = 0; j < nk; ++j) { const size_t kt = (size_t)b * SEQ + k0 + j;
        float s = wave_sum(q * bf2f(QKV[kt * NQKV + 2048 + g * 64 + lane]));
        s += t5[t5_bucket(k0 + j - t) * 8 + h];
        if (lane == 0) sc[w][j] = s; }
    __syncthreads();
    const float snk = sink[h];
    float mx = snk; for (int j = lane; j < nk; j += 64) mx = fmaxf(mx, sc[w][j]);
    mx = wave_max(mx);
    float l = 0.f; for (int j = lane; j < nk; j += 64) { const float e = __expf(sc[w][j] - mx); l += e; sc[w][j] = bfr(e); }
    l = wave_sum(l) + __expf(snk - mx);
    __syncthreads();
    float o = 0.f;
    for (int j = 0; j < nk; ++j) { const size_t kt = (size_t)b * SEQ + k0 + j; o += sc[w][j] * bf2f(QKV[kt * NQKV + 2176 + g * 64 + lane]); }
    OSW[(size_t)tok * 512 + h * 64 + lane] = (bf16)f2bf(o / l);
}
}

extern "C" void kernel_launch(void* const* d_in, const int* in_sizes, int n_in, void* d_out, int out_size, void* d_ws, size_t ws_size, hipStream_t stream) {
    if (n_in != 22 || in_sizes[0] != M * DM || out_size != M * DM || ws_size < WS_END) { fprintf(stderr, "kernel_launch: unexpected shapes (n_in %d, in0 %d, out %d, ws %zu)\n", n_in, n_in > 0 ? in_sizes[0] : -1, out_size, ws_size); return; }
    Inputs I;
    { const float** p = (const float**)&I; for (int i = 0; i < 22; ++i) p[i] = (const float*)d_in[i]; }
    unsigned char* ws = (unsigned char*)d_ws; float* out = (float*)d_out;
    float* SS = (float*)(ws + WS_SS);
    bf16 *XB = (bf16*)(ws + WS_XB), *H = (bf16*)(ws + WS_H), *QKV = (bf16*)(ws + WS_QKV), *T = (bf16*)(ws + WS_T), *MRG = (bf16*)(ws + WS_MRG), *G = (bf16*)(ws + WS_G),
         *ONA = (bf16*)(ws + WS_ONA), *OSW = (bf16*)(ws + WS_OSW);
    (void)hipMemsetAsync(ws + WS_CTL, 0, CTL_ZERO_BYTES, stream);
    hipLaunchKernelGGL(slow::prep_x, dim3(M), dim3(256), 0, stream, I.x, XB, SS);
    for (int l = 0; l < DEPTH; ++l) {
        const float* base = l == 0 ? I.x : out;
        float* ss0 = SS + (size_t)(3 * l + 0) * M; float* ss1 = SS + (size_t)(3 * l + 1) * M; float* ss2 = SS + (size_t)(3 * l + 2) * M; float* ss3 = SS + (size_t)(3 * l + 3) * M;
        { slow::OpFfnUp op{DM, 0, XB, I.ffn1_wg + (size_t)l * DM * FF, I.ffn1_wu + (size_t)l * DM * FF, I.ffn1_norm + l * DM, ss0, H};
          hipLaunchKernelGGL(slow::gemm<slow::OpFfnUp>, dim3(FF / 64, M / 64), dim3(256), 0, stream, op); }
        { slow::OpResid op{FF, 0.5f, H, I.ffn1_wd + (size_t)l * FF * DM, base, out, XB, ss1};
          hipLaunchKernelGGL(slow::gemm<slow::OpResid>, dim3(DM / 64, M / 64), dim3(256), 0, stream, op); }
        { slow::OpWin op{DM, 0, XB, I.w_in + (size_t)l * DM * INW, I.mix_norm + l * DM, ss1, I.b_gate + l * NG, I.na_q_norm + l * 64, I.na_k_norm + l * 64, I.sw_q_norm + l * 64, I.sw_k_norm + l * 64, QKV, G};
          hipLaunchKernelGGL(slow::gemm<slow::OpWin>, dim3(INW / 64, M / 64), dim3(256), 0, stream, op); }
        hipLaunchKernelGGL(slow::attn_na, dim3(M * 8 / 4), dim3(256), 0, stream, QKV, I.na_rpb + (size_t)l * 8 * 15 * 31, ONA);
        hipLaunchKernelGGL(slow::attn_sw, dim3(M * 8 / 4), dim3(256), 0, stream, QKV, I.t5, I.sw_sink + l * 8, OSW);
        { slow::OpBranch op{512, 0, ONA, OSW, G, I.w_br_na + (size_t)l * 512 * DM, I.w_br_sw + (size_t)l * 512 * DM, T, MRG};
          hipLaunchKernelGGL(slow::gemm<slow::OpBranch>, dim3(DM / 64, M / 64), dim3(256), 0, stream, op); }
        { slow::OpResid op{DM, 1.0f, MRG, I.w_out + (size_t)l * DM * DM, out, out, XB, ss2};
          hipLaunchKernelGGL(slow::gemm<slow::OpResid>, dim3(DM / 64, M / 64), dim3(256), 0, stream, op); }
        { slow::OpFfnUp op{DM, 0, XB, I.ffn2_wg + (size_t)l * DM * FF, I.ffn2_wu + (size_t)l * DM * FF, I.ffn2_norm + l * DM, ss2, H};
          hipLaunchKernelGGL(slow::gemm<slow::OpFfnUp>, dim3(FF / 64, M / 64), dim3(256), 0, stream, op); }
        { const bool last = (l == DEPTH - 1);
          slow::OpResid op{FF, 0.5f, H, I.ffn2_wd + (size_t)l * FF * DM, out, out, last ? nullptr : XB, last ? nullptr : ss3};
          hipLaunchKernelGGL(slow::gemm<slow::OpResid>, dim3(DM / 64, M / 64), dim3(256), 0, stream, op); }
    }
}
```

```cpp
#include <hip/hip_runtime.h>
#include <cstdio>
#include <cstdint>

constexpr int BATCH = 8, SEQ = 2048, DM = 1024, DEPTH = 2, FF = 2816;
constexpr int M = BATCH * SEQ;
constexpr int GRID_W = 64, ROWS = SEQ / GRID_W;
constexpr int NQKV = 2304, NG = 2048, INW = NQKV + NG;
constexpr float EPS = 1e-6f;
constexpr float NEGV = -1e30f;

typedef unsigned short bf16;

constexpr size_t MiB = 1u << 20;
constexpr size_t WS_CTL = 0;
constexpr size_t WS_SS = 512 * 1024;
constexpr size_t CTL_ZERO_BYTES = 1 * MiB;
constexpr size_t WS_W = 1 * MiB;
constexpr size_t WS_XB = 47 * MiB;
constexpr size_t WS_H = 79 * MiB;
constexpr size_t WS_QKV = 79 * MiB;
constexpr size_t WS_T = 79 * MiB;
constexpr size_t WS_MRG = 111 * MiB;
constexpr size_t WS_G = 151 * MiB;
constexpr size_t WS_ONA = 215 * MiB;
constexpr size_t WS_OSW = 231 * MiB;
constexpr size_t WS_END = 247 * MiB;

__device__ __forceinline__ unsigned f2bf(float f) { unsigned u = __builtin_bit_cast(unsigned, f); return (u + 0x7fffu + ((u >> 16) & 1u)) >> 16; }
__device__ __forceinline__ float bf2f(unsigned b) { return __builtin_bit_cast(float, b << 16); }
__device__ __forceinline__ float bfr(float f) { return bf2f(f2bf(f)); }

struct Inputs {
    const float *x, *ffn1_norm, *ffn1_wg, *ffn1_wu, *ffn1_wd, *mix_norm, *w_in, *b_gate, *na_q_norm, *na_k_norm, *na_rpb, *sw_q_norm, *sw_k_norm, *sw_sink, *t5,
                *w_br_na, *w_br_sw, *w_out, *ffn2_norm, *ffn2_wg, *ffn2_wu, *ffn2_wd;
};

namespace slow {
template <class Op> __global__ void __launch_bounds__(256) gemm(Op op) {
    constexpr int NS = Op::NSEL;
    __shared__ float As[NS][16][68];
    __shared__ float Bs[NS][16][68];
    __shared__ float Cs[NS][64][65];
    const int tid = threadIdx.x, tx = tid & 15, ty = tid >> 4;
    const int m0 = blockIdx.y * 64, n0 = blockIdx.x * 64;
    float acc[NS][4][4];
#pragma unroll
    for (int s = 0; s < NS; ++s)
#pragma unroll
        for (int i = 0; i < 4; ++i)
#pragma unroll
            for (int j = 0; j < 4; ++j) acc[s][i][j] = 0.f;
    for (int k0 = 0; k0 < op.K; k0 += 16) {
#pragma unroll
        for (int s = 0; s < NS; ++s) {
#pragma unroll
            for (int e = 0; e < 4; ++e) {
                const int idx = tid + e * 256;
                { const int kk = idx & 15, mm = idx >> 4; As[s][kk][mm] = op.a(s, m0 + mm, k0 + kk); }
                { const int nn = idx & 63, kk = idx >> 6; Bs[s][kk][nn] = op.b(s, k0 + kk, n0 + nn); }
            }
        }
        __syncthreads();
#pragma unroll
        for (int kk = 0; kk < 16; ++kk) {
#pragma unroll
            for (int s = 0; s < NS; ++s) {
                float av[4], bv[4];
#pragma unroll
                for (int i = 0; i < 4; ++i) { av[i] = As[s][kk][ty * 4 + i]; bv[i] = Bs[s][kk][tx * 4 + i]; }
#pragma unroll
                for (int i = 0; i < 4; ++i)
#pragma unroll
                    for (int j = 0; j < 4; ++j) acc[s][i][j] += av[i] * bv[j];
            }
        }
        __syncthreads();
    }
#pragma unroll
    for (int s = 0; s < NS; ++s)
#pragma unroll
        for (int i = 0; i < 4; ++i)
#pragma unroll
            for (int j = 0; j < 4; ++j) Cs[s][ty * 4 + i][tx * 4 + j] = acc[s][i][j];
    __syncthreads();
    op.epi(m0, n0, Cs, tid);
}

struct OpFfnUp {
    static constexpr int NSEL = 2; int K, pad_;
    const bf16* xb; const float *wg, *wu, *gn, *ss; bf16* H;
    __device__ float a(int, int m, int k) const { return bf2f(xb[(size_t)m * DM + k]); }
    __device__ float b(int s, int k, int n) const { return bfr(gn[k] * (s ? wu : wg)[(size_t)k * FF + n]); }
    __device__ void epi(int m0, int n0, float (*Cs)[64][65], int tid) const {
        for (int e = tid; e < 4096; e += 256) { const int i = e >> 6, j = e & 63, m = m0 + i;
            const float r = rsqrtf(ss[m] * (1.f / DM) + EPS), zg = r * Cs[0][i][j], zu = r * Cs[1][i][j];
            const float h = zg / (1.f + __expf(-zg)) * zu;
            H[(size_t)m * FF + n0 + j] = (bf16)f2bf(h); }
    }
};
struct OpResid {
    static constexpr int NSEL = 1; int K; float alpha;
    const bf16* A; const float* w; const float* base; float* out; bf16* xb; float* ss;
    __device__ float a(int, int m, int k) const { return bf2f(A[(size_t)m * K + k]); }
    __device__ float b(int, int k, int n) const { return bfr(w[(size_t)k * DM + n]); }
    __device__ void epi(int m0, int n0, float (*Cs)[64][65], int tid) const {
        for (int e = tid; e < 4096; e += 256) { const int i = e >> 6, j = e & 63; const size_t o = (size_t)(m0 + i) * DM + n0 + j;
            const float v = base[o] + alpha * Cs[0][i][j]; out[o] = v; Cs[0][i][j] = v; if (xb) xb[o] = (bf16)f2bf(v); }
        __syncthreads();
        if (ss && tid < 64) { float s = 0.f; for (int j = 0; j < 64; ++j) s += Cs[0][tid][j] * Cs[0][tid][j]; atomicAdd(ss + m0 + tid, s); }
    }
};
struct OpWin {
    static constexpr int NSEL = 1; int K, pad_;
    const bf16* xb; const float *w, *gn, *ss, *bg, *naq, *nak, *swq, *swk; bf16 *QKV, *G;
    __device__ float a(int, int m, int k) const { return bf2f(xb[(size_t)m * DM + k]); }
    __device__ float b(int, int k, int n) const { return bfr(gn[k] * w[(size_t)k * INW + n]); }
    __device__ void epi(int m0, int n0, float (*Cs)[64][65], int tid) const {
        __shared__ float hn[64];
        const int hg = n0 >> 6;
        const float* gain = hg < 8 ? naq : hg < 16 ? nak : (hg >= 24 && hg < 32) ? swq : (hg >= 32 && hg < 34) ? swk : nullptr;
        const float qs = (hg < 8 || (hg >= 24 && hg < 32)) ? 0.125f : 1.f;
        for (int e = tid; e < 4096; e += 256) { const int i = e >> 6, j = e & 63; Cs[0][i][j] *= rsqrtf(ss[m0 + i] * (1.f / DM) + EPS); }
        __syncthreads();
        if (tid < 64) { float s = 0.f; for (int j = 0; j < 64; ++j) s += Cs[0][tid][j] * Cs[0][tid][j]; hn[tid] = rsqrtf(s * (1.f / 64.f) + EPS); }
        __syncthreads();
        for (int e = tid; e < 4096; e += 256) { const int i = e >> 6, j = e & 63, m = m0 + i; float z = Cs[0][i][j];
            if (hg < 36) { if (gain) z = z * hn[i] * gain[j] * qs; QKV[(size_t)m * NQKV + n0 + j] = (bf16)f2bf(z); }
            else { const int c = n0 - NQKV + j; z = 1.f / (1.f + __expf(-(z + bg[c]))); G[(size_t)m * NG + c] = (bf16)f2bf(z); } }
    }
};
struct OpBranch {
    static constexpr int NSEL = 2; int K, pad_;
    const bf16 *ONA, *OSW, *G; const float *pa, *pb; bf16 *T, *MRG;
    __device__ float a(int s, int m, int k) const { return bf2f((s ? OSW : ONA)[(size_t)m * 512 + k]); }
    __device__ float b(int s, int k, int n) const { return bfr((s ? pb : pa)[(size_t)k * DM + n]); }
    __device__ void epi(int m0, int n0, float (*Cs)[64][65], int tid) const {
        for (int e = tid; e < 4096; e += 256) { const int i = e >> 6, j = e & 63, m = m0 + i, n = n0 + j;
            const float gA = bf2f(G[(size_t)m * NG + n]), gB = bf2f(G[(size_t)m * NG + DM + n]);
            const float t = bfr(gA * Cs[0][i][j]); T[(size_t)m * DM + n] = (bf16)f2bf(t);
            MRG[(size_t)m * DM + n] = (bf16)f2bf(t + gB * Cs[1][i][j]); }
    }
};

__global__ void __launch_bounds__(256) prep_x(const float* x, bf16* xb, float* ss) {
    __shared__ float red[256];
    const int m = blockIdx.x, tid = threadIdx.x; float s = 0.f;
    for (int c = tid; c < DM; c += 256) { const float v = x[(size_t)m * DM + c]; xb[(size_t)m * DM + c] = (bf16)f2bf(v); s += v * v; }
    red[tid] = s; __syncthreads();
    for (int o = 128; o > 0; o >>= 1) { if (tid < o) red[tid] += red[tid + o]; __syncthreads(); }
    if (tid == 0) ss[m] = red[0];
}

__device__ __forceinline__ float wave_sum(float v) {
#pragma unroll
    for (int o = 1; o < 64; o <<= 1) v += __shfl_xor(v, o);
    return v;
}
__device__ __forceinline__ float wave_max(float v) {
#pragma unroll
    for (int o = 1; o < 64; o <<= 1) v = fmaxf(v, __shfl_xor(v, o));
    return v;
}
__global__ void __launch_bounds__(256) attn_na(const bf16* QKV, const float* rpb  , bf16* ONA) {
    __shared__ float sc[4][128];
    const int w = threadIdx.x >> 6, lane = threadIdx.x & 63;
    const int item = blockIdx.x * 4 + w;
    const int h = item & 7, tok = item >> 3, b = tok / SEQ, t = tok % SEQ, r = t / GRID_W, c = t % GRID_W;
    int rs = r - 4; rs = rs < 0 ? 0 : (rs > ROWS - 8 ? ROWS - 8 : rs);
    int cs = c - 8; cs = cs < 0 ? 0 : (cs > GRID_W - 16 ? GRID_W - 16 : cs);
    const float q = bf2f(QKV[(size_t)tok * NQKV + h * 64 + lane]);
    for (int j = 0; j < 128; ++j) { const int kr = rs + (j >> 4), kc = cs + (j & 15); const size_t kt = (size_t)b * SEQ + kr * GRID_W + kc;
        float s = wave_sum(q * bf2f(QKV[kt * NQKV + 512 + h * 64 + lane]));
        s += rpb[(h * 15 + (kr - r + 7)) * 31 + (kc - c + 15)];
        if (lane == 0) sc[w][j] = s; }
    __syncthreads();
    const float s0 = sc[w][lane], s1 = sc[w][lane + 64];
    const float mx = wave_max(fmaxf(s0, s1));
    const float e0 = __expf(s0 - mx), e1 = __expf(s1 - mx);
    const float l = wave_sum(e0 + e1);
    __syncthreads();
    sc[w][lane] = bfr(e0); sc[w][lane + 64] = bfr(e1);
    __syncthreads();
    float o = 0.f;
    for (int j = 0; j < 128; ++j) { const int kr = rs + (j >> 4), kc = cs + (j & 15); const size_t kt = (size_t)b * SEQ + kr * GRID_W + kc;
        o += sc[w][j] * bf2f(QKV[kt * NQKV + 1024 + h * 64 + lane]); }
    ONA[(size_t)tok * 512 + h * 64 + lane] = (bf16)f2bf(o / l);
}
__device__ __forceinline__ int t5_bucket(int rel) {
    const int n = rel < 0 ? -rel : rel; int v;
    if (n < 8) v = n; else { int k = 0; while (64 * (2 << k) <= n * n) ++k; v = 8 + k; v = v > 15 ? 15 : v; }
    return (rel > 0 ? 16 : 0) + v;
}
__global__ void __launch_bounds__(256) attn_sw(const bf16* QKV, const float* t5  , const float* sink  , bf16* OSW) {
    __shared__ float sc[4][320];
    const int w = threadIdx.x >> 6, lane = threadIdx.x & 63;
    const int item = blockIdx.x * 4 + w;
    const int h = item & 7, tok = item >> 3, b = tok / SEQ, t = tok % SEQ, g = h >> 2;
    const int k0 = t - 128 < 0 ? 0 : t - 128, k1 = t + 128 > SEQ - 1 ? SEQ - 1 : t + 128, nk = k1 - k0 + 1;
    const float q = bf2f(QKV[(size_t)tok * NQKV + 1536 + h * 64 + lane]);
    for (int j = 0; j < nk; ++j) { const size_t kt = (size_t)b * SEQ + k0 + j;
        float s = wave_sum(q * bf2f(QKV[kt * NQKV + 2048 + g * 64 + lane]));
        s += t5[t5_bucket(k0 + j - t) * 8 + h];
        if (lane == 0) sc[w][j] = s; }
    __syncthreads();
    const float snk = sink[h];
    float mx = snk; for (int j = lane; j < nk; j += 64) mx = fmaxf(mx, sc[w][j]);
    mx = wave_max(mx);
    float l = 0.f; for (int j = lane; j < nk; j += 64) { const float e = __expf(sc[w][j] - mx); l += e; sc[w][j] = bfr(e); }
    l = wave_sum(l) + __expf(snk - mx);
    __syncthreads();
    float o = 0.f;
    for (int j = 0; j < nk; ++j) { const size_t kt = (size_t)b * SEQ + k0 + j; o += sc[w][j] * bf2f(QKV[kt * NQKV + 2176 + g * 64 + lane]); }
    OSW[(size_t)tok * 512 + h * 64 + lane] = (bf16)f2bf(o / l);
}
}

#define LAS __attribute__((address_space(3)))
#define GAS __attribute__((address_space(1)))
typedef short bf16x8 __attribute__((ext_vector_type(8)));
typedef short s16x4 __attribute__((ext_vector_type(4)));
typedef float f32x4 __attribute__((ext_vector_type(4)));
typedef unsigned u32x4 __attribute__((ext_vector_type(4)));
typedef unsigned u32x2 __attribute__((ext_vector_type(2)));
typedef GAS unsigned gu32;

constexpr int NWAVES = 8, NTHREADS = 512;
constexpr int LDS_BYTES = 147456;
constexpr int RING_BYTES = 131072;
constexpr int MISC_OFF = RING_BYTES + 320;

constexpr size_t WO_1C = 0;
constexpr size_t WO_1D = WO_1C + (size_t)2 * FF * DM * 2;
constexpr size_t WO_IN = WO_1D + (size_t)DM * FF * 2;
constexpr size_t WO_PA = WO_IN + (size_t)INW * DM * 2;
constexpr size_t WO_PB = WO_PA + (size_t)DM * 512 * 2;
constexpr size_t WO_OUT = WO_PB + (size_t)DM * 512 * 2;
constexpr size_t WO_2C = WO_OUT + (size_t)DM * DM * 2;
constexpr size_t WO_2D = WO_2C + (size_t)2 * FF * DM * 2;
constexpr size_t WO_END = WO_2D + (size_t)DM * FF * 2;
static_assert(WS_W + WO_END <= WS_XB, "weight region");

__device__ __forceinline__ unsigned cvt_pk_bf16(float lo, float hi) { unsigned r; asm volatile("v_cvt_pk_bf16_f32 %0, %1, %2" : "=v"(r) : "v"(lo), "v"(hi)); return r; }
__device__ __forceinline__ float fast_sigmoid(float z) { return __builtin_amdgcn_rcpf(1.f + __builtin_amdgcn_exp2f(-1.4426950408889634f * z)); }
__device__ __forceinline__ float rs_row(const float* ss, int row) { return __builtin_amdgcn_rsqf(ss[row] * (1.f / DM) + EPS); }

namespace pg8 {
constexpr int BM = 256, BK = 64, HALF = 128, HTB = HALF * BK * 2, STAGE_BYTES = 8 * HTB, NXCD = 8, WGM = 8;
__host__ __device__ __forceinline__ int lds_byte(int r, int c) { const int st = (r >> 4) * 2 + (c >> 5), rr = r & 15, cc = c & 31, ob = rr * 64 + cc * 2; return st * 1024 + (ob ^ (((ob >> 9) & 1) << 5)); }
__host__ __device__ __forceinline__ void stage_rc(int b, int& R, int& C) { const int st = b / 1024, sb = b % 1024, swz = sb ^ (((sb >> 9) & 1) << 5); R = (st >> 1) * 16 + swz / 64; C = (st & 1) * 32 + (swz % 64) / 2; }
struct Unit { int pm, pn; };
struct Gemm { const bf16* A; const bf16* Bt; int M, N, K; };
struct StaticOrder {
    int nM, nN, nwg, G, c;
    __device__ void init(int M_, int N_, int G_, int c_) { nM = M_ / BM; nN = N_ / BM; nwg = nM * nN; G = G_; c = c_; }
    __device__ bool next(int i, Unit& u) const {
        const long L = (long)i * G + c; if (L >= nwg) return false;
        int wgid = (int)L; { const int q = nwg / NXCD, r = nwg % NXCD, xcd = wgid % NXCD, off = wgid / NXCD; wgid = (xcd < r ? xcd * (q + 1) : r * (q + 1) + (xcd - r) * q) + off; }
        const int nig = WGM * nN, gid = wgid / nig, fm = gid * WGM, gsz = (nM - fm) < WGM ? (nM - fm) : WGM;
        u.pm = fm + ((wgid % nig) % gsz); u.pn = (wgid % nig) / gsz; return true;
    }
};
template <class Epi, bool ALIGN_EPI, bool SP2>
__device__ __forceinline__ void gemm_phase(LAS unsigned char* lds, const Gemm g, const StaticOrder& S, const Epi& E) {
    int tid_ = threadIdx.x; asm volatile("" : "+v"(tid_));
    const int tid = tid_, wid = __builtin_amdgcn_readfirstlane(tid >> 6), lane = tid & 63, wr = wid >> 2, wc = wid & 3, fr = lane & 15, fq = lane >> 4;
    const int K = g.K, nt = K / BK;
    unsigned voff[2];
#pragma unroll
    for (int i = 0; i < 2; ++i) { int R, C; stage_rc(tid * 16 + i * 8192, R, C); voff[i] = (unsigned)(R * K + C) * 2u; }
    const size_t kstep = (size_t)(BK * 2), hstep = (size_t)HALF * K * 2, tstep = 2 * hstep;
    const unsigned ldsw = (unsigned)wid * 1024u;
    const int aoff = lds_byte(wr * 64 + fr, fq * 8), boff = lds_byte(wc * 32 + fr, fq * 8);
#define PG8_SA(b, h) (((b) * 2 + (h)) * HTB)
#define PG8_SB(b, h) ((4 + (b) * 2 + (h)) * HTB)
#define PG8_STAGE(bufoff, gbase) do { _Pragma("unroll") for (int _i = 0; _i < 2; ++_i) \
        __builtin_amdgcn_global_load_lds((const unsigned*)((const char*)(gbase) + voff[_i]), (LAS unsigned*)(lds + (bufoff) + ldsw + _i * 8192), 16, 0, 0); } while (0)
#define PG8_LDA(dst, b, h) do { _Pragma("unroll") for (int m = 0; m < 4; ++m) _Pragma("unroll") for (int k = 0; k < 2; ++k) dst[m][k] = *(const LAS bf16x8*)(lds + PG8_SA(b, h) + aoff + m * 2048 + k * 1024); } while (0)
#define PG8_LDB(dst, b, h) do { _Pragma("unroll") for (int n = 0; n < 2; ++n) _Pragma("unroll") for (int k = 0; k < 2; ++k) dst[n][k] = *(const LAS bf16x8*)(lds + PG8_SB(b, h) + boff + n * 2048 + k * 1024); } while (0)
#define PG8_MMA(ai, bj, At, Bt) do { __builtin_amdgcn_s_setprio(1); _Pragma("unroll") for (int m = 0; m < 4; ++m) _Pragma("unroll") for (int n = 0; n < 2; ++n) _Pragma("unroll") for (int k = 0; k < 2; ++k) \
        acc[ai][bj][m][n] = __builtin_amdgcn_mfma_f32_16x16x32_bf16(Bt[n][k], At[m][k], acc[ai][bj][m][n], 0, 0, 0); __builtin_amdgcn_s_setprio(0); } while (0)
#define PG8_WAIT_V(n) asm volatile("s_waitcnt vmcnt(" #n ")" ::: "memory")
#define PG8_WAIT_L(n) asm volatile("s_waitcnt lgkmcnt(" #n ")" ::: "memory")
#define PG8_BAR __builtin_amdgcn_s_barrier()
#define PG8_SCHED __builtin_amdgcn_sched_barrier(0)
    Unit cur, nxt; int ui = 0;
    if (!S.next(0, cur)) return;
    f32x4 acc[2][2][4][2];
#pragma unroll
    for (int a = 0; a < 2; ++a)
#pragma unroll
        for (int b = 0; b < 2; ++b)
#pragma unroll
            for (int m = 0; m < 4; ++m)
#pragma unroll
                for (int n = 0; n < 2; ++n) acc[a][b][m][n] = (f32x4){0.f, 0.f, 0.f, 0.f};
    bf16x8 At[4][2], B0[2][2], B1[2][2];
    const char* cA = (const char*)g.A + (size_t)cur.pm * tstep; const char* cB = (const char*)g.Bt + (size_t)cur.pn * tstep;
    if constexpr (SP2) {
        PG8_STAGE(PG8_SB(0, 0), cB); PG8_STAGE(PG8_SB(0, 1), cB + hstep); PG8_STAGE(PG8_SA(0, 0), cA); PG8_STAGE(PG8_SA(0, 1), cA + hstep);
        if (wr == 1) PG8_BAR;
        PG8_WAIT_V(2); PG8_BAR;
        PG8_STAGE(PG8_SB(1, 0), cB + kstep); PG8_STAGE(PG8_SA(1, 0), cA + kstep); PG8_STAGE(PG8_SB(1, 1), cB + hstep + kstep);
        PG8_WAIT_V(6); PG8_BAR;
    } else {
        PG8_STAGE(PG8_SB(0, 0), cB); PG8_STAGE(PG8_SA(0, 0), cA); PG8_STAGE(PG8_SB(0, 1), cB + hstep); PG8_STAGE(PG8_SA(0, 1), cA + hstep);
        if (wr == 1) PG8_BAR;
        PG8_WAIT_V(4); PG8_BAR;
        PG8_STAGE(PG8_SB(1, 0), cB + kstep); PG8_STAGE(PG8_SA(1, 0), cA + kstep); PG8_STAGE(PG8_SB(1, 1), cB + hstep + kstep);
        PG8_WAIT_V(6); PG8_BAR;
    }
    for (;;) {
        const bool has_next = S.next(ui + 1, nxt);
        const char* nA = has_next ? (const char*)g.A + (size_t)nxt.pm * tstep : cA; const char* nB = has_next ? (const char*)g.Bt + (size_t)nxt.pn * tstep : cB;
        for (int t = 0; t < nt; t += 2) {
            const bool last = (t == nt - 2);
            const char* a1 = cA + (size_t)(t + 1) * kstep;
            const char* a2 = last ? nA : cA + (size_t)(t + 2) * kstep; const char* b2 = last ? nB : cB + (size_t)(t + 2) * kstep;
            const char* a3 = a2 + kstep; const char* b3 = b2 + kstep;
            if constexpr (SP2) {
            PG8_LDB(B0, 0, 0); PG8_LDB(B1, 0, 1); PG8_SCHED; PG8_LDA(At, 0, 0); PG8_STAGE(PG8_SA(1, 1), a1 + hstep);
            PG8_WAIT_V(8); PG8_WAIT_L(0); PG8_BAR; PG8_MMA(0, 0, At, B0); PG8_MMA(0, 1, At, B1); PG8_BAR; PG8_SCHED;
            PG8_LDA(At, 0, 1); PG8_STAGE(PG8_SB(0, 0), b2); PG8_STAGE(PG8_SB(0, 1), b2 + hstep); PG8_STAGE(PG8_SA(0, 0), a2);
            PG8_WAIT_V(8); PG8_WAIT_L(0); PG8_BAR; PG8_MMA(1, 0, At, B0); PG8_MMA(1, 1, At, B1); PG8_BAR; PG8_SCHED;
            PG8_LDB(B0, 1, 0); PG8_LDB(B1, 1, 1); PG8_SCHED; PG8_LDA(At, 1, 0); PG8_STAGE(PG8_SA(0, 1), a2 + hstep);
            PG8_WAIT_V(8); PG8_WAIT_L(0); PG8_BAR; PG8_MMA(0, 0, At, B0); PG8_MMA(0, 1, At, B1); PG8_BAR; PG8_SCHED;
            PG8_LDA(At, 1, 1); PG8_STAGE(PG8_SB(1, 0), b3); PG8_STAGE(PG8_SB(1, 1), b3 + hstep); PG8_STAGE(PG8_SA(1, 0), a3);
            PG8_WAIT_V(8); PG8_WAIT_L(0); PG8_BAR; PG8_MMA(1, 0, At, B0); PG8_MMA(1, 1, At, B1); PG8_BAR; PG8_SCHED;
            } else {
            PG8_LDB(B0, 0, 0); PG8_SCHED; PG8_LDA(At, 0, 0); PG8_STAGE(PG8_SA(1, 1), a1 + hstep);
            PG8_WAIT_L(8); PG8_BAR; PG8_WAIT_L(0); PG8_MMA(0, 0, At, B0); PG8_BAR; PG8_SCHED;
            PG8_LDB(B1, 0, 1); PG8_STAGE(PG8_SB(0, 0), b2);
            PG8_BAR; PG8_WAIT_L(0); PG8_MMA(0, 1, At, B1); PG8_BAR;
            PG8_LDA(At, 0, 1); PG8_STAGE(PG8_SA(0, 0), a2);
            PG8_BAR; PG8_WAIT_L(0); PG8_MMA(1, 0, At, B0); PG8_BAR; PG8_SCHED;
            PG8_STAGE(PG8_SB(0, 1), b2 + hstep);
            PG8_WAIT_V(6); PG8_BAR; PG8_MMA(1, 1, At, B1); PG8_BAR;
            PG8_LDB(B0, 1, 0); PG8_SCHED; PG8_LDA(At, 1, 0); PG8_STAGE(PG8_SA(0, 1), a2 + hstep);
            PG8_WAIT_L(8); PG8_BAR; PG8_WAIT_L(0); PG8_MMA(0, 0, At, B0); PG8_BAR; PG8_SCHED;
            PG8_LDB(B1, 1, 1); PG8_STAGE(PG8_SB(1, 0), b3);
            PG8_BAR; PG8_WAIT_L(0); PG8_MMA(0, 1, At, B1); PG8_BAR;
            PG8_LDA(At, 1, 1); PG8_STAGE(PG8_SA(1, 0), a3);
            PG8_BAR; PG8_WAIT_L(0); PG8_MMA(1, 0, At, B0); PG8_BAR; PG8_SCHED;
            PG8_STAGE(PG8_SB(1, 1), b3 + hstep);
            PG8_WAIT_V(6); PG8_BAR; PG8_MMA(1, 1, At, B1); PG8_BAR;
            }
        }
        if constexpr (ALIGN_EPI) { if (wr == 0) PG8_BAR; }
        E(acc, cur, wr, wc, fr, fq);
        if (!has_next) break;
#pragma unroll
        for (int a = 0; a < 2; ++a)
#pragma unroll
            for (int b = 0; b < 2; ++b)
#pragma unroll
                for (int m = 0; m < 4; ++m)
#pragma unroll
                    for (int n = 0; n < 2; ++n) acc[a][b][m][n] = (f32x4){0.f, 0.f, 0.f, 0.f};
        cur = nxt; cA = nA; cB = nB; ++ui;
        if constexpr (ALIGN_EPI) { if (wr == 1) PG8_BAR; }
    }
    PG8_WAIT_V(0);
    if constexpr (!ALIGN_EPI) { if (wr == 0) PG8_BAR; }
    PG8_BAR;
#undef PG8_SA
#undef PG8_SB
#undef PG8_STAGE
#undef PG8_LDA
#undef PG8_LDB
#undef PG8_MMA
#undef PG8_WAIT_V
#undef PG8_WAIT_L
#undef PG8_BAR
#undef PG8_SCHED
}

typedef f32x4 Acc[2][2][4][2];
struct EpiFfnUp {
    bf16* H; const float* ss;
    __device__ __forceinline__ void operator()(const Acc& acc, const Unit& u, int wr, int wc, int fr, int fq) const {
        const int row0 = u.pm * BM + wr * 64 + fr, col0 = u.pn * 128 + wc * 32 + 8 * fq;
        float rr[2][4];
#pragma unroll
        for (int ai = 0; ai < 2; ++ai)
#pragma unroll
            for (int m = 0; m < 4; ++m) rr[ai][m] = ss[row0 + ai * HALF + m * 16];
#pragma unroll
        for (int ai = 0; ai < 2; ++ai)
#pragma unroll
            for (int m = 0; m < 4; ++m) { const int row = row0 + ai * HALF + m * 16; const float r = __builtin_amdgcn_rsqf(rr[ai][m] * (1.f / DM) + EPS); float h[8];
#pragma unroll
                for (int n = 0; n < 2; ++n)
#pragma unroll
                    for (int j = 0; j < 4; ++j) { const float zg = r * acc[ai][0][m][n][j], zu = r * acc[ai][1][m][n][j]; h[4 * n + j] = zg * fast_sigmoid(zg) * zu; }
                u32x4 w; w.x = cvt_pk_bf16(h[0], h[1]); w.y = cvt_pk_bf16(h[2], h[3]); w.z = cvt_pk_bf16(h[4], h[5]); w.w = cvt_pk_bf16(h[6], h[7]);
                *(u32x4*)(H + (size_t)row * FF + col0) = w; }
    }
};
struct EpiResid {
    const float* base; float* out; bf16* xb; float* ss; float alpha;
    __device__ __forceinline__ void operator()(const Acc& acc, const Unit& u, int wr, int wc, int fr, int fq) const {
        const int row0 = u.pm * BM + wr * 64 + fr, col0 = u.pn * BM + wc * 64 + 8 * fq;
#pragma unroll
        for (int ai = 0; ai < 2; ++ai) {
            f32x4 bs[4][2][2];
#pragma unroll
            for (int m = 0; m < 4; ++m)
#pragma unroll
                for (int bj = 0; bj < 2; ++bj) { const size_t o = (size_t)(row0 + ai * HALF + m * 16) * DM + col0 + bj * 32; bs[m][bj][0] = *(const f32x4*)(base + o); bs[m][bj][1] = *(const f32x4*)(base + o + 4); }
#pragma unroll
            for (int m = 0; m < 4; ++m) { const int row = row0 + ai * HALF + m * 16; float part = 0.f;
#pragma unroll
                for (int bj = 0; bj < 2; ++bj) { const size_t o = (size_t)row * DM + col0 + bj * 32;
                    const f32x4 v0 = bs[m][bj][0] + alpha * acc[ai][bj][m][0], v1 = bs[m][bj][1] + alpha * acc[ai][bj][m][1];
                    *(f32x4*)(out + o) = v0; *(f32x4*)(out + o + 4) = v1;
                    if (xb) { u32x4 w; w.x = cvt_pk_bf16(v0[0], v0[1]); w.y = cvt_pk_bf16(v0[2], v0[3]); w.z = cvt_pk_bf16(v1[0], v1[1]); w.w = cvt_pk_bf16(v1[2], v1[3]); *(u32x4*)(xb + o) = w; }
                    part += (v0[0] * v0[0] + v0[1] * v0[1]) + (v0[2] * v0[2] + v0[3] * v0[3]) + (v1[0] * v1[0] + v1[1] * v1[1]) + (v1[2] * v1[2] + v1[3] * v1[3]); }
                if (ss) { part += __shfl_xor(part, 16); part += __shfl_xor(part, 32); if (fq == 0) atomicAdd(ss + row, part); } }
            asm volatile("" ::: "memory"); }
    }
};
struct EpiWin {
    bf16 *QKV, *G; const float *ss, *bg, *naq, *nak, *swq, *swk;
    __device__ __forceinline__ void operator()(const Acc& acc, const Unit& u, int wr, int wc, int fr, int fq) const {
        const int hg = __builtin_amdgcn_readfirstlane(4 * u.pn + wc);
        const int row0 = u.pm * BM + wr * 64 + fr;
        const float* gain = hg < 8 ? naq : hg < 16 ? nak : (hg >= 24 && hg < 32) ? swq : (hg >= 32 && hg < 34) ? swk : nullptr;
        const float qs = (hg < 8 || (hg >= 24 && hg < 32)) ? 0.125f : 1.f;
        const bool gate = hg >= 36;
        f32x4 gv[2][2];
#pragma unroll
        for (int bj = 0; bj < 2; ++bj)
#pragma unroll
            for (int n = 0; n < 2; ++n) { const int d = 32 * bj + 8 * fq + 4 * n;
                gv[bj][n] = gate ? *(const f32x4*)(bg + 64 * (hg - 36) + d) : gain ? *(const f32x4*)(gain + d) : (f32x4){1.f, 1.f, 1.f, 1.f}; }
        float rr[2][4];
#pragma unroll
        for (int ai = 0; ai < 2; ++ai)
#pragma unroll
            for (int m = 0; m < 4; ++m) rr[ai][m] = ss[row0 + ai * HALF + m * 16];
#pragma unroll
        for (int ai = 0; ai < 2; ++ai)
#pragma unroll
            for (int m = 0; m < 4; ++m) { const int row = row0 + ai * HALF + m * 16; const float r = __builtin_amdgcn_rsqf(rr[ai][m] * (1.f / DM) + EPS);
                f32x4 z[2][2]; float q = 0.f;
#pragma unroll
                for (int bj = 0; bj < 2; ++bj)
#pragma unroll
                    for (int n = 0; n < 2; ++n) { z[bj][n] = r * acc[ai][bj][m][n]; const f32x4 t = z[bj][n]; q += (t[0] * t[0] + t[1] * t[1]) + (t[2] * t[2] + t[3] * t[3]); }
                if (gate) {
#pragma unroll
                    for (int bj = 0; bj < 2; ++bj)
#pragma unroll
                        for (int n = 0; n < 2; ++n)
#pragma unroll
                            for (int j = 0; j < 4; ++j) z[bj][n][j] = fast_sigmoid(z[bj][n][j] + gv[bj][n][j]);
                } else if (gain) {
                    q += __shfl_xor(q, 16); q += __shfl_xor(q, 32);
                    const float hn = __builtin_amdgcn_rsqf(q * (1.f / 64.f) + EPS) * qs;
#pragma unroll
                    for (int bj = 0; bj < 2; ++bj)
#pragma unroll
                        for (int n = 0; n < 2; ++n) z[bj][n] = z[bj][n] * hn * gv[bj][n];
                }
                bf16* dst = gate ? G + (size_t)row * NG + 64 * (hg - 36) + 8 * fq : QKV + (size_t)row * NQKV + 64 * hg + 8 * fq;
#pragma unroll
                for (int bj = 0; bj < 2; ++bj) { u32x4 w; w.x = cvt_pk_bf16(z[bj][0][0], z[bj][0][1]); w.y = cvt_pk_bf16(z[bj][0][2], z[bj][0][3]); w.z = cvt_pk_bf16(z[bj][1][0], z[bj][1][1]); w.w = cvt_pk_bf16(z[bj][1][2], z[bj][1][3]);
                    *(u32x4*)(dst + 32 * bj) = w; } }
    }
};
template <int SECOND> struct EpiBranch {
    bf16 *T, *MRG; const bf16* G;
    __device__ __forceinline__ void operator()(const Acc& acc, const Unit& u, int wr, int wc, int fr, int fq) const {
        const int row0 = u.pm * BM + wr * 64 + fr, col0 = u.pn * BM + wc * 64 + 8 * fq;
#pragma unroll
        for (int ai = 0; ai < 2; ++ai) {
            u32x4 gw[4][2], tw[4][2];
#pragma unroll
            for (int m = 0; m < 4; ++m)
#pragma unroll
                for (int bj = 0; bj < 2; ++bj) { const int row = row0 + ai * HALF + m * 16, c = col0 + 32 * bj;
                    gw[m][bj] = *(const u32x4*)(G + (size_t)row * NG + SECOND * DM + c);
                    tw[m][bj] = (u32x4){0u, 0u, 0u, 0u}; if (SECOND) tw[m][bj] = *(const u32x4*)(T + (size_t)row * DM + c); }
#pragma unroll
            for (int m = 0; m < 4; ++m)
#pragma unroll
                for (int bj = 0; bj < 2; ++bj) { const size_t o = (size_t)(row0 + ai * HALF + m * 16) * DM + col0 + 32 * bj;
                    float v[8];
#pragma unroll
                    for (int e = 0; e < 8; ++e) { const unsigned gq = gw[m][bj][e >> 1], tq = tw[m][bj][e >> 1];
                        const unsigned gbits = (e & 1) ? (gq & 0xffff0000u) : (gq << 16), tbits = (e & 1) ? (tq & 0xffff0000u) : (tq << 16);
                        v[e] = __builtin_bit_cast(float, tbits) + __builtin_bit_cast(float, gbits) * acc[ai][bj][m][e >> 2][e & 3]; }
                    u32x4 w; w.x = cvt_pk_bf16(v[0], v[1]); w.y = cvt_pk_bf16(v[2], v[3]); w.z = cvt_pk_bf16(v[4], v[5]); w.w = cvt_pk_bf16(v[6], v[7]);
                    *(u32x4*)((SECOND ? MRG : T) + o) = w; }
            asm volatile("" ::: "memory"); }
    }
};
}

#define XB_TMO      128
#define XB_XCNT(j)  (256  + 64 * (j))
#define XB_XSUB(j)  (1280 + 64 * (j))
#define XB_XGEN(j)  (2304 + 64 * (j))
#define XB_TOP      3328
#define XB_TOPGEN   3392
#define XCD_BAR_WORDS 3456
#define XB_SPIN_CAP (1u << 18)
__device__ __forceinline__ unsigned xb_ld(unsigned* p)              { return __hip_atomic_load(p, __ATOMIC_RELAXED, __HIP_MEMORY_SCOPE_AGENT); }
__device__ __forceinline__ unsigned xb_add(unsigned* p, unsigned v) { return __hip_atomic_fetch_add(p, v, __ATOMIC_RELAXED, __HIP_MEMORY_SCOPE_AGENT); }
__device__ __forceinline__ unsigned xb_xcc_id() { return (unsigned)__builtin_amdgcn_s_getreg((3 << 11) | 20) & 0xFu; }
#define XB_SPIN(cond, bar) do { unsigned _sp = 0; while (cond) { __builtin_amdgcn_s_sleep(1); \
    if ((++_sp & 255u) == 0u) { if (xb_ld(&(bar)[XB_TMO])) break; if (_sp > XB_SPIN_CAP) { atomicAdd(&(bar)[XB_TMO], 1u); break; } } } } while (0)
struct XcdBarrier { unsigned* bar; unsigned x; volatile LAS unsigned* st; };
__device__ __forceinline__ XcdBarrier xcd_barrier_post(unsigned* bar, volatile LAS unsigned* st) {
    XcdBarrier b; b.bar = bar; b.x = xb_xcc_id(); b.st = st;
    if (threadIdx.x == 0) (void)xb_add(&bar[XB_XCNT(b.x)], 1u);
    return b;
}
__device__ __forceinline__ void xcd_barrier_complete(unsigned* bar, unsigned x, unsigned& nloc, unsigned& nx) {
    const unsigned G = gridDim.x * gridDim.y * gridDim.z;
    unsigned sum, cnt, mine, sp = 0u;
    for (;;) {
        sum = 0u; cnt = 0u; mine = 0u;
#pragma unroll
        for (unsigned j = 0; j < 16; ++j) { const unsigned c = xb_ld(&bar[XB_XCNT(j)]); sum += c; cnt += (c > 0u) ? 1u : 0u; mine = (j == x) ? c : mine; }
        if (sum == G) break;
        __builtin_amdgcn_s_sleep(1);
        if ((++sp & 255u) == 0u) { if (xb_ld(&bar[XB_TMO])) break; if (sp > XB_SPIN_CAP) { atomicAdd(&bar[XB_TMO], 1u); break; } }
    }
    nloc = mine > 0u ? mine : 1u; nx = cnt > 0u ? cnt : 1u;
}
__device__ __forceinline__ void xcd_barrier(const XcdBarrier& b) {
    asm volatile("s_waitcnt vmcnt(0)" ::: "memory");
    __syncthreads();
    if (threadIdx.x == 0) {
        unsigned* bar = b.bar;
        __builtin_amdgcn_s_waitcnt(0);
        unsigned nloc = b.st[0], nx = b.st[1];
        if (nloc == 0u) { xcd_barrier_complete(bar, b.x, nloc, nx); b.st[0] = nloc; b.st[1] = nx; }
        const unsigned old = xb_add(&bar[XB_XSUB(b.x)], 1u);
        const unsigned gen = old / nloc;
        if (old + 1u == (gen + 1u) * nloc) {
            __builtin_amdgcn_fence(__ATOMIC_RELEASE, "agent");
            asm volatile("s_waitcnt vmcnt(0)" ::: "memory");
            const unsigned og = xb_add(&bar[XB_TOP], 1u);
            const unsigned tg = og / nx;
            if (og + 1u == (tg + 1u) * nx) xb_add(&bar[XB_TOPGEN], 1u);
            else XB_SPIN(xb_ld(&bar[XB_TOPGEN]) == tg, bar);
            __builtin_amdgcn_fence(__ATOMIC_ACQUIRE, "agent");
            xb_add(&bar[XB_XGEN(b.x)], 1u);
            asm volatile("s_waitcnt vmcnt(0)" ::: "memory");
        } else {
            XB_SPIN(xb_ld(&bar[XB_XGEN(b.x)]) == gen, bar);
            __builtin_amdgcn_fence(__ATOMIC_ACQUIRE, "agent");
            asm volatile("s_waitcnt vmcnt(0)" ::: "memory");
        }
    }
    __syncthreads();
}

__device__ __forceinline__ unsigned pk2(float lo, float hi) { return f2bf(lo) | (f2bf(hi) << 16); }
__device__ __forceinline__ int perm32(int rho) { const int n = rho >> 4, i = rho & 15; return 8 * (i >> 2) + 4 * n + (i & 3); }
__device__ __forceinline__ void prep_item(const float* W, int ldw, int cbase, const float* gn, bf16* WT, int K, int rbase, int k0, LAS float* scr, int lane) {
#pragma unroll 8
    for (int i = 0; i < 32; ++i) { const int kk = 2 * i + (lane >> 5); const float g = gn ? gn[k0 + kk] : 1.f; scr[kk * 33 + (lane & 31)] = g * W[(size_t)(k0 + kk) * ldw + cbase + (lane & 31)]; }
    asm volatile("s_waitcnt lgkmcnt(0)" ::: "memory");
    const int c = lane & 7;
#pragma unroll
    for (int j = 0; j < 4; ++j) { const int rr = (lane >> 3) + 8 * j; const LAS float* s = scr + (8 * c) * 33 + perm32(rr);
        u32x4 o; o.x = pk2(s[0 * 33], s[1 * 33]); o.y = pk2(s[2 * 33], s[3 * 33]); o.z = pk2(s[4 * 33], s[5 * 33]); o.w = pk2(s[6 * 33], s[7 * 33]);
        *(u32x4*)(WT + (size_t)(rbase + rr) * K + k0 + 8 * c) = o; }
    asm volatile("s_waitcnt lgkmcnt(0)" ::: "memory");
}
__device__ __forceinline__ void prep_head(const float* W, int K, int N, const float* gn, bf16* WT, int it, LAS float* scr, int lane) {
    const int nsg = N / 32, kb = it / nsg, sg = it % nsg, pn = sg >> 3, bj = (sg >> 2) & 1, wc = sg & 3;
    prep_item(W, N, 256 * pn + 64 * wc + 32 * bj, gn, WT, K, 32 * sg, 64 * kb, scr, lane);
}
__device__ __forceinline__ void prep_gateup(const float* Wg, const float* Wu, const float* gn, bf16* WT, int it, LAS float* scr, int lane) {
    const int nsg = 2 * FF / 32, kb = it / nsg, sg = it % nsg, pn = sg >> 3, bj = (sg >> 2) & 1, wc = sg & 3;
    prep_item(bj ? Wu : Wg, FF, 128 * pn + 32 * wc, gn, WT, DM, 32 * sg, 64 * kb, scr, lane);
}
__device__ __forceinline__ float wave_sum64(float v) {
#pragma unroll
    for (int o = 1; o < 64; o <<= 1) v += __shfl_xor(v, o);
    return v;
}

__device__ __forceinline__ bf16x8 tr_pair(const LAS unsigned char* p0, const LAS unsigned char* p1) {
    typedef short v4i16 __attribute__((ext_vector_type(4)));
    const v4i16 lo = __builtin_amdgcn_ds_read_tr16_b64_v4i16((LAS v4i16*)p0), hi = __builtin_amdgcn_ds_read_tr16_b64_v4i16((LAS v4i16*)p1);
    return (bf16x8){lo[0], lo[1], lo[2], lo[3], hi[0], hi[1], hi[2], hi[3]};
}
__device__ __forceinline__ int fK(int key) { return ((key >> 1) & 1) | (((key >> 3) & 3) << 1); }
__device__ __forceinline__ int fV(int key) { return ((key >> 1) & 1) | (((key >> 3) & 1) << 1); }

template <int NS> __device__ __forceinline__ float softmax_pack(f32x4 (&S)[NS][2], bf16x8 (&pk)[NS], bool has_sink, float sink) {
    float mx = has_sink ? sink : -3.0e38f;
#pragma unroll
    for (int s = 0; s < NS; ++s)
#pragma unroll
        for (int hb = 0; hb < 2; ++hb) mx = fmaxf(mx, fmaxf(fmaxf(S[s][hb][0], S[s][hb][1]), fmaxf(S[s][hb][2], S[s][hb][3])));
    mx = fmaxf(mx, __shfl_xor(mx, 16)); mx = fmaxf(mx, __shfl_xor(mx, 32));
    const float mb = mx * 1.4426950408889634f; float l = 0.f;
#pragma unroll
    for (int s = 0; s < NS; ++s) {
#pragma unroll
        for (int hb = 0; hb < 2; ++hb)
#pragma unroll
            for (int j = 0; j < 4; ++j) { const float e = __builtin_amdgcn_exp2f(S[s][hb][j] * 1.4426950408889634f - mb); S[s][hb][j] = e; l += e; }
        u32x4 w; w.x = cvt_pk_bf16(S[s][0][0], S[s][0][1]); w.y = cvt_pk_bf16(S[s][0][2], S[s][0][3]); w.z = cvt_pk_bf16(S[s][1][0], S[s][1][1]); w.w = cvt_pk_bf16(S[s][1][2], S[s][1][3]);
        pk[s] = __builtin_bit_cast(bf16x8, w);
    }
    l += __shfl_xor(l, 16); l += __shfl_xor(l, 32);
    if (has_sink) l += __builtin_amdgcn_exp2f(sink * 1.4426950408889634f - mb);
    return 1.f / l;
}

constexpr int SW_K_OFF = 0, SW_V_OFF = 49152, SW_LUT_OFF = 98304, SW_LUT_LD = 512;
__device__ __forceinline__ void swa_unit(LAS unsigned char* lds, int b, int g, int nb, const bf16* QKV, const float* t5, const float* sink, bf16* OSW) {
    int tid_ = threadIdx.x; asm volatile("" : "+v"(tid_));
    const int tid = tid_, lane = tid & 63, wid = __builtin_amdgcn_readfirstlane(tid >> 6), fr = lane & 15, fq = lane >> 4;
#pragma unroll
    for (int i = 0; i < 6; ++i) { const int cid = tid + NTHREADS * i, key = cid >> 3, c = cid & 7, kp = 128 * (nb - 1) + key; const bool ok = kp >= 0 && kp < SEQ;
        const bf16* src = QKV + (size_t)(b * SEQ + (ok ? kp : 0)) * NQKV + 64 * g + 8 * c;
        u32x4 kv = (u32x4){0u, 0u, 0u, 0u}, vv = kv; if (ok) { kv = *(const u32x4*)(src + 2048); vv = *(const u32x4*)(src + 2176); }
        *(LAS u32x4*)(lds + SW_K_OFF + key * 128 + ((c ^ fK(key)) << 4)) = kv;
        *(LAS u32x4*)(lds + SW_V_OFF + key * 128 + (((c >> 1) ^ fV(key)) << 5) + ((c & 1) << 4)) = vv; }
    for (int idx = tid; idx < 4 * 512; idx += NTHREADS) { const int hh = idx >> 9, rel = (idx & 511) - 255;
        ((LAS float*)(lds + SW_LUT_OFF))[idx] = (rel >= -128 && rel <= 128) ? t5[slow::t5_bucket(rel) * 8 + 4 * g + hh] : NEGV; }
    __syncthreads();
    const int fKl = ((fr >> 1) & 1) | ((fr >> 2) << 1);
    const LAS unsigned char* kb0 = lds + SW_K_OFF + (8 * (fr >> 2) + (fr & 3)) * 128 + ((fq ^ fKl) << 4);
    const LAS unsigned char* kb1 = lds + SW_K_OFF + (8 * (fr >> 2) + (fr & 3)) * 128 + (((4 + fq) ^ fKl) << 4);
    const int q4 = (lane & 15) >> 2, p4 = lane & 3, fVl = ((q4 >> 1) & 1) | ((fq & 1) << 1);
    const LAS unsigned char* vb = lds + SW_V_OFF + (8 * fq + q4) * 128 + p4 * 8;
    const int relbase = 8 * fq - 128 - 16 * wid - fr + 255;
    const bool first_bad = (nb == 0), last_bad = (nb == SEQ / 128 - 1);
    const size_t tokq = (size_t)b * SEQ + 128 * nb + 16 * wid + fr;
    for (int hh = 0; hh < 4; ++hh) {
        const int h = 4 * g + hh;
        const bf16x8 q0 = *(const bf16x8*)(QKV + tokq * NQKV + 1536 + 64 * h + 8 * fq), q1 = *(const bf16x8*)(QKV + tokq * NQKV + 1536 + 64 * h + 32 + 8 * fq);
        const LAS float* lut = (const LAS float*)(lds + SW_LUT_OFF) + hh * SW_LUT_LD + relbase;
        f32x4 S[12][2]; bf16x8 pk[12];
#pragma unroll
        for (int s = 0; s < 12; ++s) {
            const bool bad = (s < 4 && first_bad) || (s >= 8 && last_bad);
#pragma unroll
            for (int hb = 0; hb < 2; ++hb) { const bf16x8 k0 = *(const LAS bf16x8*)(kb0 + s * 4096 + hb * 512), k1 = *(const LAS bf16x8*)(kb1 + s * 4096 + hb * 512);
                f32x4 a = (f32x4){0.f, 0.f, 0.f, 0.f}; a = __builtin_amdgcn_mfma_f32_16x16x32_bf16(k0, q0, a, 0, 0, 0); a = __builtin_amdgcn_mfma_f32_16x16x32_bf16(k1, q1, a, 0, 0, 0);
#pragma unroll
                for (int j = 0; j < 4; ++j) a[j] = bad ? NEGV : a[j] + lut[32 * s + 4 * hb + j];
                S[s][hb] = a; }
            if (s & 1) asm volatile("" ::: "memory"); }
        const float rl = softmax_pack<12>(S, pk, true, sink[h]);
        f32x4 O[4];
#pragma unroll
        for (int db = 0; db < 4; ++db) O[db] = (f32x4){0.f, 0.f, 0.f, 0.f};
#pragma unroll
        for (int s = 0; s < 12; ++s) {
#pragma unroll
            for (int db = 0; db < 4; ++db) { const LAS unsigned char* p = vb + s * 4096 + ((db ^ fVl) << 5); O[db] = __builtin_amdgcn_mfma_f32_16x16x32_bf16(tr_pair(p, p + 512), pk[s], O[db], 0, 0, 0); }
            if (s & 1) asm volatile("" ::: "memory"); }
        bf16* dst = OSW + tokq * 512 + 64 * h + 4 * fq;
#pragma unroll
        for (int db = 0; db < 4; ++db) { u32x2 w; w.x = cvt_pk_bf16(O[db][0] * rl, O[db][1] * rl); w.y = cvt_pk_bf16(O[db][2] * rl, O[db][3] * rl); *(u32x2*)(dst + 16 * db) = w; }
    }
    __syncthreads();
}

constexpr int NA_V_OFF = 0, NA_TAB_OFF = 122880;
__device__ __forceinline__ int na_rowstart(int r) { int rs = r - 4; return rs < 0 ? 0 : (rs > ROWS - 8 ? ROWS - 8 : rs); }
__device__ __forceinline__ void na_unit(LAS unsigned char* lds, int b, int h, int rq, const bf16* QKV, const float* rpb, bf16* ONA) {
    int tid_ = threadIdx.x; asm volatile("" : "+v"(tid_));
    const int tid = tid_, lane = tid & 63, wid = __builtin_amdgcn_readfirstlane(tid >> 6), fr = lane & 15, fq = lane >> 4;
    const int kr_lo = na_rowstart(8 * rq), kr_hi = na_rowstart(8 * rq + 7) + 7, nkeys = (kr_hi - kr_lo + 1) * GRID_W;
    for (int cid = tid; cid < nkeys * 8; cid += NTHREADS) { const int key = cid >> 3, c = cid & 7;
        const u32x4 vv = *(const u32x4*)(QKV + (size_t)(b * SEQ + kr_lo * GRID_W + key) * NQKV + 1024 + 64 * h + 8 * c);
        *(LAS u32x4*)(lds + NA_V_OFF + key * 128 + (((c >> 1) ^ fV(key)) << 5) + ((c & 1) << 4)) = vv; }
    for (int idx = tid; idx < 15 * 31; idx += NTHREADS) ((LAS float*)(lds + NA_TAB_OFF))[idx] = rpb[h * 465 + idx];
    __syncthreads();
    const LAS float* tab = (const LAS float*)(lds + NA_TAB_OFF);
    const int q4 = (lane & 15) >> 2, p4 = lane & 3;
    for (int i = 0; i < 4; ++i) {
        const int p = wid + 8 * i, r = 8 * rq + (p >> 2), cb = p & 3, rs = na_rowstart(r);
        int kcs = 16 * cb - 8; kcs = kcs < 0 ? 0 : (kcs > 32 ? 32 : kcs);
        const int qcol = 16 * cb + fr; int qcs = qcol - 8; qcs = qcs < 0 ? 0 : (qcs > 48 ? 48 : qcs);
        const size_t tokq = (size_t)b * SEQ + r * GRID_W + qcol;
        const bf16x8 q0 = *(const bf16x8*)(QKV + tokq * NQKV + 64 * h + 8 * fq), q1 = *(const bf16x8*)(QKV + tokq * NQKV + 64 * h + 32 + 8 * fq);
        const bf16* kbase = QKV + ((size_t)b * SEQ + rs * GRID_W + kcs + 8 * (fr >> 2) + (fr & 3)) * NQKV + 512 + 64 * h + 8 * fq;
        f32x4 S[8][2]; bf16x8 pk[8];
#pragma unroll
        for (int s = 0; s < 8; ++s) {
#pragma unroll
            for (int hb = 0; hb < 2; ++hb) { const bf16* kp = kbase + (size_t)(s * GRID_W + 4 * hb) * NQKV; const bf16x8 k0 = *(const bf16x8*)kp, k1 = *(const bf16x8*)(kp + 32);
                f32x4 a = (f32x4){0.f, 0.f, 0.f, 0.f}; a = __builtin_amdgcn_mfma_f32_16x16x32_bf16(k0, q0, a, 0, 0, 0); a = __builtin_amdgcn_mfma_f32_16x16x32_bf16(k1, q1, a, 0, 0, 0);
                const int ri = rs + s - r + 7;
#pragma unroll
                for (int j = 0; j < 4; ++j) { const int kcol = kcs + 8 * fq + 4 * hb + j; const bool ok = kcol >= qcs && kcol < qcs + 16; int ci = kcol - qcol + 15; ci = ci < 0 ? 0 : (ci > 30 ? 30 : ci);
                    a[j] = ok ? a[j] + tab[ri * 31 + ci] : NEGV; }
                S[s][hb] = a; }
            if ((s & 3) == 3) asm volatile("" ::: "memory"); }
        const float rl = softmax_pack<8>(S, pk, false, 0.f);
        const int fVl = ((q4 >> 1) & 1) | ((((kcs >> 3) + fq) & 1) << 1);
        const LAS unsigned char* vb = lds + NA_V_OFF + ((rs - kr_lo) * GRID_W + kcs + 8 * fq + q4) * 128 + p4 * 8;
        f32x4 O[4];
#pragma unroll
        for (int db = 0; db < 4; ++db) O[db] = (f32x4){0.f, 0.f, 0.f, 0.f};
#pragma unroll
        for (int s = 0; s < 8; ++s) {
#pragma unroll
            for (int db = 0; db < 4; ++db) { const LAS unsigned char* pp = vb + s * (GRID_W * 128) + ((db ^ fVl) << 5); O[db] = __builtin_amdgcn_mfma_f32_16x16x32_bf16(tr_pair(pp, pp + 512), pk[s], O[db], 0, 0, 0); }
            if (s & 1) asm volatile("" ::: "memory"); }
        bf16* dst = ONA + tokq * 512 + 64 * h + 4 * fq;
#pragma unroll
        for (int db = 0; db < 4; ++db) { u32x2 w; w.x = cvt_pk_bf16(O[db][0] * rl, O[db][1] * rl); w.y = cvt_pk_bf16(O[db][2] * rl, O[db][3] * rl); *(u32x2*)(dst + 16 * db) = w; }
    }
    __syncthreads();
}

#ifndef PG8_SP2
#define PG8_SP2 true
#endif
#ifndef PG8_ALIGN
#define PG8_ALIGN true
#endif
#ifndef CODE_MASK
#define CODE_MASK 255
#endif
constexpr int N_PHASES = 9 * DEPTH;
struct Args { Inputs I; float* out; unsigned char* ws; int ph_lo, ph_hi, bar_region, pad; };

__global__ void __launch_bounds__(NTHREADS, 2) mega_fwd(Args args) {
    extern __shared__ __attribute__((aligned(16))) unsigned char lds_raw[];
    LAS unsigned char* lds = (LAS unsigned char*)lds_raw;
    volatile LAS unsigned* MISC = (volatile LAS unsigned*)(lds + MISC_OFF);
    const int tid = threadIdx.x, lane = tid & 63, wave = __builtin_amdgcn_readfirstlane(tid >> 6);
    const int G = gridDim.x, bx = blockIdx.x, vcu = (G % 8 == 0) ? (bx % 8) * (G / 8) + bx / 8 : bx;
    unsigned char* ws = args.ws;
    const Inputs& I = args.I;
    float* out = args.out;
    float* SS = (float*)(ws + WS_SS);
    bf16 *XB = (bf16*)(ws + WS_XB), *H = (bf16*)(ws + WS_H), *QKV = (bf16*)(ws + WS_QKV), *T = (bf16*)(ws + WS_T), *MRG = (bf16*)(ws + WS_MRG), *GT = (bf16*)(ws + WS_G),
         *ONA = (bf16*)(ws + WS_ONA), *OSW = (bf16*)(ws + WS_OSW);
    unsigned char* WB = ws + WS_W;
    for (int u = tid; u < (LDS_BYTES - RING_BYTES) / 4; u += NTHREADS) ((LAS unsigned*)(lds + RING_BYTES))[u] = 0u;
    __syncthreads();
    const int lo = args.ph_lo, hi = args.ph_hi;
    XcdBarrier bar; bar.bar = (unsigned*)(ws + WS_CTL) + 4096 + args.bar_region * XCD_BAR_WORDS; bar.x = 0; bar.st = nullptr;
    if (hi - lo > 1) bar = xcd_barrier_post(bar.bar, MISC + 8);

    for (int ph = lo; ph < hi; ++ph) {
        const int l = ph / 9, k = ph % 9;
        float* ss0 = SS + (size_t)(3 * l + 0) * M; float* ss1 = SS + (size_t)(3 * l + 1) * M; float* ss2 = SS + (size_t)(3 * l + 2) * M; float* ss3 = SS + (size_t)(3 * l + 3) * M;
        if (k == 0 && (CODE_MASK & 1)) {
            int lane_ = tid & 63; asm volatile("" : "+v"(lane_)); const int lane = lane_;
            LAS float* scr = (LAS float*)(lds + wave * 16384);
            const int gw = vcu * NWAVES + wave, NGW = G * NWAVES;
            constexpr int I_1C = (DM / 64) * (2 * FF / 32), I_1D = (FF / 64) * (DM / 32), I_IN = (DM / 64) * (INW / 32), I_P = (512 / 64) * (DM / 32), I_O = (DM / 64) * (DM / 32);
            constexpr int NITEMS = 2 * I_1C + 2 * I_1D + I_IN + 2 * I_P + I_O;
            for (int it = gw; it < NITEMS; it += NGW) {
                int r = it;
                if (r < I_1C) { prep_gateup(I.ffn1_wg + (size_t)l * DM * FF, I.ffn1_wu + (size_t)l * DM * FF, I.ffn1_norm + l * DM, (bf16*)(WB + WO_1C), r, scr, lane); continue; } r -= I_1C;
                if (r < I_1C) { prep_gateup(I.ffn2_wg + (size_t)l * DM * FF, I.ffn2_wu + (size_t)l * DM * FF, I.ffn2_norm + l * DM, (bf16*)(WB + WO_2C), r, scr, lane); continue; } r -= I_1C;
                if (r < I_1D) { prep_head(I.ffn1_wd + (size_t)l * FF * DM, FF, DM, nullptr, (bf16*)(WB + WO_1D), r, scr, lane); continue; } r -= I_1D;
                if (r < I_1D) { prep_head(I.ffn2_wd + (size_t)l * FF * DM, FF, DM, nullptr, (bf16*)(WB + WO_2D), r, scr, lane); continue; } r -= I_1D;
                if (r < I_IN) { prep_head(I.w_in + (size_t)l * DM * INW, DM, INW, I.mix_norm + l * DM, (bf16*)(WB + WO_IN), r, scr, lane); continue; } r -= I_IN;
                if (r < I_P) { prep_head(I.w_br_na + (size_t)l * 512 * DM, 512, DM, nullptr, (bf16*)(WB + WO_PA), r, scr, lane); continue; } r -= I_P;
                if (r < I_P) { prep_head(I.w_br_sw + (size_t)l * 512 * DM, 512, DM, nullptr, (bf16*)(WB + WO_PB), r, scr, lane); continue; } r -= I_P;
                prep_head(I.w_out + (size_t)l * DM * DM, DM, DM, nullptr, (bf16*)(WB + WO_OUT), r, scr, lane);
            }
            if (l == 0) {
                for (int m = gw; m < M; m += NGW) { const f32x4* xr = (const f32x4*)(I.x + (size_t)m * DM) + lane; float s = 0.f; u32x2* o8 = (u32x2*)(XB + (size_t)m * DM) + lane;
#pragma unroll
                    for (int j = 0; j < 4; ++j) { const f32x4 v = xr[64 * j]; s += (v[0] * v[0] + v[1] * v[1]) + (v[2] * v[2] + v[3] * v[3]); u32x2 w; w.x = pk2(v[0], v[1]); w.y = pk2(v[2], v[3]); o8[64 * j] = w; }
                    s = wave_sum64(s); if (lane == 0) ss0[m] = s; }
            }
            __syncthreads();
        } else if ((k == 1 || k == 7) && (CODE_MASK & 2)) {
            pg8::Gemm g{XB, (const bf16*)(WB + (k == 1 ? WO_1C : WO_2C)), M, 2 * FF, DM}; pg8::StaticOrder S; S.init(M, 2 * FF, G, bx);
            pg8::EpiFfnUp E{H, k == 1 ? ss0 : ss2};
            pg8::gemm_phase<pg8::EpiFfnUp, PG8_ALIGN, PG8_SP2>(lds, g, S, E);
        } else if ((k == 2 || k == 8) && (CODE_MASK & 4)) {
            pg8::Gemm g{H, (const bf16*)(WB + (k == 2 ? WO_1D : WO_2D)), M, DM, FF}; pg8::StaticOrder S; S.init(M, DM, G, bx);
            const bool fin = (k == 8 && l == DEPTH - 1);
            pg8::EpiResid E{(k == 2 && l == 0) ? I.x : out, out, fin ? nullptr : XB, fin ? nullptr : (k == 2 ? ss1 : ss3), 0.5f};
            pg8::gemm_phase<pg8::EpiResid, false, PG8_SP2>(lds, g, S, E);
        } else if (k == 3 && (CODE_MASK & 8)) {
            pg8::Gemm g{XB, (const bf16*)(WB + WO_IN), M, INW, DM}; pg8::StaticOrder S; S.init(M, INW, G, bx);
            pg8::EpiWin E{QKV, GT, ss1, I.b_gate + l * NG, I.na_q_norm + l * 64, I.na_k_norm + l * 64, I.sw_q_norm + l * 64, I.sw_k_norm + l * 64};
            pg8::gemm_phase<pg8::EpiWin, PG8_ALIGN, PG8_SP2>(lds, g, S, E);
        } else if (k == 4 && (CODE_MASK & 48)) {
            if (CODE_MASK & 16) for (int u = vcu; u < 256; u += G) na_unit(lds, u >> 5, (u >> 2) & 7, u & 3, QKV, I.na_rpb + (size_t)l * 8 * 465, ONA);
            if (CODE_MASK & 32) for (int u = vcu; u < 256; u += G) swa_unit(lds, u >> 5, (u >> 4) & 1, u & 15, QKV, I.t5, I.sw_sink + l * 8, OSW);
        } else if (k == 5 && (CODE_MASK & 64)) {
            pg8::StaticOrder S; S.init(M, DM, G, bx);
            { pg8::Gemm g{ONA, (const bf16*)(WB + WO_PA), M, DM, 512}; pg8::EpiBranch<0> E{T, MRG, GT}; pg8::gemm_phase<pg8::EpiBranch<0>, false, PG8_SP2>(lds, g, S, E); }
            { pg8::Gemm g{OSW, (const bf16*)(WB + WO_PB), M, DM, 512}; pg8::EpiBranch<1> E{T, MRG, GT}; pg8::gemm_phase<pg8::EpiBranch<1>, false, PG8_SP2>(lds, g, S, E); }
        } else if (k == 6 && (CODE_MASK & 128)) {
            pg8::Gemm g{MRG, (const bf16*)(WB + WO_OUT), M, DM, DM}; pg8::StaticOrder S; S.init(M, DM, G, bx);
            pg8::EpiResid E{out, out, XB, ss2, 1.0f};
            pg8::gemm_phase<pg8::EpiResid, false, PG8_SP2>(lds, g, S, E);
        }
        if (ph + 1 < hi) xcd_barrier(bar);
    }
}
#ifndef FAST_MASK
#define FAST_MASK 0x3ffffu
#endif
#ifndef MERGE_LAUNCHES
#define MERGE_LAUNCHES 0
#endif
static void launch_slow_phase(const Inputs& I, int ph, unsigned char* ws, float* out, hipStream_t stream) {
    const int l = ph / 9, k = ph % 9;
    float* SS = (float*)(ws + WS_SS);
    bf16 *XB = (bf16*)(ws + WS_XB), *H = (bf16*)(ws + WS_H), *QKV = (bf16*)(ws + WS_QKV), *T = (bf16*)(ws + WS_T), *MRG = (bf16*)(ws + WS_MRG), *G = (bf16*)(ws + WS_G),
         *ONA = (bf16*)(ws + WS_ONA), *OSW = (bf16*)(ws + WS_OSW);
    float* ss0 = SS + (size_t)(3 * l + 0) * M; float* ss1 = SS + (size_t)(3 * l + 1) * M; float* ss2 = SS + (size_t)(3 * l + 2) * M; float* ss3 = SS + (size_t)(3 * l + 3) * M;
    switch (k) {
    case 0: if (l == 0) hipLaunchKernelGGL(slow::prep_x, dim3(M), dim3(256), 0, stream, I.x, XB, SS); break;
    case 1: { slow::OpFfnUp op{DM, 0, XB, I.ffn1_wg + (size_t)l * DM * FF, I.ffn1_wu + (size_t)l * DM * FF, I.ffn1_norm + l * DM, ss0, H};
              hipLaunchKernelGGL(slow::gemm<slow::OpFfnUp>, dim3(FF / 64, M / 64), dim3(256), 0, stream, op); } break;
    case 2: { slow::OpResid op{FF, 0.5f, H, I.ffn1_wd + (size_t)l * FF * DM, l == 0 ? I.x : out, out, XB, ss1};
              hipLaunchKernelGGL(slow::gemm<slow::OpResid>, dim3(DM / 64, M / 64), dim3(256), 0, stream, op); } break;
    case 3: { slow::OpWin op{DM, 0, XB, I.w_in + (size_t)l * DM * INW, I.mix_norm + l * DM, ss1, I.b_gate + l * NG, I.na_q_norm + l * 64, I.na_k_norm + l * 64, I.sw_q_norm + l * 64, I.sw_k_norm + l * 64, QKV, G};
              hipLaunchKernelGGL(slow::gemm<slow::OpWin>, dim3(INW / 64, M / 64), dim3(256), 0, stream, op); } break;
    case 4: hipLaunchKernelGGL(slow::attn_na, dim3(M * 8 / 4), dim3(256), 0, stream, QKV, I.na_rpb + (size_t)l * 8 * 15 * 31, ONA);
            hipLaunchKernelGGL(slow::attn_sw, dim3(M * 8 / 4), dim3(256), 0, stream, QKV, I.t5, I.sw_sink + l * 8, OSW); break;
    case 5: { slow::OpBranch op{512, 0, ONA, OSW, G, I.w_br_na + (size_t)l * 512 * DM, I.w_br_sw + (size_t)l * 512 * DM, T, MRG};
              hipLaunchKernelGGL(slow::gemm<slow::OpBranch>, dim3(DM / 64, M / 64), dim3(256), 0, stream, op); } break;
    case 6: { slow::OpResid op{DM, 1.0f, MRG, I.w_out + (size_t)l * DM * DM, out, out, XB, ss2};
              hipLaunchKernelGGL(slow::gemm<slow::OpResid>, dim3(DM / 64, M / 64), dim3(256), 0, stream, op); } break;
    case 7: { slow::OpFfnUp op{DM, 0, XB, I.ffn2_wg + (size_t)l * DM * FF, I.ffn2_wu + (size_t)l * DM * FF, I.ffn2_norm + l * DM, ss2, H};
              hipLaunchKernelGGL(slow::gemm<slow::OpFfnUp>, dim3(FF / 64, M / 64), dim3(256), 0, stream, op); } break;
    default: { const bool last = (l == DEPTH - 1);
              slow::OpResid op{FF, 0.5f, H, I.ffn2_wd + (size_t)l * FF * DM, out, out, last ? nullptr : XB, last ? nullptr : ss3};
              hipLaunchKernelGGL(slow::gemm<slow::OpResid>, dim3(DM / 64, M / 64), dim3(256), 0, stream, op); } break;
    }
}

extern "C" void kernel_launch(void* const* d_in, const int* in_sizes, int n_in, void* d_out, int out_size, void* d_ws, size_t ws_size, hipStream_t stream) {
    static int grid = 0;
    if (grid == 0) {
        if (n_in != 22 || in_sizes[0] != M * DM || out_size != M * DM || ws_size < WS_END) { fprintf(stderr, "kernel_launch: unexpected shapes (n_in %d, in0 %d, out %d, ws %zu)\n", n_in, n_in > 0 ? in_sizes[0] : -1, out_size, ws_size); grid = -1; return; }
        int dev = 0, cus = 0, per_cu = 0;
        if (hipGetDevice(&dev) != hipSuccess || hipDeviceGetAttribute(&cus, hipDeviceAttributeMultiprocessorCount, dev) != hipSuccess) { grid = -1; return; }
        if (hipFuncSetAttribute((const void*)mega_fwd, hipFuncAttributeMaxDynamicSharedMemorySize, LDS_BYTES) != hipSuccess) { fprintf(stderr, "kernel_launch: hipFuncSetAttribute failed\n"); grid = -1; return; }
        if (hipOccupancyMaxActiveBlocksPerMultiprocessor(&per_cu, (const void*)mega_fwd, NTHREADS, LDS_BYTES) != hipSuccess || per_cu < 1) fprintf(stderr, "kernel_launch: occupancy query says %d blocks/CU\n", per_cu);
        (void)hipGetLastError();
        grid = cus;
    }
    if (grid < 0) return;
    Inputs I;
    { const float** p = (const float**)&I; for (int i = 0; i < 22; ++i) p[i] = (const float*)d_in[i]; }
    unsigned char* ws = (unsigned char*)d_ws; float* out = (float*)d_out;
    (void)hipMemsetAsync(ws + WS_CTL, 0, CTL_ZERO_BYTES, stream);
    int region = 0;
    for (int ph = 0; ph < N_PHASES;) {
        if (!((FAST_MASK >> ph) & 1u)) { launch_slow_phase(I, ph, ws, out, stream); ++ph; continue; }
        int hi = ph + 1;
        if (MERGE_LAUNCHES) while (hi < N_PHASES && ((FAST_MASK >> hi) & 1u)) ++hi;
        Args a{};
        a.I = I; a.out = out; a.ws = ws; a.ph_lo = ph; a.ph_hi = hi; a.bar_region = region++; a.pad = 0;
        hipLaunchKernelGGL(mega_fwd, dim3(grid), dim3(NTHREADS), LDS_BYTES, stream, a);
        ph = hi;
    }
}
```

```cpp
#include <hip/hip_runtime.h>
#include <cstdio>
#include <cstdint>

constexpr int BATCH = 8, SEQ = 2048, DM = 1024, DEPTH = 2, FF = 2816;
constexpr int M = BATCH * SEQ;
constexpr int GRID_W = 64, ROWS = SEQ / GRID_W;
constexpr int NQKV = 2304, NG = 2048, INW = NQKV + NG;
constexpr float EPS = 1e-6f;
constexpr float NEGV = -1e30f;

typedef unsigned short bf16;

constexpr size_t MiB = 1u << 20;
constexpr size_t WS_CTL = 0;
constexpr size_t WS_SS = 512 * 1024;
constexpr size_t CTL_ZERO_BYTES = 1 * MiB;
constexpr size_t WS_W = 1 * MiB;
constexpr size_t WS_XB = 47 * MiB;
constexpr size_t WS_H = 79 * MiB;
constexpr size_t WS_QKV = 79 * MiB;
constexpr size_t WS_T = 79 * MiB;
constexpr size_t WS_MRG = 111 * MiB;
constexpr size_t WS_G = 151 * MiB;
constexpr size_t WS_ONA = 215 * MiB;
constexpr size_t WS_OSW = 231 * MiB;
constexpr size_t WS_END = 247 * MiB;

__device__ __forceinline__ unsigned f2bf(float f) { unsigned u = __builtin_bit_cast(unsigned, f); return (u + 0x7fffu + ((u >> 16) & 1u)) >> 16; }
__device__ __forceinline__ float bf2f(unsigned b) { return __builtin_bit_cast(float, b << 16); }
__device__ __forceinline__ float bfr(float f) { return bf2f(f2bf(f)); }

struct Inputs {
    const float *x, *ffn1_norm, *ffn1_wg, *ffn1_wu, *ffn1_wd, *mix_norm, *w_in, *b_gate, *na_q_norm, *na_k_norm, *na_rpb, *sw_q_norm, *sw_k_norm, *sw_sink, *t5,
                *w_br_na, *w_br_sw, *w_out, *ffn2_norm, *ffn2_wg, *ffn2_wu, *ffn2_wd;
};

namespace slow {
template <class Op> __global__ void __launch_bounds__(256) gemm(Op op) {
    constexpr int NS = Op::NSEL;
    __shared__ float As[NS][16][68];
    __shared__ float Bs[NS][16][68];
    __shared__ float Cs[NS][64][65];
    const int tid = threadIdx.x, tx = tid & 15, ty = tid >> 4;
    const int m0 = blockIdx.y * 64, n0 = blockIdx.x * 64;
    float acc[NS][4][4];
#pragma unroll
    for (int s = 0; s < NS; ++s)
#pragma unroll
        for (int i = 0; i < 4; ++i)
#pragma unroll
            for (int j = 0; j < 4; ++j) acc[s][i][j] = 0.f;
    for (int k0 = 0; k0 < op.K; k0 += 16) {
#pragma unroll
        for (int s = 0; s < NS; ++s) {
#pragma unroll
            for (int e = 0; e < 4; ++e) {
                const int idx = tid + e * 256;
                { const int kk = idx & 15, mm = idx >> 4; As[s][kk][mm] = op.a(s, m0 + mm, k0 + kk); }
                { const int nn = idx & 63, kk = idx >> 6; Bs[s][kk][nn] = op.b(s, k0 + kk, n0 + nn); }
            }
        }
        __syncthreads();
#pragma unroll
        for (int kk = 0; kk < 16; ++kk) {
#pragma unroll
            for (int s = 0; s < NS; ++s) {
                float av[4], bv[4];
#pragma unroll
                for (int i = 0; i < 4; ++i) { av[i] = As[s][kk][ty * 4 + i]; bv[i] = Bs[s][kk][tx * 4 + i]; }
#pragma unroll
                for (int i = 0; i < 4; ++i)
#pragma unroll
                    for (int j = 0; j < 4; ++j) acc[s][i][j] += av[i] * bv[j];
            }
        }
        __syncthreads();
    }
#pragma unroll
    for (int s = 0; s < NS; ++s)
#pragma unroll
        for (int i = 0; i < 4; ++i)
#pragma unroll
            for (int j = 0; j < 4; ++j) Cs[s][ty * 4 + i][tx * 4 + j] = acc[s][i][j];
    __syncthreads();
    op.epi(m0, n0, Cs, tid);
}

struct OpFfnUp {
    static constexpr int NSEL = 2; int K, pad_;
    const bf16* xb; const float *wg, *wu, *gn, *ss; bf16* H;
    __device__ float a(int, int m, int k) const { return bf2f(xb[(size_t)m * DM + k]); }
    __device__ float b(int s, int k, int n) const { return bfr(gn[k] * (s ? wu : wg)[(size_t)k * FF + n]); }
    __device__ void epi(int m0, int n0, float (*Cs)[64][65], int tid) const {
        for (int e = tid; e < 4096; e += 256) { const int i = e >> 6, j = e & 63, m = m0 + i;
            const float r = rsqrtf(ss[m] * (1.f / DM) + EPS), zg = r * Cs[0][i][j], zu = r * Cs[1][i][j];
            const float h = zg / (1.f + __expf(-zg)) * zu;
            H[(size_t)m * FF + n0 + j] = (bf16)f2bf(h); }
    }
};
struct OpResid {
    static constexpr int NSEL = 1; int K; float alpha;
    const bf16* A; const float* w; const float* base; float* out; bf16* xb; float* ss;
    __device__ float a(int, int m, int k) const { return bf2f(A[(size_t)m * K + k]); }
    __device__ float b(int, int k, int n) const { return bfr(w[(size_t)k * DM + n]); }
    __device__ void epi(int m0, int n0, float (*Cs)[64][65], int tid) const {
        for (int e = tid; e < 4096; e += 256) { const int i = e >> 6, j = e & 63; const size_t o = (size_t)(m0 + i) * DM + n0 + j;
            const float v = base[o] + alpha * Cs[0][i][j]; out[o] = v; Cs[0][i][j] = v; if (xb) xb[o] = (bf16)f2bf(v); }
        __syncthreads();
        if (ss && tid < 64) { float s = 0.f; for (int j = 0; j < 64; ++j) s += Cs[0][tid][j] * Cs[0][tid][j]; atomicAdd(ss + m0 + tid, s); }
    }
};
struct OpWin {
    static constexpr int NSEL = 1; int K, pad_;
    const bf16* xb; const float *w, *gn, *ss, *bg, *naq, *nak, *swq, *swk; bf16 *QKV, *G;
    __device__ float a(int, int m, int k) const { return bf2f(xb[(size_t)m * DM + k]); }
    __device__ float b(int, int k, int n) const { return bfr(gn[k] * w[(size_t)k * INW + n]); }
    __device__ void epi(int m0, int n0, float (*Cs)[64][65], int tid) const {
        __shared__ float hn[64];
        const int hg = n0 >> 6;
        const float* gain = hg < 8 ? naq : hg < 16 ? nak : (hg >= 24 && hg < 32) ? swq : (hg >= 32 && hg < 34) ? swk : nullptr;
        const float qs = (hg < 8 || (hg >= 24 && hg < 32)) ? 0.125f : 1.f;
        for (int e = tid; e < 4096; e += 256) { const int i = e >> 6, j = e & 63; Cs[0][i][j] *= rsqrtf(ss[m0 + i] * (1.f / DM) + EPS); }
        __syncthreads();
        if (tid < 64) { float s = 0.f; for (int j = 0; j < 64; ++j) s += Cs[0][tid][j] * Cs[0][tid][j]; hn[tid] = rsqrtf(s * (1.f / 64.f) + EPS); }
        __syncthreads();
        for (int e = tid; e < 4096; e += 256) { const int i = e >> 6, j = e & 63, m = m0 + i; float z = Cs[0][i][j];
            if (hg < 36) { if (gain) z = z * hn[i] * gain[j] * qs; QKV[(size_t)m * NQKV + n0 + j] = (bf16)f2bf(z); }
            else { const int c = n0 - NQKV + j; z = 1.f / (1.f + __expf(-(z + bg[c]))); G[(size_t)m * NG + c] = (bf16)f2bf(z); } }
    }
};
struct OpBranch {
    static constexpr int NSEL = 2; int K, pad_;
    const bf16 *ONA, *OSW, *G; const float *pa, *pb; bf16 *T, *MRG;
    __device__ float a(int s, int m, int k) const { return bf2f((s ? OSW : ONA)[(size_t)m * 512 + k]); }
    __device__ float b(int s, int k, int n) const { return bfr((s ? pb : pa)[(size_t)k * DM + n]); }
    __device__ void epi(int m0, int n0, float (*Cs)[64][65], int tid) const {
        for (int e = tid; e < 4096; e += 256) { const int i = e >> 6, j = e & 63, m = m0 + i, n = n0 + j;
            const float gA = bf2f(G[(size_t)m * NG + n]), gB = bf2f(G[(size_t)m * NG + DM + n]);
            const float t = bfr(gA * Cs[0][i][j]); T[(size_t)m * DM + n] = (bf16)f2bf(t);
            MRG[(size_t)m * DM + n] = (bf16)f2bf(t + gB * Cs[1][i][j]); }
    }
};

__global__ void __launch_bounds__(256) prep_x(const float* x, bf16* xb, float* ss) {
    __shared__ float red[256];
    const int m = blockIdx.x, tid = threadIdx.x; float s = 0.f;
    for (int c = tid; c < DM; c += 256) { const float v = x[(size_t)m * DM + c]; xb[(size_t)m * DM + c] = (bf16)f2bf(v); s += v * v; }
    red[tid] = s; __syncthreads();
    for (int o = 128; o > 0; o >>= 1) { if (tid < o) red[tid] += red[tid + o]; __syncthreads(); }
    if (tid == 0) ss[m] = red[0];
}

__device__ __forceinline__ float wave_sum(float v) {
#pragma unroll
    for (int o = 1; o < 64; o <<= 1) v += __shfl_xor(v, o);
    return v;
}
__device__ __forceinline__ float wave_max(float v) {
#pragma unroll
    for (int o = 1; o < 64; o <<= 1) v = fmaxf(v, __shfl_xor(v, o));
    return v;
}
__global__ void __launch_bounds__(256) attn_na(const bf16* QKV, const float* rpb  , bf16* ONA) {
    __shared__ float sc[4][128];
    const int w = threadIdx.x >> 6, lane = threadIdx.x & 63;
    const int item = blockIdx.x * 4 + w;
    const int h = item & 7, tok = item >> 3, b = tok / SEQ, t = tok % SEQ, r = t / GRID_W, c = t % GRID_W;
    int rs = r - 4; rs = rs < 0 ? 0 : (rs > ROWS - 8 ? ROWS - 8 : rs);
    int cs = c - 8; cs = cs < 0 ? 0 : (cs > GRID_W - 16 ? GRID_W - 16 : cs);
    const float q = bf2f(QKV[(size_t)tok * NQKV + h * 64 + lane]);
    for (int j = 0; j < 128; ++j) { const int kr = rs + (j >> 4), kc = cs + (j & 15); const size_t kt = (size_t)b * SEQ + kr * GRID_W + kc;
        float s = wave_sum(q * bf2f(QKV[kt * NQKV + 512 + h * 64 + lane]));
        s += rpb[(h * 15 + (kr - r + 7)) * 31 + (kc - c + 15)];
        if (lane == 0) sc[w][j] = s; }
    __syncthreads();
    const float s0 = sc[w][lane], s1 = sc[w][lane + 64];
    const float mx = wave_max(fmaxf(s0, s1));
    const float e0 = __expf(s0 - mx), e1 = __expf(s1 - mx);
    const float l = wave_sum(e0 + e1);
    __syncthreads();
    sc[w][lane] = bfr(e0); sc[w][lane + 64] = bfr(e1);
    __syncthreads();
    float o = 0.f;
    for (int j = 0; j < 128; ++j) { const int kr = rs + (j >> 4), kc = cs + (j & 15); const size_t kt = (size_t)b * SEQ + kr * GRID_W + kc;
        o += sc[w][j] * bf2f(QKV[kt * NQKV + 1024 + h * 64 + lane]); }
    ONA[(size_t)tok * 512 + h * 64 + lane] = (bf16)f2bf(o / l);
}
__device__ __forceinline__ int t5_bucket(int rel) {
    const int n = rel < 0 ? -rel : rel; int v;
    if (n < 8) v = n; else { int k = 0; while (64 * (2 << k) <= n * n) ++k; v = 8 + k; v = v > 15 ? 15 : v; }
    return (rel > 0 ? 16 : 0) + v;
}
__global__ void __launch_bounds__(256) attn_sw(const bf16* QKV, const float* t5  , const float* sink  , bf16* OSW) {
    __shared__ float sc[4][320];
    const int w = threadIdx.x >> 6, lane = threadIdx.x & 63;
    const int item = blockIdx.x * 4 + w;
    const int h = item & 7, tok = item >> 3, b = tok / SEQ, t = tok % SEQ, g = h >> 2;
    const int k0 = t - 128 < 0 ? 0 : t - 128, k1 = t + 128 > SEQ - 1 ? SEQ - 1 : t + 128, nk = k1 - k0 + 1;
    const float q = bf2f(QKV[(size_t)tok * NQKV + 1536 + h * 64 + lane]);
    for (int j = 0; j < nk; ++j) { const size_t kt = (size_t)b * SEQ + k0 + j;
        float s = wave_sum(q * bf2f(QKV[kt * NQKV + 2048 + g * 64 + lane]));
        s += t5[t5_bucket(k0 + j - t) * 8 + h];
        if (lane == 0) sc[w][j] = s; }
    __syncthreads();
    const float snk = sink[h];
    float mx = snk; for (int j = lane; j < nk; j += 64) mx = fmaxf(mx, sc[w][j]);
    mx = wave_max(mx);
    float l = 0.f; for (int j = lane; j < nk; j += 64) { const float e = __expf(sc[w][j] - mx); l += e; sc[w][j] = bfr(e); }
    l = wave_sum(l) + __expf(snk - mx);
    __syncthreads();
    float o = 0.f;
    for (int j = 0; j < nk; ++j) { const size_t kt = (size_t)b * SEQ + k0 + j; o += sc[w][j] * bf2f(QKV[kt * NQKV + 2176 + g * 64 + lane]); }
    OSW[(size_t)tok * 512 + h * 64 + lane] = (bf16)f2bf(o / l);
}
}

#define LAS __attribute__((address_space(3)))
#define GAS __attribute__((address_space(1)))
typedef short bf16x8 __attribute__((ext_vector_type(8)));
typedef short s16x4 __attribute__((ext_vector_type(4)));
typedef float f32x4 __attribute__((ext_vector_type(4)));
typedef unsigned u32x4 __attribute__((ext_vector_type(4)));
typedef unsigned u32x2 __attribute__((ext_vector_type(2)));
typedef GAS unsigned gu32;

constexpr int NWAVES = 8, NTHREADS = 512;
constexpr int LDS_BYTES = 147456;
constexpr int RING_BYTES = 131072;
constexpr int MISC_OFF = RING_BYTES + 320;

constexpr size_t WO_1C = 0;
constexpr size_t WO_1D = WO_1C + (size_t)2 * FF * DM * 2;
constexpr size_t WO_IN = WO_1D + (size_t)DM * FF * 2;
constexpr size_t WO_PA = WO_IN + (size_t)INW * DM * 2;
constexpr size_t WO_PB = WO_PA + (size_t)DM * 512 * 2;
constexpr size_t WO_OUT = WO_PB + (size_t)DM * 512 * 2;
constexpr size_t WO_2C = WO_OUT + (size_t)DM * DM * 2;
constexpr size_t WO_2D = WO_2C + (size_t)2 * FF * DM * 2;
constexpr size_t WO_END = WO_2D + (size_t)DM * FF * 2;
static_assert(WS_W + WO_END <= WS_XB, "weight region");

__device__ __forceinline__ unsigned cvt_pk_bf16(float lo, float hi) { unsigned r; asm volatile("v_cvt_pk_bf16_f32 %0, %1, %2" : "=v"(r) : "v"(lo), "v"(hi)); return r; }
__device__ __forceinline__ float fast_sigmoid(float z) { return __builtin_amdgcn_rcpf(1.f + __builtin_amdgcn_exp2f(-1.4426950408889634f * z)); }
__device__ __forceinline__ float rs_row(const float* ss, int row) { return __builtin_amdgcn_rsqf(ss[row] * (1.f / DM) + EPS); }

namespace pg8 {
constexpr int BM = 256, BK = 64, HALF = 128, HTB = HALF * BK * 2, STAGE_BYTES = 8 * HTB, NXCD = 8, WGM = 8;
__host__ __device__ __forceinline__ int lds_byte(int r, int c) { const int st = (r >> 4) * 2 + (c >> 5), rr = r & 15, cc = c & 31, ob = rr * 64 + cc * 2; return st * 1024 + (ob ^ (((ob >> 9) & 1) << 5)); }
__host__ __device__ __forceinline__ void stage_rc(int b, int& R, int& C) { const int st = b / 1024, sb = b % 1024, swz = sb ^ (((sb >> 9) & 1) << 5); R = (st >> 1) * 16 + swz / 64; C = (st & 1) * 32 + (swz % 64) / 2; }
struct Unit { int pm, pn; };
struct Gemm { const bf16* A; const bf16* Bt; int M, N, K; };
struct StaticOrder {
    int nM, nN, nwg, G, c;
    __device__ void init(int M_, int N_, int G_, int c_) { nM = M_ / BM; nN = N_ / BM; nwg = nM * nN; G = G_; c = c_; }
    __device__ bool next(int i, Unit& u) const {
        const long L = (long)i * G + c; if (L >= nwg) return false;
        int wgid = (int)L; { const int q = nwg / NXCD, r = nwg % NXCD, xcd = wgid % NXCD, off = wgid / NXCD; wgid = (xcd < r ? xcd * (q + 1) : r * (q + 1) + (xcd - r) * q) + off; }
        const int nig = WGM * nN, gid = wgid / nig, fm = gid * WGM, gsz = (nM - fm) < WGM ? (nM - fm) : WGM;
        u.pm = fm + ((wgid % nig) % gsz); u.pn = (wgid % nig) / gsz; return true;
    }
};
template <class Epi, bool ALIGN_EPI, bool SP2>
__device__ __forceinline__ void gemm_phase(LAS unsigned char* lds, const Gemm g, const StaticOrder& S, const Epi& E) {
    int tid_ = threadIdx.x; asm volatile("" : "+v"(tid_));
    const int tid = tid_, wid = __builtin_amdgcn_readfirstlane(tid >> 6), lane = tid & 63, wr = wid >> 2, wc = wid & 3, fr = lane & 15, fq = lane >> 4;
    const int K = g.K, nt = K / BK;
    unsigned voff[2];
#pragma unroll
    for (int i = 0; i < 2; ++i) { int R, C; stage_rc(tid * 16 + i * 8192, R, C); voff[i] = (unsigned)(R * K + C) * 2u; }
    const size_t kstep = (size_t)(BK * 2), hstep = (size_t)HALF * K * 2, tstep = 2 * hstep;
    const unsigned ldsw = (unsigned)wid * 1024u;
    const int aoff = lds_byte(wr * 64 + fr, fq * 8), boff = lds_byte(wc * 32 + fr, fq * 8);
#define PG8_SA(b, h) (((b) * 2 + (h)) * HTB)
#define PG8_SB(b, h) ((4 + (b) * 2 + (h)) * HTB)
#define PG8_STAGE(bufoff, gbase) do { _Pragma("unroll") for (int _i = 0; _i < 2; ++_i) \
        __builtin_amdgcn_global_load_lds((const unsigned*)((const char*)(gbase) + voff[_i]), (LAS unsigned*)(lds + (bufoff) + ldsw + _i * 8192), 16, 0, 0); } while (0)
#define PG8_LDA(dst, b, h) do { _Pragma("unroll") for (int m = 0; m < 4; ++m) _Pragma("unroll") for (int k = 0; k < 2; ++k) dst[m][k] = *(const LAS bf16x8*)(lds + PG8_SA(b, h) + aoff + m * 2048 + k * 1024); } while (0)
#define PG8_LDB(dst, b, h) do { _Pragma("unroll") for (int n = 0; n < 2; ++n) _Pragma("unroll") for (int k = 0; k < 2; ++k) dst[n][k] = *(const LAS bf16x8*)(lds + PG8_SB(b, h) + boff + n * 2048 + k * 1024); } while (0)
#define PG8_MMA(ai, bj, At, Bt) do { __builtin_amdgcn_s_setprio(1); _Pragma("unroll") for (int m = 0; m < 4; ++m) _Pragma("unroll") for (int n = 0; n < 2; ++n) _Pragma("unroll") for (int k = 0; k < 2; ++k) \
        acc[ai][bj][m][n] = __builtin_amdgcn_mfma_f32_16x16x32_bf16(Bt[n][k], At[m][k], acc[ai][bj][m][n], 0, 0, 0); __builtin_amdgcn_s_setprio(0); } while (0)
#define PG8_WAIT_V(n) asm volatile("s_waitcnt vmcnt(" #n ")" ::: "memory")
#define PG8_WAIT_L(n) asm volatile("s_waitcnt lgkmcnt(" #n ")" ::: "memory")
#define PG8_BAR __builtin_amdgcn_s_barrier()
#define PG8_SCHED __builtin_amdgcn_sched_barrier(0)
    Unit cur, nxt; int ui = 0;
    if (!S.next(0, cur)) return;
    f32x4 acc[2][2][4][2];
#pragma unroll
    for (int a = 0; a < 2; ++a)
#pragma unroll
        for (int b = 0; b < 2; ++b)
#pragma unroll
            for (int m = 0; m < 4; ++m)
#pragma unroll
                for (int n = 0; n < 2; ++n) acc[a][b][m][n] = (f32x4){0.f, 0.f, 0.f, 0.f};
    bf16x8 At[4][2], B0[2][2], B1[2][2];
    const char* cA = (const char*)g.A + (size_t)cur.pm * tstep; const char* cB = (const char*)g.Bt + (size_t)cur.pn * tstep;
    if constexpr (SP2) {
        PG8_STAGE(PG8_SB(0, 0), cB); PG8_STAGE(PG8_SB(0, 1), cB + hstep); PG8_STAGE(PG8_SA(0, 0), cA); PG8_STAGE(PG8_SA(0, 1), cA + hstep);
        if (wr == 1) PG8_BAR;
        PG8_WAIT_V(2); PG8_BAR;
        PG8_STAGE(PG8_SB(1, 0), cB + kstep); PG8_STAGE(PG8_SA(1, 0), cA + kstep); PG8_STAGE(PG8_SB(1, 1), cB + hstep + kstep);
        PG8_WAIT_V(6); PG8_BAR;
    } else {
        PG8_STAGE(PG8_SB(0, 0), cB); PG8_STAGE(PG8_SA(0, 0), cA); PG8_STAGE(PG8_SB(0, 1), cB + hstep); PG8_STAGE(PG8_SA(0, 1), cA + hstep);
        if (wr == 1) PG8_BAR;
        PG8_WAIT_V(4); PG8_BAR;
        PG8_STAGE(PG8_SB(1, 0), cB + kstep); PG8_STAGE(PG8_SA(1, 0), cA + kstep); PG8_STAGE(PG8_SB(1, 1), cB + hstep + kstep);
        PG8_WAIT_V(6); PG8_BAR;
    }
    for (;;) {
        const bool has_next = S.next(ui + 1, nxt);
        const char* nA = has_next ? (const char*)g.A + (size_t)nxt.pm * tstep : cA; const char* nB = has_next ? (const char*)g.Bt + (size_t)nxt.pn * tstep : cB;
        for (int t = 0; t < nt; t += 2) {
            const bool last = (t == nt - 2);
            const char* a1 = cA + (size_t)(t + 1) * kstep;
            const char* a2 = last ? nA : cA + (size_t)(t + 2) * kstep; const char* b2 = last ? nB : cB + (size_t)(t + 2) * kstep;
            const char* a3 = a2 + kstep; const char* b3 = b2 + kstep;
            if constexpr (SP2) {
            PG8_LDB(B0, 0, 0); PG8_LDB(B1, 0, 1); PG8_SCHED; PG8_LDA(At, 0, 0); PG8_STAGE(PG8_SA(1, 1), a1 + hstep);
            PG8_WAIT_V(8); PG8_WAIT_L(0); PG8_BAR; PG8_MMA(0, 0, At, B0); PG8_MMA(0, 1, At, B1); PG8_BAR; PG8_SCHED;
            PG8_LDA(At, 0, 1); PG8_STAGE(PG8_SB(0, 0), b2); PG8_STAGE(PG8_SB(0, 1), b2 + hstep); PG8_STAGE(PG8_SA(0, 0), a2);
            PG8_WAIT_V(8); PG8_WAIT_L(0); PG8_BAR; PG8_MMA(1, 0, At, B0); PG8_MMA(1, 1, At, B1); PG8_BAR; PG8_SCHED;
            PG8_LDB(B0, 1, 0); PG8_LDB(B1, 1, 1); PG8_SCHED; PG8_LDA(At, 1, 0); PG8_STAGE(PG8_SA(0, 1), a2 + hstep);
            PG8_WAIT_V(8); PG8_WAIT_L(0); PG8_BAR; PG8_MMA(0, 0, At, B0); PG8_MMA(0, 1, At, B1); PG8_BAR; PG8_SCHED;
            PG8_LDA(At, 1, 1); PG8_STAGE(PG8_SB(1, 0), b3); PG8_STAGE(PG8_SB(1, 1), b3 + hstep); PG8_STAGE(PG8_SA(1, 0), a3);
            PG8_WAIT_V(8); PG8_WAIT_L(0); PG8_BAR; PG8_MMA(1, 0, At, B0); PG8_MMA(1, 1, At, B1); PG8_BAR; PG8_SCHED;
            } else {
            PG8_LDB(B0, 0, 0); PG8_SCHED; PG8_LDA(At, 0, 0); PG8_STAGE(PG8_SA(1, 1), a1 + hstep);
            PG8_WAIT_L(8); PG8_BAR; PG8_WAIT_L(0); PG8_MMA(0, 0, At, B0); PG8_BAR; PG8_SCHED;
            PG8_LDB(B1, 0, 1); PG8_STAGE(PG8_SB(0, 0), b2);
            PG8_BAR; PG8_WAIT_L(0); PG8_MMA(0, 1, At, B1); PG8_BAR;
            PG8_LDA(At, 0, 1); PG8_STAGE(PG8_SA(0, 0), a2);
            PG8_BAR; PG8_WAIT_L(0); PG8_MMA(1, 0, At, B0); PG8_BAR; PG8_SCHED;
            PG8_STAGE(PG8_SB(0, 1), b2 + hstep);
            PG8_WAIT_V(6); PG8_BAR; PG8_MMA(1, 1, At, B1); PG8_BAR;
            PG8_LDB(B0, 1, 0); PG8_SCHED; PG8_LDA(At, 1, 0); PG8_STAGE(PG8_SA(0, 1), a2 + hstep);
            PG8_WAIT_L(8); PG8_BAR; PG8_WAIT_L(0); PG8_MMA(0, 0, At, B0); PG8_BAR; PG8_SCHED;
            PG8_LDB(B1, 1, 1); PG8_STAGE(PG8_SB(1, 0), b3);
            PG8_BAR; PG8_WAIT_L(0); PG8_MMA(0, 1, At, B1); PG8_BAR;
            PG8_LDA(At, 1, 1); PG8_STAGE(PG8_SA(1, 0), a3);
            PG8_BAR; PG8_WAIT_L(0); PG8_MMA(1, 0, At, B0); PG8_BAR; PG8_SCHED;
            PG8_STAGE(PG8_SB(1, 1), b3 + hstep);
            PG8_WAIT_V(6); PG8_BAR; PG8_MMA(1, 1, At, B1); PG8_BAR;
            }
        }
        if constexpr (ALIGN_EPI) { if (wr == 0) PG8_BAR; }
        E(acc, cur, wr, wc, fr, fq);
        if (!has_next) break;
#pragma unroll
        for (int a = 0; a < 2; ++a)
#pragma unroll
            for (int b = 0; b < 2; ++b)
#pragma unroll
                for (int m = 0; m < 4; ++m)
#pragma unroll
                    for (int n = 0; n < 2; ++n) acc[a][b][m][n] = (f32x4){0.f, 0.f, 0.f, 0.f};
        cur = nxt; cA = nA; cB = nB; ++ui;
        if constexpr (ALIGN_EPI) { if (wr == 1) PG8_BAR; }
    }
    PG8_WAIT_V(0);
    if constexpr (!ALIGN_EPI) { if (wr == 0) PG8_BAR; }
    PG8_BAR;
#undef PG8_SA
#undef PG8_SB
#undef PG8_STAGE
#undef PG8_LDA
#undef PG8_LDB
#undef PG8_MMA
#undef PG8_WAIT_V
#undef PG8_WAIT_L
#undef PG8_BAR
#undef PG8_SCHED
}

typedef f32x4 Acc[2][2][4][2];
struct EpiFfnUp {
    bf16* H; const float* ss;
    __device__ __forceinline__ void operator()(const Acc& acc, const Unit& u, int wr, int wc, int fr, int fq) const {
        const int row0 = u.pm * BM + wr * 64 + fr, col0 = u.pn * 128 + wc * 32 + 8 * fq;
        float rr[2][4];
#pragma unroll
        for (int ai = 0; ai < 2; ++ai)
#pragma unroll
            for (int m = 0; m < 4; ++m) rr[ai][m] = ss[row0 + ai * HALF + m * 16];
#pragma unroll
        for (int ai = 0; ai < 2; ++ai)
#pragma unroll
            for (int m = 0; m < 4; ++m) { const int row = row0 + ai * HALF + m * 16; const float r = __builtin_amdgcn_rsqf(rr[ai][m] * (1.f / DM) + EPS); float h[8];
#pragma unroll
                for (int n = 0; n < 2; ++n)
#pragma unroll
                    for (int j = 0; j < 4; ++j) { const float zg = r * acc[ai][0][m][n][j], zu = r * acc[ai][1][m][n][j]; h[4 * n + j] = zg * fast_sigmoid(zg) * zu; }
                u32x4 w; w.x = cvt_pk_bf16(h[0], h[1]); w.y = cvt_pk_bf16(h[2], h[3]); w.z = cvt_pk_bf16(h[4], h[5]); w.w = cvt_pk_bf16(h[6], h[7]);
                *(u32x4*)(H + (size_t)row * FF + col0) = w; }
    }
};
struct EpiResid {
    const float* base; float* out; bf16* xb; float* ss; float alpha;
    __device__ __forceinline__ void operator()(const Acc& acc, const Unit& u, int wr, int wc, int fr, int fq) const {
        const int row0 = u.pm * BM + wr * 64 + fr, col0 = u.pn * BM + wc * 64 + 8 * fq;
#pragma unroll
        for (int ai = 0; ai < 2; ++ai) {
            f32x4 bs[4][2][2];
#pragma unroll
            for (int m = 0; m < 4; ++m)
#pragma unroll
                for (int bj = 0; bj < 2; ++bj) { const size_t o = (size_t)(row0 + ai * HALF + m * 16) * DM + col0 + bj * 32; bs[m][bj][0] = *(const f32x4*)(base + o); bs[m][bj][1] = *(const f32x4*)(base + o + 4); }
#pragma unroll
            for (int m = 0; m < 4; ++m) { const int row = row0 + ai * HALF + m * 16; float part = 0.f;
#pragma unroll
                for (int bj = 0; bj < 2; ++bj) { const size_t o = (size_t)row * DM + col0 + bj * 32;
                    const f32x4 v0 = bs[m][bj][0] + alpha * acc[ai][bj][m][0], v1 = bs[m][bj][1] + alpha * acc[ai][bj][m][1];
                    *(f32x4*)(out + o) = v0; *(f32x4*)(out + o + 4) = v1;
                    if (xb) { u32x4 w; w.x = cvt_pk_bf16(v0[0], v0[1]); w.y = cvt_pk_bf16(v0[2], v0[3]); w.z = cvt_pk_bf16(v1[0], v1[1]); w.w = cvt_pk_bf16(v1[2], v1[3]); *(u32x4*)(xb + o) = w; }
                    part += (v0[0] * v0[0] + v0[1] * v0[1]) + (v0[2] * v0[2] + v0[3] * v0[3]) + (v1[0] * v1[0] + v1[1] * v1[1]) + (v1[2] * v1[2] + v1[3] * v1[3]); }
                if (ss) { part += __shfl_xor(part, 16); part += __shfl_xor(part, 32); if (fq == 0) atomicAdd(ss + row, part); } }
            asm volatile("" ::: "memory"); }
    }
};
struct EpiWin {
    bf16 *QKV, *G; const float *ss, *bg, *naq, *nak, *swq, *swk;
    __device__ __forceinline__ void operator()(const Acc& acc, const Unit& u, int wr, int wc, int fr, int fq) const {
        const int hg = __builtin_amdgcn_readfirstlane(4 * u.pn + wc);
        const int row0 = u.pm * BM + wr * 64 + fr;
        const float* gain = hg < 8 ? naq : hg < 16 ? nak : (hg >= 24 && hg < 32) ? swq : (hg >= 32 && hg < 34) ? swk : nullptr;
        const float qs = (hg < 8 || (hg >= 24 && hg < 32)) ? 0.125f : 1.f;
        const bool gate = hg >= 36;
        f32x4 gv[2][2];
#pragma unroll
        for (int bj = 0; bj < 2; ++bj)
#pragma unroll
            for (int n = 0; n < 2; ++n) { const int d = 32 * bj + 8 * fq + 4 * n;
                gv[bj][n] = gate ? *(const f32x4*)(bg + 64 * (hg - 36) + d) : gain ? *(const f32x4*)(gain + d) : (f32x4){1.f, 1.f, 1.f, 1.f}; }
        float rr[2][4];
#pragma unroll
        for (int ai = 0; ai < 2; ++ai)
#pragma unroll
            for (int m = 0; m < 4; ++m) rr[ai][m] = ss[row0 + ai * HALF + m * 16];
#pragma unroll
        for (int ai = 0; ai < 2; ++ai)
#pragma unroll
            for (int m = 0; m < 4; ++m) { const int row = row0 + ai * HALF + m * 16; const float r = __builtin_amdgcn_rsqf(rr[ai][m] * (1.f / DM) + EPS);
                f32x4 z[2][2]; float q = 0.f;
#pragma unroll
                for (int bj = 0; bj < 2; ++bj)
#pragma unroll
                    for (int n = 0; n < 2; ++n) { z[bj][n] = r * acc[ai][bj][m][n]; const f32x4 t = z[bj][n]; q += (t[0] * t[0] + t[1] * t[1]) + (t[2] * t[2] + t[3] * t[3]); }
                if (gate) {
#pragma unroll
                    for (int bj = 0; bj < 2; ++bj)
#pragma unroll
                        for (int n = 0; n < 2; ++n)
#pragma unroll
                            for (int j = 0; j < 4; ++j) z[bj][n][j] = fast_sigmoid(z[bj][n][j] + gv[bj][n][j]);
                } else if (gain) {
                    q += __shfl_xor(q, 16); q += __shfl_xor(q, 32);
                    const float hn = __builtin_amdgcn_rsqf(q * (1.f / 64.f) + EPS) * qs;
#pragma unroll
                    for (int bj = 0; bj < 2; ++bj)
#pragma unroll
                        for (int n = 0; n < 2; ++n) z[bj][n] = z[bj][n] * hn * gv[bj][n];
                }
                bf16* dst = gate ? G + (size_t)row * NG + 64 * (hg - 36) + 8 * fq : QKV + (size_t)row * NQKV + 64 * hg + 8 * fq;
#pragma unroll
                for (int bj = 0; bj < 2; ++bj) { u32x4 w; w.x = cvt_pk_bf16(z[bj][0][0], z[bj][0][1]); w.y = cvt_pk_bf16(z[bj][0][2], z[bj][0][3]); w.z = cvt_pk_bf16(z[bj][1][0], z[bj][1][1]); w.w = cvt_pk_bf16(z[bj][1][2], z[bj][1][3]);
                    *(u32x4*)(dst + 32 * bj) = w; } }
    }
};
template <int SECOND> struct EpiBranch {
    bf16 *T, *MRG; const bf16* G;
    __device__ __forceinline__ void operator()(const Acc& acc, const Unit& u, int wr, int wc, int fr, int fq) const {
        const int row0 = u.pm * BM + wr * 64 + fr, col0 = u.pn * BM + wc * 64 + 8 * fq;
#pragma unroll
        for (int ai = 0; ai < 2; ++ai) {
            u32x4 gw[4][2], tw[4][2];
#pragma unroll
            for (int m = 0; m < 4; ++m)
#pragma unroll
                for (int bj = 0; bj < 2; ++bj) { const int row = row0 + ai * HALF + m * 16, c = col0 + 32 * bj;
                    gw[m][bj] = *(const u32x4*)(G + (size_t)row * NG + SECOND * DM + c);
                    tw[m][bj] = (u32x4){0u, 0u, 0u, 0u}; if (SECOND) tw[m][bj] = *(const u32x4*)(T + (size_t)row * DM + c); }
#pragma unroll
            for (int m = 0; m < 4; ++m)
#pragma unroll
                for (int bj = 0; bj < 2; ++bj) { const size_t o = (size_t)(row0 + ai * HALF + m * 16) * DM + col0 + 32 * bj;
                    float v[8];
#pragma unroll
                    for (int e = 0; e < 8; ++e) { const unsigned gq = gw[m][bj][e >> 1], tq = tw[m][bj][e >> 1];
                        const unsigned gbits = (e & 1) ? (gq & 0xffff0000u) : (gq << 16), tbits = (e & 1) ? (tq & 0xffff0000u) : (tq << 16);
                        v[e] = __builtin_bit_cast(float, tbits) + __builtin_bit_cast(float, gbits) * acc[ai][bj][m][e >> 2][e & 3]; }
                    u32x4 w; w.x = cvt_pk_bf16(v[0], v[1]); w.y = cvt_pk_bf16(v[2], v[3]); w.z = cvt_pk_bf16(v[4], v[5]); w.w = cvt_pk_bf16(v[6], v[7]);
                    *(u32x4*)((SECOND ? MRG : T) + o) = w; }
            asm volatile("" ::: "memory"); }
    }
};
}

#define XB_TMO      128
#define XB_XCNT(j)  (256  + 64 * (j))
#define XB_XSUB(j)  (1280 + 64 * (j))
#define XB_XGEN(j)  (2304 + 64 * (j))
#define XB_TOP      3328
#define XB_TOPGEN   3392
#define XCD_BAR_WORDS 3456
#define XB_SPIN_CAP (1u << 18)
__device__ __forceinline__ unsigned xb_ld(unsigned* p)              { return __hip_atomic_load(p, __ATOMIC_RELAXED, __HIP_MEMORY_SCOPE_AGENT); }
__device__ __forceinline__ unsigned xb_add(unsigned* p, unsigned v) { return __hip_atomic_fetch_add(p, v, __ATOMIC_RELAXED, __HIP_MEMORY_SCOPE_AGENT); }
__device__ __forceinline__ unsigned xb_xcc_id() { return (unsigned)__builtin_amdgcn_s_getreg((3 << 11) | 20) & 0xFu; }
#define XB_SPIN(cond, bar) do { unsigned _sp = 0; while (cond) { __builtin_amdgcn_s_sleep(1); \
    if ((++_sp & 255u) == 0u) { if (xb_ld(&(bar)[XB_TMO])) break; if (_sp > XB_SPIN_CAP) { atomicAdd(&(bar)[XB_TMO], 1u); break; } } } } while (0)
struct XcdBarrier { unsigned* bar; unsigned x; volatile LAS unsigned* st; };
__device__ __forceinline__ XcdBarrier xcd_barrier_post(unsigned* bar, volatile LAS unsigned* st) {
    XcdBarrier b; b.bar = bar; b.x = xb_xcc_id(); b.st = st;
    if (threadIdx.x == 0) (void)xb_add(&bar[XB_XCNT(b.x)], 1u);
    return b;
}
__device__ __forceinline__ void xcd_barrier_complete(unsigned* bar, unsigned x, unsigned& nloc, unsigned& nx) {
    const unsigned G = gridDim.x * gridDim.y * gridDim.z;
    unsigned sum, cnt, mine, sp = 0u;
    for (;;) {
        sum = 0u; cnt = 0u; mine = 0u;
#pragma unroll
        for (unsigned j = 0; j < 16; ++j) { const unsigned c = xb_ld(&bar[XB_XCNT(j)]); sum += c; cnt += (c > 0u) ? 1u : 0u; mine = (j == x) ? c : mine; }
        if (sum == G) break;
        __builtin_amdgcn_s_sleep(1);
        if ((++sp & 255u) == 0u) { if (xb_ld(&bar[XB_TMO])) break; if (sp > XB_SPIN_CAP) { atomicAdd(&bar[XB_TMO], 1u); break; } }
    }
    nloc = mine > 0u ? mine : 1u; nx = cnt > 0u ? cnt : 1u;
}
__device__ __forceinline__ void xcd_barrier(const XcdBarrier& b) {
    asm volatile("s_waitcnt vmcnt(0)" ::: "memory");
    __syncthreads();
    if (threadIdx.x == 0) {
        unsigned* bar = b.bar;
        __builtin_amdgcn_s_waitcnt(0);
        unsigned nloc = b.st[0], nx = b.st[1];
        if (nloc == 0u) { xcd_barrier_complete(bar, b.x, nloc, nx); b.st[0] = nloc; b.st[1] = nx; }
        const unsigned old = xb_add(&bar[XB_XSUB(b.x)], 1u);
        const unsigned gen = old / nloc;
        if (old + 1u == (gen + 1u) * nloc) {
            __builtin_amdgcn_fence(__ATOMIC_RELEASE, "agent");
            asm volatile("s_waitcnt vmcnt(0)" ::: "memory");
            const unsigned og = xb_add(&bar[XB_TOP], 1u);
            const unsigned tg = og / nx;
            if (og + 1u == (tg + 1u) * nx) xb_add(&bar[XB_TOPGEN], 1u);
            else XB_SPIN(xb_ld(&bar[XB_TOPGEN]) == tg, bar);
            __builtin_amdgcn_fence(__ATOMIC_ACQUIRE, "agent");
            xb_add(&bar[XB_XGEN(b.x)], 1u);
            asm volatile("s_waitcnt vmcnt(0)" ::: "memory");
        } else {
            XB_SPIN(xb_ld(&bar[XB_XGEN(b.x)]) == gen, bar);
            __builtin_amdgcn_fence(__ATOMIC_ACQUIRE, "agent");
            asm volatile("s_waitcnt vmcnt(0)" ::: "memory");
        }
    }
    __syncthreads();
}

__device__ __forceinline__ unsigned pk2(float lo, float hi) { return f2bf(lo) | (f2bf(hi) << 16); }
__device__ __forceinline__ int perm32(int rho) { const int n = rho >> 4, i = rho & 15; return 8 * (i >> 2) + 4 * n + (i & 3); }
__device__ __forceinline__ void prep_item(const float* W, int ldw, int cbase, const float* gn, bf16* WT, int K, int rbase, int k0, LAS float* scr, int lane) {
#pragma unroll 8
    for (int i = 0; i < 32; ++i) { const int kk = 2 * i + (lane >> 5); const float g = gn ? gn[k0 + kk] : 1.f; scr[kk * 33 + (lane & 31)] = g * W[(size_t)(k0 + kk) * ldw + cbase + (lane & 31)]; }
    asm volatile("s_waitcnt lgkmcnt(0)" ::: "memory");
    const int c = lane & 7;
#pragma unroll
    for (int j = 0; j < 4; ++j) { const int rr = (lane >> 3) + 8 * j; const LAS float* s = scr + (8 * c) * 33 + perm32(rr);
        u32x4 o; o.x = pk2(s[0 * 33], s[1 * 33]); o.y = pk2(s[2 * 33], s[3 * 33]); o.z = pk2(s[4 * 33], s[5 * 33]); o.w = pk2(s[6 * 33], s[7 * 33]);
        *(u32x4*)(WT + (size_t)(rbase + rr) * K + k0 + 8 * c) = o; }
    asm volatile("s_waitcnt lgkmcnt(0)" ::: "memory");
}
__device__ __forceinline__ void prep_head(const float* W, int K, int N, const float* gn, bf16* WT, int it, LAS float* scr, int lane) {
    const int nsg = N / 32, kb = it / nsg, sg = it % nsg, pn = sg >> 3, bj = (sg >> 2) & 1, wc = sg & 3;
    prep_item(W, N, 256 * pn + 64 * wc + 32 * bj, gn, WT, K, 32 * sg, 64 * kb, scr, lane);
}
__device__ __forceinline__ void prep_gateup(const float* Wg, const float* Wu, const float* gn, bf16* WT, int it, LAS float* scr, int lane) {
    const int nsg = 2 * FF / 32, kb = it / nsg, sg = it % nsg, pn = sg >> 3, bj = (sg >> 2) & 1, wc = sg & 3;
    prep_item(bj ? Wu : Wg, FF, 128 * pn + 32 * wc, gn, WT, DM, 32 * sg, 64 * kb, scr, lane);
}
__device__ __forceinline__ float wave_sum64(float v) {
#pragma unroll
    for (int o = 1; o < 64; o <<= 1) v += __shfl_xor(v, o);
    return v;
}

__device__ __forceinline__ bf16x8 tr_pair(const LAS unsigned char* p0, const LAS unsigned char* p1) {
    typedef short v4i16 __attribute__((ext_vector_type(4)));
    const v4i16 lo = __builtin_amdgcn_ds_read_tr16_b64_v4i16((LAS v4i16*)p0), hi = __builtin_amdgcn_ds_read_tr16_b64_v4i16((LAS v4i16*)p1);
    return (bf16x8){lo[0], lo[1], lo[2], lo[3], hi[0], hi[1], hi[2], hi[3]};
}
__device__ __forceinline__ int fK(int key) { return ((key >> 1) & 1) | (((key >> 3) & 3) << 1); }
__device__ __forceinline__ int fV(int key) { return ((key >> 1) & 1) | (((key >> 3) & 1) << 1); }

template <int NS> __device__ __forceinline__ float softmax_pack(f32x4 (&S)[NS][2], bf16x8 (&pk)[NS], bool has_sink, float sink) {
    float mx = has_sink ? sink : -3.0e38f;
#pragma unroll
    for (int s = 0; s < NS; ++s)
#pragma unroll
        for (int hb = 0; hb < 2; ++hb) mx = fmaxf(mx, fmaxf(fmaxf(S[s][hb][0], S[s][hb][1]), fmaxf(S[s][hb][2], S[s][hb][3])));
    mx = fmaxf(mx, __shfl_xor(mx, 16)); mx = fmaxf(mx, __shfl_xor(mx, 32));
    const float mb = mx * 1.4426950408889634f; float l = 0.f;
#pragma unroll
    for (int s = 0; s < NS; ++s) {
#pragma unroll
        for (int hb = 0; hb < 2; ++hb)
#pragma unroll
            for (int j = 0; j < 4; ++j) { const float e = __builtin_amdgcn_exp2f(S[s][hb][j] * 1.4426950408889634f - mb); S[s][hb][j] = e; l += e; }
        u32x4 w; w.x = cvt_pk_bf16(S[s][0][0], S[s][0][1]); w.y = cvt_pk_bf16(S[s][0][2], S[s][0][3]); w.z = cvt_pk_bf16(S[s][1][0], S[s][1][1]); w.w = cvt_pk_bf16(S[s][1][2], S[s][1][3]);
        pk[s] = __builtin_bit_cast(bf16x8, w);
    }
    l += __shfl_xor(l, 16); l += __shfl_xor(l, 32);
    if (has_sink) l += __builtin_amdgcn_exp2f(sink * 1.4426950408889634f - mb);
    return 1.f / l;
}

constexpr int SW_K_OFF = 0, SW_V_OFF = 49152, SW_LUT_OFF = 98304, SW_LUT_LD = 512;
__device__ __forceinline__ void swa_unit(LAS unsigned char* lds, int b, int g, int nb, const bf16* QKV, const float* t5, const float* sink, bf16* OSW) {
    int tid_ = threadIdx.x; asm volatile("" : "+v"(tid_));
    const int tid = tid_, lane = tid & 63, wid = __builtin_amdgcn_readfirstlane(tid >> 6), fr = lane & 15, fq = lane >> 4;
#pragma unroll
    for (int i = 0; i < 6; ++i) { const int cid = tid + NTHREADS * i, key = cid >> 3, c = cid & 7, kp = 128 * (nb - 1) + key; const bool ok = kp >= 0 && kp < SEQ;
        const bf16* src = QKV + (size_t)(b * SEQ + (ok ? kp : 0)) * NQKV + 64 * g + 8 * c;
        u32x4 kv = (u32x4){0u, 0u, 0u, 0u}, vv = kv; if (ok) { kv = *(const u32x4*)(src + 2048); vv = *(const u32x4*)(src + 2176); }
        *(LAS u32x4*)(lds + SW_K_OFF + key * 128 + ((c ^ fK(key)) << 4)) = kv;
        *(LAS u32x4*)(lds + SW_V_OFF + key * 128 + (((c >> 1) ^ fV(key)) << 5) + ((c & 1) << 4)) = vv; }
    for (int idx = tid; idx < 4 * 512; idx += NTHREADS) { const int hh = idx >> 9, rel = (idx & 511) - 255;
        ((LAS float*)(lds + SW_LUT_OFF))[idx] = (rel >= -128 && rel <= 128) ? t5[slow::t5_bucket(rel) * 8 + 4 * g + hh] : NEGV; }
    __syncthreads();
    const int fKl = ((fr >> 1) & 1) | ((fr >> 2) << 1);
    const LAS unsigned char* kb0 = lds + SW_K_OFF + (8 * (fr >> 2) + (fr & 3)) * 128 + ((fq ^ fKl) << 4);
    const LAS unsigned char* kb1 = lds + SW_K_OFF + (8 * (fr >> 2) + (fr & 3)) * 128 + (((4 + fq) ^ fKl) << 4);
    const int q4 = (lane & 15) >> 2, p4 = lane & 3, fVl = ((q4 >> 1) & 1) | ((fq & 1) << 1);
    const LAS unsigned char* vb = lds + SW_V_OFF + (8 * fq + q4) * 128 + p4 * 8;
    const int relbase = 8 * fq - 128 - 16 * wid - fr + 255;
    const bool first_bad = (nb == 0), last_bad = (nb == SEQ / 128 - 1);
    const size_t tokq = (size_t)b * SEQ + 128 * nb + 16 * wid + fr;
    for (int hh = 0; hh < 4; ++hh) {
        const int h = 4 * g + hh;
        const bf16x8 q0 = *(const bf16x8*)(QKV + tokq * NQKV + 1536 + 64 * h + 8 * fq), q1 = *(const bf16x8*)(QKV + tokq * NQKV + 1536 + 64 * h + 32 + 8 * fq);
        const LAS float* lut = (const LAS float*)(lds + SW_LUT_OFF) + hh * SW_LUT_LD + relbase;
        f32x4 S[12][2]; bf16x8 pk[12];
#pragma unroll
        for (int s = 0; s < 12; ++s) {
            const bool bad = (s < 4 && first_bad) || (s >= 8 && last_bad);
#pragma unroll
            for (int hb = 0; hb < 2; ++hb) { const bf16x8 k0 = *(const LAS bf16x8*)(kb0 + s * 4096 + hb * 512), k1 = *(const LAS bf16x8*)(kb1 + s * 4096 + hb * 512);
                f32x4 a = (f32x4){0.f, 0.f, 0.f, 0.f}; a = __builtin_amdgcn_mfma_f32_16x16x32_bf16(k0, q0, a, 0, 0, 0); a = __builtin_amdgcn_mfma_f32_16x16x32_bf16(k1, q1, a, 0, 0, 0);
#pragma unroll
                for (int j = 0; j < 4; ++j) a[j] = bad ? NEGV : a[j] + lut[32 * s + 4 * hb + j];
                S[s][hb] = a; }
            if (s & 1) asm volatile("" ::: "memory"); }
        const float rl = softmax_pack<12>(S, pk, true, sink[h]);
        f32x4 O[4];
#pragma unroll
        for (int db = 0; db < 4; ++db) O[db] = (f32x4){0.f, 0.f, 0.f, 0.f};
#pragma unroll
        for (int s = 0; s < 12; ++s) {
#pragma unroll
            for (int db = 0; db < 4; ++db) { const LAS unsigned char* p = vb + s * 4096 + ((db ^ fVl) << 5); O[db] = __builtin_amdgcn_mfma_f32_16x16x32_bf16(tr_pair(p, p + 512), pk[s], O[db], 0, 0, 0); }
            if (s & 1) asm volatile("" ::: "memory"); }
        bf16* dst = OSW + tokq * 512 + 64 * h + 4 * fq;
#pragma unroll
        for (int db = 0; db < 4; ++db) { u32x2 w; w.x = cvt_pk_bf16(O[db][0] * rl, O[db][1] * rl); w.y = cvt_pk_bf16(O[db][2] * rl, O[db][3] * rl); *(u32x2*)(dst + 16 * db) = w; }
    }
    __syncthreads();
}

constexpr int NA_V_OFF = 0, NA_TAB_OFF = 122880;
__device__ __forceinline__ int na_rowstart(int r) { int rs = r - 4; return rs < 0 ? 0 : (rs > ROWS - 8 ? ROWS - 8 : rs); }
__device__ __forceinline__ void na_unit(LAS unsigned char* lds, int b, int h, int rq, const bf16* QKV, const float* rpb, bf16* ONA) {
    int tid_ = threadIdx.x; asm volatile("" : "+v"(tid_));
    const int tid = tid_, lane = tid & 63, wid = __builtin_amdgcn_readfirstlane(tid >> 6), fr = lane & 15, fq = lane >> 4;
    const int kr_lo = na_rowstart(8 * rq), kr_hi = na_rowstart(8 * rq + 7) + 7, nkeys = (kr_hi - kr_lo + 1) * GRID_W;
    for (int cid = tid; cid < nkeys * 8; cid += NTHREADS) { const int key = cid >> 3, c = cid & 7;
        const u32x4 vv = *(const u32x4*)(QKV + (size_t)(b * SEQ + kr_lo * GRID_W + key) * NQKV + 1024 + 64 * h + 8 * c);
        *(LAS u32x4*)(lds + NA_V_OFF + key * 128 + (((c >> 1) ^ fV(key)) << 5) + ((c & 1) << 4)) = vv; }
    for (int idx = tid; idx < 15 * 31; idx += NTHREADS) ((LAS float*)(lds + NA_TAB_OFF))[idx] = rpb[h * 465 + idx];
    __syncthreads();
    const LAS float* tab = (const LAS float*)(lds + NA_TAB_OFF);
    const int q4 = (lane & 15) >> 2, p4 = lane & 3;
    for (int i = 0; i < 4; ++i) {
        const int p = wid + 8 * i, r = 8 * rq + (p >> 2), cb = p & 3, rs = na_rowstart(r);
        int kcs = 16 * cb - 8; kcs = kcs < 0 ? 0 : (kcs > 32 ? 32 : kcs);
        const int qcol = 16 * cb + fr; int qcs = qcol - 8; qcs = qcs < 0 ? 0 : (qcs > 48 ? 48 : qcs);
        const size_t tokq = (size_t)b * SEQ + r * GRID_W + qcol;
        const bf16x8 q0 = *(const bf16x8*)(QKV + tokq * NQKV + 64 * h + 8 * fq), q1 = *(const bf16x8*)(QKV + tokq * NQKV + 64 * h + 32 + 8 * fq);
        const bf16* kbase = QKV + ((size_t)b * SEQ + rs * GRID_W + kcs + 8 * (fr >> 2) + (fr & 3)) * NQKV + 512 + 64 * h + 8 * fq;
        f32x4 S[8][2]; bf16x8 pk[8];
#pragma unroll
        for (int s = 0; s < 8; ++s) {
#pragma unroll
            for (int hb = 0; hb < 2; ++hb) { const bf16* kp = kbase + (size_t)(s * GRID_W + 4 * hb) * NQKV; const bf16x8 k0 = *(const bf16x8*)kp, k1 = *(const bf16x8*)(kp + 32);
                f32x4 a = (f32x4){0.f, 0.f, 0.f, 0.f}; a = __builtin_amdgcn_mfma_f32_16x16x32_bf16(k0, q0, a, 0, 0, 0); a = __builtin_amdgcn_mfma_f32_16x16x32_bf16(k1, q1, a, 0, 0, 0);
                const int ri = rs + s - r + 7;
#pragma unroll
                for (int j = 0; j < 4; ++j) { const int kcol = kcs + 8 * fq + 4 * hb + j; const bool ok = kcol >= qcs && kcol < qcs + 16; int ci = kcol - qcol + 15; ci = ci < 0 ? 0 : (ci > 30 ? 30 : ci);
                    a[j] = ok ? a[j] + tab[ri * 31 + ci] : NEGV; }
                S[s][hb] = a; }
            if ((s & 3) == 3) asm volatile("" ::: "memory"); }
        const float rl = softmax_pack<8>(S, pk, false, 0.f);
        const int fVl = ((q4 >> 1) & 1) | ((((kcs >> 3) + fq) & 1) << 1);
        const LAS unsigned char* vb = lds + NA_V_OFF + ((rs - kr_lo) * GRID_W + kcs + 8 * fq + q4) * 128 + p4 * 8;
        f32x4 O[4];
#pragma unroll
        for (int db = 0; db < 4; ++db) O[db] = (f32x4){0.f, 0.f, 0.f, 0.f};
#pragma unroll
        for (int s = 0; s < 8; ++s) {
#pragma unroll
            for (int db = 0; db < 4; ++db) { const LAS unsigned char* pp = vb + s * (GRID_W * 128) + ((db ^ fVl) << 5); O[db] = __builtin_amdgcn_mfma_f32_16x16x32_bf16(tr_pair(pp, pp + 512), pk[s], O[db], 0, 0, 0); }
            if (s & 1) asm volatile("" ::: "memory"); }
        bf16* dst = ONA + tokq * 512 + 64 * h + 4 * fq;
#pragma unroll
        for (int db = 0; db < 4; ++db) { u32x2 w; w.x = cvt_pk_bf16(O[db][0] * rl, O[db][1] * rl); w.y = cvt_pk_bf16(O[db][2] * rl, O[db][3] * rl); *(u32x2*)(dst + 16 * db) = w; }
    }
    __syncthreads();
}

#ifndef PG8_SP2
#define PG8_SP2 true
#endif
#ifndef PG8_ALIGN
#define PG8_ALIGN true
#endif
#ifndef CODE_MASK
#define CODE_MASK 255
#endif
constexpr int N_PHASES = 9 * DEPTH;
struct Args { Inputs I; float* out; unsigned char* ws; int ph_lo, ph_hi, bar_region, pad; };

__global__ void __launch_bounds__(NTHREADS, 2) mega_fwd(Args args) {
    extern __shared__ __attribute__((aligned(16))) unsigned char lds_raw[];
    LAS unsigned char* lds = (LAS unsigned char*)lds_raw;
    volatile LAS unsigned* MISC = (volatile LAS unsigned*)(lds + MISC_OFF);
    const int tid = threadIdx.x, lane = tid & 63, wave = __builtin_amdgcn_readfirstlane(tid >> 6);
    const int G = gridDim.x, bx = blockIdx.x, vcu = (G % 8 == 0) ? (bx % 8) * (G / 8) + bx / 8 : bx;
    unsigned char* ws = args.ws;
    const Inputs& I = args.I;
    float* out = args.out;
    float* SS = (float*)(ws + WS_SS);
    bf16 *XB = (bf16*)(ws + WS_XB), *H = (bf16*)(ws + WS_H), *QKV = (bf16*)(ws + WS_QKV), *T = (bf16*)(ws + WS_T), *MRG = (bf16*)(ws + WS_MRG), *GT = (bf16*)(ws + WS_G),
         *ONA = (bf16*)(ws + WS_ONA), *OSW = (bf16*)(ws + WS_OSW);
    unsigned char* WB = ws + WS_W;
    for (int u = tid; u < (LDS_BYTES - RING_BYTES) / 4; u += NTHREADS) ((LAS unsigned*)(lds + RING_BYTES))[u] = 0u;
    __syncthreads();
    const int lo = args.ph_lo, hi = args.ph_hi;
    XcdBarrier bar; bar.bar = (unsigned*)(ws + WS_CTL) + 4096 + args.bar_region * XCD_BAR_WORDS; bar.x = 0; bar.st = nullptr;
    if (hi - lo > 1) bar = xcd_barrier_post(bar.bar, MISC + 8);

    for (int ph = lo; ph < hi; ++ph) {
        const int l = ph / 9, k = ph % 9;
        float* ss0 = SS + (size_t)(3 * l + 0) * M; float* ss1 = SS + (size_t)(3 * l + 1) * M; float* ss2 = SS + (size_t)(3 * l + 2) * M; float* ss3 = SS + (size_t)(3 * l + 3) * M;
        if (k == 0 && (CODE_MASK & 1)) {
            int lane_ = tid & 63; asm volatile("" : "+v"(lane_)); const int lane = lane_;
            LAS float* scr = (LAS float*)(lds + wave * 16384);
            const int gw = vcu * NWAVES + wave, NGW = G * NWAVES;
            constexpr int I_1C = (DM / 64) * (2 * FF / 32), I_1D = (FF / 64) * (DM / 32), I_IN = (DM / 64) * (INW / 32), I_P = (512 / 64) * (DM / 32), I_O = (DM / 64) * (DM / 32);
            constexpr int NITEMS = 2 * I_1C + 2 * I_1D + I_IN + 2 * I_P + I_O;
            for (int it = gw; it < NITEMS; it += NGW) {
                int r = it;
                if (r < I_1C) { prep_gateup(I.ffn1_wg + (size_t)l * DM * FF, I.ffn1_wu + (size_t)l * DM * FF, I.ffn1_norm + l * DM, (bf16*)(WB + WO_1C), r, scr, lane); continue; } r -= I_1C;
                if (r < I_1C) { prep_gateup(I.ffn2_wg + (size_t)l * DM * FF, I.ffn2_wu + (size_t)l * DM * FF, I.ffn2_norm + l * DM, (bf16*)(WB + WO_2C), r, scr, lane); continue; } r -= I_1C;
                if (r < I_1D) { prep_head(I.ffn1_wd + (size_t)l * FF * DM, FF, DM, nullptr, (bf16*)(WB + WO_1D), r, scr, lane); continue; } r -= I_1D;
                if (r < I_1D) { prep_head(I.ffn2_wd + (size_t)l * FF * DM, FF, DM, nullptr, (bf16*)(WB + WO_2D), r, scr, lane); continue; } r -= I_1D;
                if (r < I_IN) { prep_head(I.w_in + (size_t)l * DM * INW, DM, INW, I.mix_norm + l * DM, (bf16*)(WB + WO_IN), r, scr, lane); continue; } r -= I_IN;
                if (r < I_P) { prep_head(I.w_br_na + (size_t)l * 512 * DM, 512, DM, nullptr, (bf16*)(WB + WO_PA), r, scr, lane); continue; } r -= I_P;
                if (r < I_P) { prep_head(I.w_br_sw + (size_t)l * 512 * DM, 512, DM, nullptr, (bf16*)(WB + WO_PB), r, scr, lane); continue; } r -= I_P;
                prep_head(I.w_out + (size_t)l * DM * DM, DM, DM, nullptr, (bf16*)(WB + WO_OUT), r, scr, lane);
            }
            if (l == 0) {
                for (int m = gw; m < M; m += NGW) { const f32x4* xr = (const f32x4*)(I.x + (size_t)m * DM) + lane; float s = 0.f; u32x2* o8 = (u32x2*)(XB + (size_t)m * DM) + lane;
#pragma unroll
                    for (int j = 0; j < 4; ++j) { const f32x4 v = xr[64 * j]; s += (v[0] * v[0] + v[1] * v[1]) + (v[2] * v[2] + v[3] * v[3]); u32x2 w; w.x = pk2(v[0], v[1]); w.y = pk2(v[2], v[3]); o8[64 * j] = w; }
                    s = wave_sum64(s); if (lane == 0) ss0[m] = s; }
            }
            __syncthreads();
        } else if ((k == 1 || k == 7) && (CODE_MASK & 2)) {
            pg8::Gemm g{XB, (const bf16*)(WB + (k == 1 ? WO_1C : WO_2C)), M, 2 * FF, DM}; pg8::StaticOrder S; S.init(M, 2 * FF, G, bx);
            pg8::EpiFfnUp E{H, k == 1 ? ss0 : ss2};
            pg8::gemm_phase<pg8::EpiFfnUp, PG8_ALIGN, PG8_SP2>(lds, g, S, E);
        } else if ((k == 2 || k == 8) && (CODE_MASK & 4)) {
            pg8::Gemm g{H, (const bf16*)(WB + (k == 2 ? WO_1D : WO_2D)), M, DM, FF}; pg8::StaticOrder S; S.init(M, DM, G, bx);
            const bool fin = (k == 8 && l == DEPTH - 1);
            pg8::EpiResid E{(k == 2 && l == 0) ? I.x : out, out, fin ? nullptr : XB, fin ? nullptr : (k == 2 ? ss1 : ss3), 0.5f};
            pg8::gemm_phase<pg8::EpiResid, false, PG8_SP2>(lds, g, S, E);
        } else if (k == 3 && (CODE_MASK & 8)) {
            pg8::Gemm g{XB, (const bf16*)(WB + WO_IN), M, INW, DM}; pg8::StaticOrder S; S.init(M, INW, G, bx);
            pg8::EpiWin E{QKV, GT, ss1, I.b_gate + l * NG, I.na_q_norm + l * 64, I.na_k_norm + l * 64, I.sw_q_norm + l * 64, I.sw_k_norm + l * 64};
            pg8::gemm_phase<pg8::EpiWin, PG8_ALIGN, PG8_SP2>(lds, g, S, E);
        } else if (k == 4 && (CODE_MASK & 48)) {
            if (CODE_MASK & 16) for (int u = vcu; u < 256; u += G) na_unit(lds, u >> 5, (u >> 2) & 7, u & 3, QKV, I.na_rpb + (size_t)l * 8 * 465, ONA);
            if (CODE_MASK & 32) for (int u = vcu; u < 256; u += G) swa_unit(lds, u >> 5, (u >> 4) & 1, u & 15, QKV, I.t5, I.sw_sink + l * 8, OSW);
        } else if (k == 5 && (CODE_MASK & 64)) {
            pg8::StaticOrder S; S.init(M, DM, G, bx);
            { pg8::Gemm g{ONA, (const bf16*)(WB + WO_PA), M, DM, 512}; pg8::EpiBranch<0> E{T, MRG, GT}; pg8::gemm_phase<pg8::EpiBranch<0>, false, PG8_SP2>(lds, g, S, E); }
            { pg8::Gemm g{OSW, (const bf16*)(WB + WO_PB), M, DM, 512}; pg8::EpiBranch<1> E{T, MRG, GT}; pg8::gemm_phase<pg8::EpiBranch<1>, false, PG8_SP2>(lds, g, S, E); }
        } else if (k == 6 && (CODE_MASK & 128)) {
            pg8::Gemm g{MRG, (const bf16*)(WB + WO_OUT), M, DM, DM}; pg8::StaticOrder S; S.init(M, DM, G, bx);
            pg8::EpiResid E{out, out, XB, ss2, 1.0f};
            pg8::gemm_phase<pg8::EpiResid, false, PG8_SP2>(lds, g, S, E);
        }
        if (ph + 1 < hi) xcd_barrier(bar);
    }
}
#ifndef FAST_MASK
#define FAST_MASK 0x3ffffu
#endif
#ifndef MERGE_LAUNCHES
#define MERGE_LAUNCHES 1
#endif
static void launch_slow_phase(const Inputs& I, int ph, unsigned char* ws, float* out, hipStream_t stream) {
    const int l = ph / 9, k = ph % 9;
    float* SS = (float*)(ws + WS_SS);
    bf16 *XB = (bf16*)(ws + WS_XB), *H = (bf16*)(ws + WS_H), *QKV = (bf16*)(ws + WS_QKV), *T = (bf16*)(ws + WS_T), *MRG = (bf16*)(ws + WS_MRG), *G = (bf16*)(ws + WS_G),
         *ONA = (bf16*)(ws + WS_ONA), *OSW = (bf16*)(ws + WS_OSW);
    float* ss0 = SS + (size_t)(3 * l + 0) * M; float* ss1 = SS + (size_t)(3 * l + 1) * M; float* ss2 = SS + (size_t)(3 * l + 2) * M; float* ss3 = SS + (size_t)(3 * l + 3) * M;
    switch (k) {
    case 0: if (l == 0) hipLaunchKernelGGL(slow::prep_x, dim3(M), dim3(256), 0, stream, I.x, XB, SS); break;
    case 1: { slow::OpFfnUp op{DM, 0, XB, I.ffn1_wg + (size_t)l * DM * FF, I.ffn1_wu + (size_t)l * DM * FF, I.ffn1_norm + l * DM, ss0, H};
              hipLaunchKernelGGL(slow::gemm<slow::OpFfnUp>, dim3(FF / 64, M / 64), dim3(256), 0, stream, op); } break;
    case 2: { slow::OpResid op{FF, 0.5f, H, I.ffn1_wd + (size_t)l * FF * DM, l == 0 ? I.x : out, out, XB, ss1};
              hipLaunchKernelGGL(slow::gemm<slow::OpResid>, dim3(DM / 64, M / 64), dim3(256), 0, stream, op); } break;
    case 3: { slow::OpWin op{DM, 0, XB, I.w_in + (size_t)l * DM * INW, I.mix_norm + l * DM, ss1, I.b_gate + l * NG, I.na_q_norm + l * 64, I.na_k_norm + l * 64, I.sw_q_norm + l * 64, I.sw_k_norm + l * 64, QKV, G};
              hipLaunchKernelGGL(slow::gemm<slow::OpWin>, dim3(INW / 64, M / 64), dim3(256), 0, stream, op); } break;
    case 4: hipLaunchKernelGGL(slow::attn_na, dim3(M * 8 / 4), dim3(256), 0, stream, QKV, I.na_rpb + (size_t)l * 8 * 15 * 31, ONA);
            hipLaunchKernelGGL(slow::attn_sw, dim3(M * 8 / 4), dim3(256), 0, stream, QKV, I.t5, I.sw_sink + l * 8, OSW); break;
    case 5: { slow::OpBranch op{512, 0, ONA, OSW, G, I.w_br_na + (size_t)l * 512 * DM, I.w_br_sw + (size_t)l * 512 * DM, T, MRG};
              hipLaunchKernelGGL(slow::gemm<slow::OpBranch>, dim3(DM / 64, M / 64), dim3(256), 0, stream, op); } break;
    case 6: { slow::OpResid op{DM, 1.0f, MRG, I.w_out + (size_t)l * DM * DM, out, out, XB, ss2};
              hipLaunchKernelGGL(slow::gemm<slow::OpResid>, dim3(DM / 64, M / 64), dim3(256), 0, stream, op); } break;
    case 7: { slow::OpFfnUp op{DM, 0, XB, I.ffn2_wg + (size_t)l * DM * FF, I.ffn2_wu + (size_t)l * DM * FF, I.ffn2_norm + l * DM, ss2, H};
              hipLaunchKernelGGL(slow::gemm<slow::OpFfnUp>, dim3(FF / 64, M / 64), dim3(256), 0, stream, op); } break;
    default: { const bool last = (l == DEPTH - 1);
              slow::OpResid op{FF, 0.5f, H, I.ffn2_wd + (size_t)l * FF * DM, out, out, last ? nullptr : XB, last ? nullptr : ss3};
              hipLaunchKernelGGL(slow::gemm<slow::OpResid>, dim3(DM / 64, M / 64), dim3(256), 0, stream, op); } break;
    }
}

extern "C" void kernel_launch(void* const* d_in, const int* in_sizes, int n_in, void* d_out, int out_size, void* d_ws, size_t ws_size, hipStream_t stream) {
    static int grid = 0;
    if (grid == 0) {
        if (n_in != 22 || in_sizes[0] != M * DM || out_size != M * DM || ws_size < WS_END) { fprintf(stderr, "kernel_launch: unexpected shapes (n_in %d, in0 %d, out %d, ws %zu)\n", n_in, n_in > 0 ? in_sizes[0] : -1, out_size, ws_size); grid = -1; return; }
        int dev = 0, cus = 0, per_cu = 0;
        if (hipGetDevice(&dev) != hipSuccess || hipDeviceGetAttribute(&cus, hipDeviceAttributeMultiprocessorCount, dev) != hipSuccess) { grid = -1; return; }
        if (hipFuncSetAttribute((const void*)mega_fwd, hipFuncAttributeMaxDynamicSharedMemorySize, LDS_BYTES) != hipSuccess) { fprintf(stderr, "kernel_launch: hipFuncSetAttribute failed\n"); grid = -1; return; }
        if (hipOccupancyMaxActiveBlocksPerMultiprocessor(&per_cu, (const void*)mega_fwd, NTHREADS, LDS_BYTES) != hipSuccess || per_cu < 1) fprintf(stderr, "kernel_launch: occupancy query says %d blocks/CU\n", per_cu);
        (void)hipGetLastError();
        grid = cus;
    }
    if (grid < 0) return;
    Inputs I;
    { const float** p = (const float**)&I; for (int i = 0; i < 22; ++i) p[i] = (const float*)d_in[i]; }
    unsigned char* ws = (unsigned char*)d_ws; float* out = (float*)d_out;
    (void)hipMemsetAsync(ws + WS_CTL, 0, CTL_ZERO_BYTES, stream);
    int region = 0;
    for (int ph = 0; ph < N_PHASES;) {
        if (!((FAST_MASK >> ph) & 1u)) { launch_slow_phase(I, ph, ws, out, stream); ++ph; continue; }
        int hi = ph + 1;
        if (MERGE_LAUNCHES) while (hi < N_PHASES && ((FAST_MASK >> hi) & 1u)) ++hi;
        Args a{};
        a.I = I; a.out = out; a.ws = ws; a.ph_lo = ph; a.ph_hi = hi; a.bar_region = region++; a.pad = 0;
        hipLaunchKernelGGL(mega_fwd, dim3(grid), dim3(NTHREADS), LDS_BYTES, stream, a);
        ph = hi;
    }
}
```

```cpp
#include <hip/hip_runtime.h>
#include <cstdio>
#include <cstdint>

constexpr int BATCH = 8, SEQ = 2048, DM = 1024, DEPTH = 2, FF = 2816;
constexpr int M = BATCH * SEQ;
constexpr int GRID_W = 64, ROWS = SEQ / GRID_W;
constexpr int NQKV = 2304, NG = 2048, INW = NQKV + NG;
constexpr float EPS = 1e-6f;
constexpr float NEGV = -1e30f;

typedef unsigned short bf16;

constexpr size_t MiB = 1u << 20;
constexpr size_t WS_CTL = 0;
constexpr size_t WS_SS = 512 * 1024;
constexpr size_t CTL_ZERO_BYTES = 1 * MiB;
constexpr size_t WS_W = 1 * MiB;
constexpr size_t WS_XB = 47 * MiB;
constexpr size_t WS_H = 79 * MiB;
constexpr size_t WS_QKV = 79 * MiB;
constexpr size_t WS_T = 79 * MiB;
constexpr size_t WS_MRG = 111 * MiB;
constexpr size_t WS_G = 151 * MiB;
constexpr size_t WS_ONA = 215 * MiB;
constexpr size_t WS_OSW = 231 * MiB;
constexpr size_t WS_END = 247 * MiB;

__device__ __forceinline__ unsigned f2bf(float f) { unsigned u = __builtin_bit_cast(unsigned, f); return (u + 0x7fffu + ((u >> 16) & 1u)) >> 16; }
__device__ __forceinline__ float bf2f(unsigned b) { return __builtin_bit_cast(float, b << 16); }
__device__ __forceinline__ float bfr(float f) { return bf2f(f2bf(f)); }

struct Inputs {
    const float *x, *ffn1_norm, *ffn1_wg, *ffn1_wu, *ffn1_wd, *mix_norm, *w_in, *b_gate, *na_q_norm, *na_k_norm, *na_rpb, *sw_q_norm, *sw_k_norm, *sw_sink, *t5,
                *w_br_na, *w_br_sw, *w_out, *ffn2_norm, *ffn2_wg, *ffn2_wu, *ffn2_wd;
};

namespace slow {
template <class Op> __global__ void __launch_bounds__(256) gemm(Op op) {
    constexpr int NS = Op::NSEL;
    __shared__ float As[NS][16][68];
    __shared__ float Bs[NS][16][68];
    __shared__ float Cs[NS][64][65];
    const int tid = threadIdx.x, tx = tid & 15, ty = tid >> 4;
    const int m0 = blockIdx.y * 64, n0 = blockIdx.x * 64;
    float acc[NS][4][4];
#pragma unroll
    for (int s = 0; s < NS; ++s)
#pragma unroll
        for (int i = 0; i < 4; ++i)
#pragma unroll
            for (int j = 0; j < 4; ++j) acc[s][i][j] = 0.f;
    for (int k0 = 0; k0 < op.K; k0 += 16) {
#pragma unroll
        for (int s = 0; s < NS; ++s) {
#pragma unroll
            for (int e = 0; e < 4; ++e) {
                const int idx = tid + e * 256;
                { const int kk = idx & 15, mm = idx >> 4; As[s][kk][mm] = op.a(s, m0 + mm, k0 + kk); }
                { const int nn = idx & 63, kk = idx >> 6; Bs[s][kk][nn] = op.b(s, k0 + kk, n0 + nn); }
            }
        }
        __syncthreads();
#pragma unroll
        for (int kk = 0; kk < 16; ++kk) {
#pragma unroll
            for (int s = 0; s < NS; ++s) {
                float av[4], bv[4];
#pragma unroll
                for (int i = 0; i < 4; ++i) { av[i] = As[s][kk][ty * 4 + i]; bv[i] = Bs[s][kk][tx * 4 + i]; }
#pragma unroll
                for (int i = 0; i < 4; ++i)
#pragma unroll
                    for (int j = 0; j < 4; ++j) acc[s][i][j] += av[i] * bv[j];
            }
        }
        __syncthreads();
    }
#pragma unroll
    for (int s = 0; s < NS; ++s)
#pragma unroll
        for (int i = 0; i < 4; ++i)
#pragma unroll
            for (int j = 0; j < 4; ++j) Cs[s][ty * 4 + i][tx * 4 + j] = acc[s][i][j];
    __syncthreads();
    op.epi(m0, n0, Cs, tid);
}

struct OpFfnUp {
    static constexpr int NSEL = 2; int K, pad_;
    const bf16* xb; const float *wg, *wu, *gn, *ss; bf16* H;
    __device__ float a(int, int m, int k) const { return bf2f(xb[(size_t)m * DM + k]); }
    __device__ float b(int s, int k, int n) const { return bfr(gn[k] * (s ? wu : wg)[(size_t)k * FF + n]); }
    __device__ void epi(int m0, int n0, float (*Cs)[64][65], int tid) const {
        for (int e = tid; e < 4096; e += 256) { const int i = e >> 6, j = e & 63, m = m0 + i;
            const float r = rsqrtf(ss[m] * (1.f / DM) + EPS), zg = r * Cs[0][i][j], zu = r * Cs[1][i][j];
            const float h = zg / (1.f + __expf(-zg)) * zu;
            H[(size_t)m * FF + n0 + j] = (bf16)f2bf(h); }
    }
};
struct OpResid {
    static constexpr int NSEL = 1; int K; float alpha;
    const bf16* A; const float* w; const float* base; float* out; bf16* xb; float* ss;
    __device__ float a(int, int m, int k) const { return bf2f(A[(size_t)m * K + k]); }
    __device__ float b(int, int k, int n) const { return bfr(w[(size_t)k * DM + n]); }
    __device__ void epi(int m0, int n0, float (*Cs)[64][65], int tid) const {
        for (int e = tid; e < 4096; e += 256) { const int i = e >> 6, j = e & 63; const size_t o = (size_t)(m0 + i) * DM + n0 + j;
            const float v = base[o] + alpha * Cs[0][i][j]; out[o] = v; Cs[0][i][j] = v; if (xb) xb[o] = (bf16)f2bf(v); }
        __syncthreads();
        if (ss && tid < 64) { float s = 0.f; for (int j = 0; j < 64; ++j) s += Cs[0][tid][j] * Cs[0][tid][j]; atomicAdd(ss + m0 + tid, s); }
    }
};
struct OpWin {
    static constexpr int NSEL = 1; int K, pad_;
    const bf16* xb; const float *w, *gn, *ss, *bg, *naq, *nak, *swq, *swk; bf16 *QKV, *G;
    __device__ float a(int, int m, int k) const { return bf2f(xb[(size_t)m * DM + k]); }
    __device__ float b(int, int k, int n) const { return bfr(gn[k] * w[(size_t)k * INW + n]); }
    __device__ void epi(int m0, int n0, float (*Cs)[64][65], int tid) const {
        __shared__ float hn[64];
        const int hg = n0 >> 6;
        const float* gain = hg < 8 ? naq : hg < 16 ? nak : (hg >= 24 && hg < 32) ? swq : (hg >= 32 && hg < 34) ? swk : nullptr;
        const float qs = (hg < 8 || (hg >= 24 && hg < 32)) ? 0.125f : 1.f;
        for (int e = tid; e < 4096; e += 256) { const int i = e >> 6, j = e & 63; Cs[0][i][j] *= rsqrtf(ss[m0 + i] * (1.f / DM) + EPS); }
        __syncthreads();
        if (tid < 64) { float s = 0.f; for (int j = 0; j < 64; ++j) s += Cs[0][tid][j] * Cs[0][tid][j]; hn[tid] = rsqrtf(s * (1.f / 64.f) + EPS); }
        __syncthreads();
        for (int e = tid; e < 4096; e += 256) { const int i = e >> 6, j = e & 63, m = m0 + i; float z = Cs[0][i][j];
            if (hg < 36) { if (gain) z = z * hn[i] * gain[j] * qs; QKV[(size_t)m * NQKV + n0 + j] = (bf16)f2bf(z); }
            else { const int c = n0 - NQKV + j; z = 1.f / (1.f + __expf(-(z + bg[c]))); G[(size_t)m * NG + c] = (bf16)f2bf(z); } }
    }
};
struct OpBranch {
    static constexpr int NSEL = 2; int K, pad_;
    const bf16 *ONA, *OSW, *G; const float *pa, *pb; bf16 *T, *MRG;
    __device__ float a(int s, int m, int k) const { return bf2f((s ? OSW : ONA)[(size_t)m * 512 + k]); }
    __device__ float b(int s, int k, int n) const { return bfr((s ? pb : pa)[(size_t)k * DM + n]); }
    __device__ void epi(int m0, int n0, float (*Cs)[64][65], int tid) const {
        for (int e = tid; e < 4096; e += 256) { const int i = e >> 6, j = e & 63, m = m0 + i, n = n0 + j;
            const float gA = bf2f(G[(size_t)m * NG + n]), gB = bf2f(G[(size_t)m * NG + DM + n]);
            const float t = bfr(gA * Cs[0][i][j]); T[(size_t)m * DM + n] = (bf16)f2bf(t);
            MRG[(size_t)m * DM + n] = (bf16)f2bf(t + gB * Cs[1][i][j]); }
    }
};

__global__ void __launch_bounds__(256) prep_x(const float* x, bf16* xb, float* ss) {
    __shared__ float red[256];
    const int m = blockIdx.x, tid = threadIdx.x; float s = 0.f;
    for (int c = tid; c < DM; c += 256) { const float v = x[(size_t)m * DM + c]; xb[(size_t)m * DM + c] = (bf16)f2bf(v); s += v * v; }
    red[tid] = s; __syncthreads();
    for (int o = 128; o > 0; o >>= 1) { if (tid < o) red[tid] += red[tid + o]; __syncthreads(); }
    if (tid == 0) ss[m] = red[0];
}

__device__ __forceinline__ float wave_sum(float v) {
#pragma unroll
    for (int o = 1; o < 64; o <<= 1) v += __shfl_xor(v, o);
    return v;
}
__device__ __forceinline__ float wave_max(float v) {
#pragma unroll
    for (int o = 1; o < 64; o <<= 1) v = fmaxf(v, __shfl_xor(v, o));
    return v;
}
__global__ void __launch_bounds__(256) attn_na(const bf16* QKV, const float* rpb  , bf16* ONA) {
    __shared__ float sc[4][128];
    const int w = threadIdx.x >> 6, lane = threadIdx.x & 63;
    const int item = blockIdx.x * 4 + w;
    const int h = item & 7, tok = item >> 3, b = tok / SEQ, t = tok % SEQ, r = t / GRID_W, c = t % GRID_W;
    int rs = r - 4; rs = rs < 0 ? 0 : (rs > ROWS - 8 ? ROWS - 8 : rs);
    int cs = c - 8; cs = cs < 0 ? 0 : (cs > GRID_W - 16 ? GRID_W - 16 : cs);
    const float q = bf2f(QKV[(size_t)tok * NQKV + h * 64 + lane]);
    for (int j = 0; j < 128; ++j) { const int kr = rs + (j >> 4), kc = cs + (j & 15); const size_t kt = (size_t)b * SEQ + kr * GRID_W + kc;
        float s = wave_sum(q * bf2f(QKV[kt * NQKV + 512 + h * 64 + lane]));
        s += rpb[(h * 15 + (kr - r + 7)) * 31 + (kc - c + 15)];
        if (lane == 0) sc[w][j] = s; }
    __syncthreads();
    const float s0 = sc[w][lane], s1 = sc[w][lane + 64];
    const float mx = wave_max(fmaxf(s0, s1));
    const float e0 = __expf(s0 - mx), e1 = __expf(s1 - mx);
    const float l = wave_sum(e0 + e1);
    __syncthreads();
    sc[w][lane] = bfr(e0); sc[w][lane + 64] = bfr(e1);
    __syncthreads();
    float o = 0.f;
    for (int j = 0; j < 128; ++j) { const int kr = rs + (j >> 4), kc = cs + (j & 15); const size_t kt = (size_t)b * SEQ + kr * GRID_W + kc;
        o += sc[w][j] * bf2f(QKV[kt * NQKV + 1024 + h * 64 + lane]); }
    ONA[(size_t)tok * 512 + h * 64 + lane] = (bf16)f2bf(o / l);
}
__device__ __forceinline__ int t5_bucket(int rel) {
    const int n = rel < 0 ? -rel : rel; int v;
    if (n < 8) v = n; else { int k = 0; while (64 * (2 << k) <= n * n) ++k; v = 8 + k; v = v > 15 ? 15 : v; }
    return (rel > 0 ? 16 : 0) + v;
}
__global__ void __launch_bounds__(256) attn_sw(const bf16* QKV, const float* t5  , const float* sink  , bf16* OSW) {
    __shared__ float sc[4][320];
    const int w = threadIdx.x >> 6, lane = threadIdx.x & 63;
    const int item = blockIdx.x * 4 + w;
    const int h = item & 7, tok = item >> 3, b = tok / SEQ, t = tok % SEQ, g = h >> 2;
    const int k0 = t - 128 < 0 ? 0 : t - 128, k1 = t + 128 > SEQ - 1 ? SEQ - 1 : t + 128, nk = k1 - k0 + 1;
    const float q = bf2f(QKV[(size_t)tok * NQKV + 1536 + h * 64 + lane]);
    for (int j = 0; j < nk; ++j) { const size_t kt = (size_t)b * SEQ + k0 + j;
        float s = wave_sum(q * bf2f(QKV[kt * NQKV + 2048 + g * 64 + lane]));
        s += t5[t5_bucket(k0 + j - t) * 8 + h];
        if (lane == 0) sc[w][j] = s; }
    __syncthreads();
    const float snk = sink[h];
    float mx = snk; for (int j = lane; j < nk; j += 64) mx = fmaxf(mx, sc[w][j]);
    mx = wave_max(mx);
    float l = 0.f; for (int j = lane; j < nk; j += 64) { const float e = __expf(sc[w][j] - mx); l += e; sc[w][j] = bfr(e); }
    l = wave_sum(l) + __expf(snk - mx);
    __syncthreads();
    float o = 0.f;
    for (int j = 0; j < nk; ++j) { const size_t kt = (size_t)b * SEQ + k0 + j; o += sc[w][j] * bf2f(QKV[kt * NQKV + 2176 + g * 64 + lane]); }
    OSW[(size_t)tok * 512 + h * 64 + lane] = (bf16)f2bf(o / l);
}
}

#ifndef CODE_MASK
#define CODE_MASK 255
#endif
#ifndef PROBE2_PHASE
#define PROBE2_PHASE -1
#endif
#ifndef PROBE_BX
#define PROBE_BX 0
#endif
#ifndef PROBE2_SEL
#define PROBE2_SEL 0
#endif
#ifndef PROBE3
#define PROBE3 0
#endif
#ifndef GROUPS
#define GROUPS 1
#endif
#ifndef PROBE5
#define PROBE5 -1
#endif
#ifndef RELAX_WAITS
#define RELAX_WAITS 1
#endif
#ifndef NA_V2
#define NA_V2 1
#endif
#ifndef RING4
#define RING4 0
#endif
#ifndef FULL_LINES
#define FULL_LINES 0
#endif
#ifndef NT_BASE
#define NT_BASE 0
#endif
#ifndef FORCE_FULL_RELEASE
#define FORCE_FULL_RELEASE 0
#endif
#ifndef WGM_P3
#define WGM_P3 PG8_WGM
#endif
#ifndef WGM_P1
#define WGM_P1 PG8_WGM
#endif
#ifndef STAGGER_TICKS
#define STAGGER_TICKS 0
#endif
#ifndef PROBE4
#define PROBE4 0
#endif
#ifndef PROBE_MASK
#define PROBE_MASK 0
#endif
#define LAS __attribute__((address_space(3)))
#define GAS __attribute__((address_space(1)))
typedef short bf16x8 __attribute__((ext_vector_type(8)));
typedef short s16x4 __attribute__((ext_vector_type(4)));
typedef float f32x4 __attribute__((ext_vector_type(4)));
typedef unsigned u32x4 __attribute__((ext_vector_type(4)));
typedef unsigned u32x2 __attribute__((ext_vector_type(2)));
typedef GAS unsigned gu32;

constexpr int NWAVES = 8, NTHREADS = 512;
constexpr int LDS_BYTES = 147456;
constexpr int RING_BYTES = 131072;
constexpr int MISC_OFF = RING_BYTES + 320;

constexpr size_t WO_1C = 0;
constexpr size_t WO_1D = WO_1C + (size_t)2 * FF * DM * 2;
constexpr size_t WO_IN = WO_1D + (size_t)DM * FF * 2;
constexpr size_t WO_PA = WO_IN + (size_t)INW * DM * 2;
constexpr size_t WO_PB = WO_PA + (size_t)DM * 512 * 2;
constexpr size_t WO_OUT = WO_PB + (size_t)DM * 512 * 2;
constexpr size_t WO_2C = WO_OUT + (size_t)DM * DM * 2;
constexpr size_t WO_2D = WO_2C + (size_t)2 * FF * DM * 2;
constexpr size_t WO_END = WO_2D + (size_t)DM * FF * 2;
static_assert(WS_W + WO_END <= WS_XB, "weight region");

typedef float f32x2_t __attribute__((ext_vector_type(2))); typedef __bf16 bf16x2_t __attribute__((ext_vector_type(2)));
__device__ __forceinline__ unsigned cvt_pk_bf16(float lo, float hi) { const f32x2_t v = {lo, hi}; const bf16x2_t b = __builtin_convertvector(v, bf16x2_t); return __builtin_bit_cast(unsigned, b); }
#ifndef WT_STORES
#define WT_STORES 0
#endif
typedef __amdgpu_buffer_rsrc_t rsrc_t;
__device__ __forceinline__ rsrc_t mk_rsrc(const void* p) { return __builtin_amdgcn_make_buffer_rsrc((void*)p, 0, 0x7fffffff, 0x00020000); }
__device__ __forceinline__ void st16(rsrc_t r, unsigned byteoff, u32x4 v) { __builtin_amdgcn_raw_buffer_store_b128(v, r, (int)byteoff, 0, (WT_STORES & 1) ? 16 : 0); }
__device__ __forceinline__ void st16o(rsrc_t r, unsigned byteoff, u32x4 v) { __builtin_amdgcn_raw_buffer_store_b128(v, r, (int)byteoff, 0, (WT_STORES & 2) ? 16 : (WT_STORES & 4) ? 2 : 0); }
__device__ __forceinline__ float fast_sigmoid(float z) { return __builtin_amdgcn_rcpf(1.f + __builtin_amdgcn_exp2f(-1.4426950408889634f * z)); }
__device__ __forceinline__ float rs_row(const float* ss, int row) { return __builtin_amdgcn_rsqf(ss[row] * (1.f / DM) + EPS); }

namespace pg8 {
#ifndef PG8_WGM
#define PG8_WGM 4
#endif
constexpr int BM = 256, BK = 64, HALF = 128, HTB = HALF * BK * 2, STAGE_BYTES = 8 * HTB, NXCD = 8, WGM = PG8_WGM;
__host__ __device__ __forceinline__ int lds_byte(int r, int c) { const int st = (r >> 4) * 2 + (c >> 5), rr = r & 15, cc = c & 31, ob = rr * 64 + cc * 2; return st * 1024 + (ob ^ (((ob >> 9) & 1) << 5)); }
__host__ __device__ __forceinline__ void stage_rc(int b, int& R, int& C) { const int st = b / 1024, sb = b % 1024, swz = sb ^ (((sb >> 9) & 1) << 5); R = (st >> 1) * 16 + swz / 64; C = (st & 1) * 32 + (swz % 64) / 2; }
struct Unit { int pm, pn, hf, sel; };
struct Gemm { const bf16* A; const bf16* Bt; int M, N, K; const bf16* A2; const bf16* Bt2; };
struct StaticOrder {
    int nM, nN, nwg, G, c, nfull, ntot, wgm;
    __device__ void init(int M_, int N_, int G_, int c_, int wgm_ = WGM) { nM = M_ / BM; nN = N_ / BM; nwg = nM * nN; G = G_; c = c_; wgm = wgm_;
        const int rem = nwg % G; const bool split = rem > 0 && 2 * rem <= G && (nwg % NXCD) == 0 && (rem % NXCD) == 0 && (G % NXCD) == 0;
        nfull = split ? nwg - rem : nwg; ntot = split ? nfull + 2 * rem : nwg; }
    __device__ bool next(int i, Unit& u) const {
        const long L = (long)i * G + c; if (L >= ntot) return false;
        const int q = nwg / NXCD, r = nwg % NXCD; int wgid;
        if (L < nfull) { const int xcd = (int)L % NXCD, off = (int)L / NXCD; wgid = (xcd < r ? xcd * (q + 1) : r * (q + 1) + (xcd - r) * q) + off; u.hf = 0; }
        else { const int Lp = (int)L - nfull, xcd = Lp % NXCD, idx = Lp / NXCD; wgid = xcd * q + nfull / NXCD + (idx >> 1); u.hf = 1 + (idx & 1); }
        const int nig = wgm * nN, gid = wgid / nig, fm = gid * wgm, gsz = (nM - fm) < wgm ? (nM - fm) : wgm;
        u.pm = fm + ((wgid % nig) % gsz); u.pn = (wgid % nig) / gsz; u.sel = 0; return true;
    }
};
struct DualOrder { StaticOrder S;
    __device__ bool next(int i, Unit& u) const { if (!S.next(i >> 1, u)) return false; u.sel = i & 1; return true; } };
struct NoBar { __device__ __forceinline__ void operator()() const {} template <class Pre> __device__ __forceinline__ bool pre(const Pre&) const { return false; } };
struct PreB { LAS unsigned char* lds; const char* cB; size_t hstep; unsigned v0, v1, ldsw; int wid;
    __device__ __forceinline__ void operator()() const { if (wid != 0) {
        __builtin_amdgcn_global_load_lds((const unsigned*)(cB + v0), (LAS unsigned*)(lds + 4 * HTB + ldsw), 16, 0, 0); __builtin_amdgcn_global_load_lds((const unsigned*)(cB + v1), (LAS unsigned*)(lds + 4 * HTB + ldsw + 8192), 16, 0, 0);
        __builtin_amdgcn_global_load_lds((const unsigned*)(cB + hstep + v0), (LAS unsigned*)(lds + 5 * HTB + ldsw), 16, 0, 0); __builtin_amdgcn_global_load_lds((const unsigned*)(cB + hstep + v1), (LAS unsigned*)(lds + 5 * HTB + ldsw + 8192), 16, 0, 0); } } };
template <class Epi, bool ALIGN_EPI, bool SP2, class Sched = StaticOrder, class Bar = NoBar>
__device__ __forceinline__ void gemm_phase(LAS unsigned char* lds, const Gemm g, const Sched& S, const Epi& E, const Bar& PB = Bar()) {
    int tid_ = threadIdx.x; asm volatile("" : "+v"(tid_));
    const int tid = tid_, wid = __builtin_amdgcn_readfirstlane(tid >> 6), lane = tid & 63, wr = wid >> 2, wc = wid & 3, fr = lane & 15, fq = lane >> 4;
    const int K = g.K, nt = K / BK;
    unsigned voff[2];
#pragma unroll
    for (int i = 0; i < 2; ++i) { int R, C; if (FULL_LINES) { R = 8 * (wid + 8 * i) + (lane >> 3); C = 8 * ((lane & 7) ^ (lane >> 3)); } else stage_rc(tid * 16 + i * 8192, R, C); voff[i] = (unsigned)(R * K + C) * 2u; }
    const size_t kstep = (size_t)(BK * 2), hstep = (size_t)HALF * K * 2, tstep = 2 * hstep;
    const unsigned ldsw = (unsigned)wid * 1024u;
    const int aoff = FULL_LINES ? (8 * wr + (fr >> 3)) * 1024 + (fr & 7) * 128 + ((fq ^ (fr & 7)) << 4) : lds_byte(wr * 64 + fr, fq * 8);
    const int boff = FULL_LINES ? (4 * wc + (fr >> 3)) * 1024 + (fr & 7) * 128 + ((fq ^ (fr & 7)) << 4) : lds_byte(wc * 32 + fr, fq * 8);
    const int aoff1 = FULL_LINES ? (aoff ^ 64) : aoff + 1024, boff1 = FULL_LINES ? (boff ^ 64) : boff + 1024;
#define PG8_SA(b, h) (((b) * 2 + (h)) * HTB)
#define PG8_SB(b, h) ((4 + (b) * 2 + (h)) * HTB)
#define PG8_STAGE(bufoff, gbase) do { _Pragma("unroll") for (int _i = 0; _i < 2; ++_i) \
        __builtin_amdgcn_global_load_lds((const unsigned*)((const char*)(gbase) + voff[_i]), (LAS unsigned*)(lds + (bufoff) + ldsw + _i * 8192), 16, 0, 0); } while (0)
#define PG8_STAGEH(bufoff, gbase, hflag) do { _Pragma("unroll") for (int _i = 0; _i < 2; ++_i) \
        __builtin_amdgcn_global_load_lds((const unsigned*)((const char*)(gbase) + ((hflag) ? 0u : voff[_i])), (LAS unsigned*)(lds + (bufoff) + ldsw + _i * 8192), 16, 0, 0); } while (0)
#define PG8_LDA(dst, b, h) do { _Pragma("unroll") for (int m = 0; m < 4; ++m) _Pragma("unroll") for (int k = 0; k < 2; ++k) dst[m][k] = *(const LAS bf16x8*)(lds + PG8_SA(b, h) + (k ? aoff1 : aoff) + m * 2048); } while (0)
#define PG8_LDB(dst, b, h) do { _Pragma("unroll") for (int n = 0; n < 2; ++n) _Pragma("unroll") for (int k = 0; k < 2; ++k) dst[n][k] = *(const LAS bf16x8*)(lds + PG8_SB(b, h) + (k ? boff1 : boff) + n * 2048); } while (0)
#define PG8_MMA(ai, bj, At, Bt) do { __builtin_amdgcn_s_setprio(1); _Pragma("unroll") for (int m = 0; m < 4; ++m) _Pragma("unroll") for (int n = 0; n < 2; ++n) _Pragma("unroll") for (int k = 0; k < 2; ++k) \
        acc[ai][bj][m][n] = __builtin_amdgcn_mfma_f32_16x16x32_bf16(Bt[n][k], At[m][k], acc[ai][bj][m][n], 0, 0, 0); __builtin_amdgcn_s_setprio(0); } while (0)
#define PG8_WAIT_V(n) asm volatile("s_waitcnt vmcnt(" #n ")" ::: "memory")
#define PG8_WAIT_L(n) asm volatile("s_waitcnt lgkmcnt(" #n ")" ::: "memory")
#define PG8_BAR __builtin_amdgcn_s_barrier()
#define PG8_SCHED __builtin_amdgcn_sched_barrier(0)
#define PG8_TRIP(W12) do { \
            const bool last = (t == nt - 2); \
            const char* a1 = cA + (size_t)(t + 1) * kstep; \
            const char* a2 = last ? nA : cA + (size_t)(t + 2) * kstep; const char* b2 = last ? nB : cB + (size_t)(t + 2) * kstep; \
            const char* a3 = a2 + kstep; const char* b3 = b2 + kstep; const size_t hs2 = last ? nhs : chs; \
            PG8_LDB(B0, 0, 0); PG8_LDB(B1, 0, 1); PG8_SCHED; PG8_LDA(At, 0, 0); PG8_STAGEH(PG8_SA(1, 1), a1 + chs, chalf_st); \
            W12; PG8_WAIT_L(0); PG8_BAR; PG8_MMA(0, 0, At, B0); PG8_MMA(0, 1, At, B1); PG8_BAR; PG8_SCHED; \
            if (!chalf) { PG8_LDA(At, 0, 1); } PG8_STAGE(PG8_SB(0, 0), b2); PG8_STAGE(PG8_SB(0, 1), b2 + hstep); PG8_STAGE(PG8_SA(0, 0), a2); \
            W12; PG8_WAIT_L(0); PG8_BAR; if (!chalf) { PG8_MMA(1, 0, At, B0); PG8_MMA(1, 1, At, B1); } PG8_BAR; PG8_SCHED; \
            PG8_LDB(B0, 1, 0); PG8_LDB(B1, 1, 1); PG8_SCHED; PG8_LDA(At, 1, 0); if (last) chalf_st = nhalf_st; PG8_STAGEH(PG8_SA(0, 1), a2 + hs2, chalf_st); \
            PG8_WAIT_V(8); PG8_WAIT_L(0); PG8_BAR; PG8_MMA(0, 0, At, B0); PG8_MMA(0, 1, At, B1); PG8_BAR; PG8_SCHED; \
            if (!chalf) { PG8_LDA(At, 1, 1); } PG8_STAGE(PG8_SB(1, 0), b3); PG8_STAGE(PG8_SB(1, 1), b3 + hstep); PG8_STAGE(PG8_SA(1, 0), a3); \
            PG8_WAIT_V(8); PG8_WAIT_L(0); PG8_BAR; if (!chalf) { PG8_MMA(1, 0, At, B0); PG8_MMA(1, 1, At, B1); } PG8_BAR; PG8_SCHED; \
        } while (0)
    unsigned pe0 = 0, pe1 = 0; if (PROBE2_PHASE >= 0 && Epi::PROBE && PROBE2_SEL == 6) pe0 = (unsigned)__builtin_amdgcn_s_memrealtime();
    Unit cur, nxt; int ui = 0;
    if (!S.next(0, cur)) { PB(); return; }
    unsigned pa0 = 0, pa1 = 0, pa2 = 0;
    f32x4 acc[2][2][4][2];
    const char* cA = (const char*)(cur.sel ? g.A2 : g.A) + (size_t)cur.pm * tstep + (cur.hf == 2 ? hstep : 0); const char* cB = (const char*)(cur.sel ? g.Bt2 : g.Bt) + (size_t)cur.pn * tstep;
    bool pref = false;
    if constexpr (Epi::PRELOAD) { E.preload(acc, cur, wr, wc, fr, fq); PB(); E.prescale(acc); }
    else { pref = PB.pre(PreB{lds, cB, hstep, voff[0], voff[1], ldsw, wid});
#pragma unroll
    for (int a = 0; a < 2; ++a)
#pragma unroll
        for (int b = 0; b < 2; ++b)
#pragma unroll
            for (int m = 0; m < 4; ++m)
#pragma unroll
                for (int n = 0; n < 2; ++n) acc[a][b][m][n] = (f32x4){0.f, 0.f, 0.f, 0.f};
    }
    bf16x8 At[4][2], B0[2][2], B1[2][2];
    size_t chs = cur.hf ? 0 : hstep;
    bool chalf_st = cur.hf != 0;
    if constexpr (SP2) {
        if (!pref || wid == 0) { PG8_STAGE(PG8_SB(0, 0), cB); PG8_STAGE(PG8_SB(0, 1), cB + hstep); }
        PG8_STAGE(PG8_SA(0, 0), cA); PG8_STAGEH(PG8_SA(0, 1), cA + chs, chalf_st);
        if (wr == 1) PG8_BAR;
        PG8_WAIT_V(2); PG8_BAR;
        PG8_STAGE(PG8_SB(1, 0), cB + kstep); PG8_STAGE(PG8_SA(1, 0), cA + kstep); PG8_STAGE(PG8_SB(1, 1), cB + hstep + kstep);
        PG8_WAIT_V(6); PG8_BAR;
    } else {
        PG8_STAGE(PG8_SB(0, 0), cB); PG8_STAGE(PG8_SA(0, 0), cA); PG8_STAGE(PG8_SB(0, 1), cB + hstep); PG8_STAGEH(PG8_SA(0, 1), cA + chs, chalf_st);
        if (wr == 1) PG8_BAR;
        PG8_WAIT_V(4); PG8_BAR;
        PG8_STAGE(PG8_SB(1, 0), cB + kstep); PG8_STAGE(PG8_SA(1, 0), cA + kstep); PG8_STAGE(PG8_SB(1, 1), cB + hstep + kstep);
        PG8_WAIT_V(6); PG8_BAR;
    }
    for (;;) {
        const bool has_next = S.next(ui + 1, nxt);
        if (PROBE2_PHASE >= 0 && Epi::PROBE && PROBE2_SEL == 6 && ui == 0) pe1 = (unsigned)__builtin_amdgcn_s_memrealtime();
        unsigned p_t0 = 0; if (PROBE2_PHASE >= 0 && Epi::PROBE) p_t0 = PROBE2_SEL == 9 ? (unsigned)__builtin_amdgcn_s_memtime() : (unsigned)__builtin_amdgcn_s_memrealtime();
        const char* nA = has_next ? (const char*)(nxt.sel ? g.A2 : g.A) + (size_t)nxt.pm * tstep + (nxt.hf == 2 ? hstep : 0) : cA; const char* nB = has_next ? (const char*)(nxt.sel ? g.Bt2 : g.Bt) + (size_t)nxt.pn * tstep : cB;
        const size_t nhs = has_next ? (nxt.hf ? 0 : hstep) : chs; const bool chalf = cur.hf != 0;
        const bool nhalf_st = has_next ? (nxt.hf != 0) : chalf_st;
        static_assert(SP2, "only the two-super-phase loop is kept");
        { int t = 0;
          if constexpr (RELAX_WAITS && Epi::MULTI) { if (ui > 0) { PG8_TRIP((void)0); t = 2; } }
          for (; t < nt; t += 2) { PG8_TRIP(PG8_WAIT_V(8)); } }
        unsigned p_t1 = 0; if (PROBE2_PHASE >= 0 && Epi::PROBE) p_t1 = PROBE2_SEL == 9 ? (unsigned)__builtin_amdgcn_s_memtime() : (unsigned)__builtin_amdgcn_s_memrealtime();
        if constexpr (ALIGN_EPI) { if (wr == 0) PG8_BAR; }
        E(acc, cur, wr, wc, fr, fq);
        if (PROBE2_PHASE >= 0 && Epi::PROBE) { const unsigned p_t3 = (unsigned)__builtin_amdgcn_s_memrealtime(); pa0 += p_t1 - p_t0; if (ui == 0 && PROBE2_SEL < 5) pa1 = p_t1 - p_t0; pa2 += (PROBE2_SEL == 9) ? (unsigned)(cur.hf ? 0 : nt) : p_t3 - p_t1; }
        if (!has_next) break;
        if (!Epi::CHAIN || cur.sel != 0) {
#pragma unroll
        for (int a = 0; a < 2; ++a)
#pragma unroll
            for (int b = 0; b < 2; ++b)
#pragma unroll
                for (int m = 0; m < 4; ++m)
#pragma unroll
                    for (int n = 0; n < 2; ++n) acc[a][b][m][n] = (f32x4){0.f, 0.f, 0.f, 0.f};
        }
        cur = nxt; cA = nA; cB = nB; chs = nhs; ++ui;
        if constexpr (ALIGN_EPI) { if (wr == 1) PG8_BAR; }
    }
    unsigned pd0 = 0; if (PROBE2_PHASE >= 0 && Epi::PROBE && PROBE2_SEL == 5) pd0 = (unsigned)__builtin_amdgcn_s_memrealtime();
    PG8_WAIT_V(0);
    if constexpr (!ALIGN_EPI) { if (wr == 0) PG8_BAR; }
    PG8_BAR;
    if (PROBE2_PHASE >= 0 && Epi::PROBE && PROBE2_SEL == 5) pa1 = (unsigned)__builtin_amdgcn_s_memrealtime() - pd0;
    if (PROBE2_PHASE >= 0 && Epi::PROBE && PROBE2_SEL == 6) pa1 = pe1 - pe0;
    if (PROBE2_PHASE >= 0 && Epi::PROBE) { volatile LAS unsigned* PM = (volatile LAS unsigned*)(lds + MISC_OFF); if (tid == 0 && PM[19]) { PM[20] = pa0; PM[21] = pa1; PM[22] = pa2; } }
#undef PG8_TRIP
#undef PG8_SA
#undef PG8_SB
#undef PG8_STAGE
#undef PG8_LDA
#undef PG8_LDB
#undef PG8_MMA
#undef PG8_WAIT_V
#undef PG8_WAIT_L
#undef PG8_BAR
#undef PG8_SCHED
}

typedef f32x4 Acc[2][2][4][2];
struct EpiFfnUp {
    static constexpr bool PROBE = (PROBE2_PHASE % 9 == 1) || (PROBE2_PHASE % 9 == 7), MULTI = true, PRELOAD = false, CHAIN = false;
    bf16* H; const float* ss;
    __device__ __forceinline__ void operator()(const Acc& acc, const Unit& u, int wr, int wc, int fr, int fq) const {
        const int row0 = u.pm * BM + (u.hf == 2 ? HALF : 0) + wr * 64 + fr, col0 = u.pn * 128 + wc * 32 + 8 * fq; const int nai = u.hf ? 1 : 2;
        const rsrc_t rH = mk_rsrc(H);
        float rr[2][4];
#pragma unroll
        for (int ai = 0; ai < 2; ++ai)
#pragma unroll
            for (int m = 0; m < 4; ++m) rr[ai][m] = ss[row0 + (ai < nai ? ai : 0) * HALF + m * 16];
#pragma unroll
        for (int ai = 0; ai < 2; ++ai) if (ai < nai)
#pragma unroll
            for (int m = 0; m < 4; ++m) { const int row = row0 + ai * HALF + m * 16; const float r = __builtin_amdgcn_rsqf(rr[ai][m] * (1.f / DM) + EPS); float h[8];
#pragma unroll
                for (int n = 0; n < 2; ++n)
#pragma unroll
                    for (int j = 0; j < 4; ++j) { const float zg = r * acc[ai][0][m][n][j], zu = r * acc[ai][1][m][n][j]; h[4 * n + j] = zg * fast_sigmoid(zg) * zu; }
                u32x4 w; w.x = cvt_pk_bf16(h[0], h[1]); w.y = cvt_pk_bf16(h[2], h[3]); w.z = cvt_pk_bf16(h[4], h[5]); w.w = cvt_pk_bf16(h[6], h[7]);
                st16(rH, (unsigned)(row * FF + col0) * 2u, w); }
    }
};
struct EpiResid {
    static constexpr bool PROBE = (PROBE2_PHASE % 9 == 2) || (PROBE2_PHASE % 9 == 6) || (PROBE2_PHASE % 9 == 8), MULTI = false, PRELOAD = false, CHAIN = false;
    const float* basef; float* out; bf16* xb; float* ss; float alpha;
    __device__ __forceinline__ void operator()(const Acc& acc, const Unit& u, int wr, int wc, int fr, int fq) const {
        const int row0 = u.pm * BM + wr * 64 + fr, col0 = u.pn * BM + wc * 64 + 8 * fq;
        const rsrc_t rO = mk_rsrc(out), rX = mk_rsrc(xb);
#pragma unroll
        for (int ai = 0; ai < 2; ++ai) {
            f32x4 bs[4][2][2];
#pragma unroll
            for (int m = 0; m < 4; ++m)
#pragma unroll
                for (int bj = 0; bj < 2; ++bj) { const size_t o = (size_t)(row0 + ai * HALF + m * 16) * DM + col0 + bj * 32;
                    if (basef) { bs[m][bj][0] = *(const f32x4*)(basef + o); bs[m][bj][1] = *(const f32x4*)(basef + o + 4); }
                    else { const u32x4 q = *(const u32x4*)(xb + o);
                        bs[m][bj][0] = (f32x4){__builtin_bit_cast(float, q.x << 16), __builtin_bit_cast(float, q.x & 0xffff0000u), __builtin_bit_cast(float, q.y << 16), __builtin_bit_cast(float, q.y & 0xffff0000u)};
                        bs[m][bj][1] = (f32x4){__builtin_bit_cast(float, q.z << 16), __builtin_bit_cast(float, q.z & 0xffff0000u), __builtin_bit_cast(float, q.w << 16), __builtin_bit_cast(float, q.w & 0xffff0000u)}; } }
#pragma unroll
            for (int m = 0; m < 4; ++m) { const int row = row0 + ai * HALF + m * 16; float part = 0.f;
#pragma unroll
                for (int bj = 0; bj < 2; ++bj) { const size_t o = (size_t)row * DM + col0 + bj * 32;
                    const f32x4 v0 = bs[m][bj][0] + alpha * acc[ai][bj][m][0], v1 = bs[m][bj][1] + alpha * acc[ai][bj][m][1];
                    if (out) { st16o(rO, (unsigned)o * 4u, __builtin_bit_cast(u32x4, v0)); st16o(rO, (unsigned)o * 4u + 16u, __builtin_bit_cast(u32x4, v1)); }
                    else { u32x4 w; w.x = cvt_pk_bf16(v0[0], v0[1]); w.y = cvt_pk_bf16(v0[2], v0[3]); w.z = cvt_pk_bf16(v1[0], v1[1]); w.w = cvt_pk_bf16(v1[2], v1[3]); st16(rX, (unsigned)o * 2u, w);
                        const float r0 = __builtin_bit_cast(float, w.x << 16), r1 = __builtin_bit_cast(float, w.x & 0xffff0000u), r2 = __builtin_bit_cast(float, w.y << 16), r3 = __builtin_bit_cast(float, w.y & 0xffff0000u),
                                    r4 = __builtin_bit_cast(float, w.z << 16), r5 = __builtin_bit_cast(float, w.z & 0xffff0000u), r6 = __builtin_bit_cast(float, w.w << 16), r7 = __builtin_bit_cast(float, w.w & 0xffff0000u);
                        part += (r0 * r0 + r1 * r1) + (r2 * r2 + r3 * r3) + (r4 * r4 + r5 * r5) + (r6 * r6 + r7 * r7); } }
                if (ss) { part += __shfl_xor(part, 16); part += __shfl_xor(part, 32); if (fq == 0) atomicAdd(ss + row, part); }
                __builtin_amdgcn_sched_barrier(0); }
            asm volatile("" ::: "memory"); }
    }
};
struct EpiWin {
    static constexpr bool PROBE = (PROBE2_PHASE % 9 == 3), MULTI = true, PRELOAD = false, CHAIN = false;
    bf16 *QKV, *G; const float* ss; const LAS float* tab;
    __device__ __forceinline__ void operator()(const Acc& acc, const Unit& u, int wr, int wc, int fr, int fq) const {
        const int hg = __builtin_amdgcn_readfirstlane(4 * u.pn + wc);
        const int row0 = u.pm * BM + (u.hf == 2 ? HALF : 0) + wr * 64 + fr; const int nai = u.hf ? 1 : 2;
        const int gt = hg < 8 ? 0 : hg < 16 ? 1 : (hg >= 24 && hg < 32) ? 2 : (hg >= 32 && hg < 34) ? 3 : -1;
        const float qs = (hg < 8 || (hg >= 24 && hg < 32)) ? 0.125f : 1.f;
        const bool gate = hg >= 36;
        const LAS float* gsrc = tab + (gate ? 64 * (hg - 36) : 2048 + 64 * (gt < 0 ? 0 : gt)) + 8 * fq;
        const rsrc_t rD = mk_rsrc(gate ? G : QKV);
        const unsigned dst0 = gate ? (unsigned)(row0 * NG + 64 * (hg - 36) + 8 * fq) * 2u : (unsigned)(row0 * NQKV + 64 * hg + 8 * fq) * 2u;
        const int pitch = gate ? NG : NQKV;
#pragma unroll
        for (int ai = 0; ai < 2; ++ai) if (ai < nai) {
            float rr[4];
#pragma unroll
            for (int m = 0; m < 4; ++m) rr[m] = ss[row0 + ai * HALF + m * 16];
#pragma unroll
            for (int m = 0; m < 4; ++m) { const int ro = ai * HALF + m * 16; const float r = __builtin_amdgcn_rsqf(rr[m] * (1.f / DM) + EPS);
                f32x4 z[2][2]; float q = 0.f;
#pragma unroll
                for (int bj = 0; bj < 2; ++bj)
#pragma unroll
                    for (int n = 0; n < 2; ++n) { z[bj][n] = r * acc[ai][bj][m][n]; const f32x4 t = z[bj][n]; q += (t[0] * t[0] + t[1] * t[1]) + (t[2] * t[2] + t[3] * t[3]); }
                if (gate) {
#pragma unroll
                    for (int bj = 0; bj < 2; ++bj)
#pragma unroll
                        for (int n = 0; n < 2; ++n) { const f32x4 gv = *(const LAS f32x4*)(gsrc + 32 * bj + 4 * n);
#pragma unroll
                            for (int j = 0; j < 4; ++j) z[bj][n][j] = fast_sigmoid(z[bj][n][j] + gv[j]); }
                } else if (gt >= 0) {
                    q += __shfl_xor(q, 16); q += __shfl_xor(q, 32);
                    const float hn = __builtin_amdgcn_rsqf(q * (1.f / 64.f) + EPS) * qs;
#pragma unroll
                    for (int bj = 0; bj < 2; ++bj)
#pragma unroll
                        for (int n = 0; n < 2; ++n) { const f32x4 gv = *(const LAS f32x4*)(gsrc + 32 * bj + 4 * n); z[bj][n] = z[bj][n] * hn * gv; }
                }
                const unsigned dst = dst0 + (unsigned)(ro * pitch) * 2u;
#pragma unroll
                for (int bj = 0; bj < 2; ++bj) { u32x4 w; w.x = cvt_pk_bf16(z[bj][0][0], z[bj][0][1]); w.y = cvt_pk_bf16(z[bj][0][2], z[bj][0][3]); w.z = cvt_pk_bf16(z[bj][1][0], z[bj][1][1]); w.w = cvt_pk_bf16(z[bj][1][2], z[bj][1][3]);
                    st16(rD, dst + 64u * bj, w); }
                } }
    }
};
struct EpiBranch {
    static constexpr bool PROBE = false, MULTI = false, PRELOAD = false, CHAIN = true;
    bf16* MRG; const bf16* G;
    __device__ __forceinline__ void operator()(Acc& acc, const Unit& u, int wr, int wc, int fr, int fq) const {
        const int row0 = u.pm * BM + (u.hf == 2 ? HALF : 0) + wr * 64 + fr, col0 = u.pn * BM + wc * 64 + 8 * fq; const int nai = u.hf ? 1 : 2;
        const bool second = u.sel != 0;
#pragma unroll
        for (int ai = 0; ai < 2; ++ai) if (ai < nai) {
            u32x4 ga[4][2], gb[4][2];
#pragma unroll
            for (int m = 0; m < 4; ++m)
#pragma unroll
                for (int bj = 0; bj < 2; ++bj) { const int row = row0 + ai * HALF + m * 16, c = col0 + 32 * bj;
                    gb[m][bj] = *(const u32x4*)(G + (size_t)row * NG + DM + c);
                    ga[m][bj] = (u32x4){0u, 0u, 0u, 0u}; if (!second) ga[m][bj] = *(const u32x4*)(G + (size_t)row * NG + c); }
#pragma unroll
            for (int m = 0; m < 4; ++m)
#pragma unroll
                for (int bj = 0; bj < 2; ++bj) { const size_t o = (size_t)(row0 + ai * HALF + m * 16) * DM + col0 + 32 * bj;
                    float v[8];
#pragma unroll
                    for (int e = 0; e < 8; ++e) { const unsigned aq = ga[m][bj][e >> 1], bq = gb[m][bj][e >> 1];
                        const float fa = __builtin_bit_cast(float, (e & 1) ? (aq & 0xffff0000u) : (aq << 16)), fb = fmaxf(__builtin_bit_cast(float, (e & 1) ? (bq & 0xffff0000u) : (bq << 16)), 9.5367431640625e-07f);
                        const float f = second ? fb : fa * __builtin_amdgcn_rcpf(fb);
                        v[e] = f * acc[ai][bj][m][e >> 2][e & 3]; acc[ai][bj][m][e >> 2][e & 3] = v[e]; }
                    if (second) { u32x4 w; w.x = cvt_pk_bf16(v[0], v[1]); w.y = cvt_pk_bf16(v[2], v[3]); w.z = cvt_pk_bf16(v[4], v[5]); w.w = cvt_pk_bf16(v[6], v[7]);
                        *(u32x4*)(MRG + o) = w; }
                    __builtin_amdgcn_sched_barrier(0); }
            asm volatile("" ::: "memory"); }
    }
};
}

namespace pg8 {
template <class Epi, class Sched>
__device__ __forceinline__ void gemm_ring4(LAS unsigned char* lds, const Gemm g, const Sched& S, const Epi& E) {
    int tid_ = threadIdx.x; asm volatile("" : "+v"(tid_));
    const int tid = tid_, wid = __builtin_amdgcn_readfirstlane(tid >> 6), lane = tid & 63, wr = wid >> 2, wc = wid & 3, fr = lane & 15, fq = lane >> 4;
    const int K = g.K, ns = K / 32;
    unsigned voff0;
    { const int p = lane * 16, ob = p ^ (((p >> 9) & 1) << 5), R = ob >> 6, C = (ob & 63) >> 1; voff0 = (unsigned)((32 * wid + R) * K + C) * 2u; }
    const size_t pstep = (size_t)16 * K * 2;
    const size_t hstep = (size_t)HALF * K * 2, tstep = 2 * hstep;
    const unsigned ldsw = (unsigned)wid * 2048u;
    const int loff = (fr * 64 + fq * 16) ^ ((((fr * 64 + fq * 16) >> 9) & 1) << 5);
    const int a_base = 4 * wr * 1024 + loff, b_base = 16384 + 2 * wc * 1024 + loff;
#define R4_STAGE(bufoff, gA, gB, khalf) do { _Pragma("unroll") for (int _i = 0; _i < 2; ++_i) { \
        __builtin_amdgcn_global_load_lds((const unsigned*)((const char*)(gA) + (((khalf) && wid >= 4) ? (size_t)0 : _i * pstep + voff0)), (LAS unsigned*)(lds + (bufoff) + ldsw + _i * 1024), 16, 0, 0); \
        __builtin_amdgcn_global_load_lds((const unsigned*)((const char*)(gB) + _i * pstep + voff0), (LAS unsigned*)(lds + (bufoff) + 16384 + ldsw + _i * 1024), 16, 0, 0); } } while (0)
#define R4_READ(FA, FB, bufoff, half) do { _Pragma("unroll") for (int m = 0; m < 4; ++m) { FA[0][m] = *(const LAS bf16x8*)(lds + (bufoff) + a_base + m * 1024); FA[1][m] = *(const LAS bf16x8*)(lds + (bufoff) + a_base + 8192 + m * 1024); } \
        _Pragma("unroll") for (int bj = 0; bj < 2; ++bj) _Pragma("unroll") for (int n = 0; n < 2; ++n) FB[bj][n] = *(const LAS bf16x8*)(lds + (bufoff) + b_base + bj * 8192 + n * 1024); } while (0)
#define R4_MMA(FA, FB, half) do { __builtin_amdgcn_s_setprio(1); _Pragma("unroll") for (int ai = 0; ai < 2; ++ai) if (ai == 0 || !(half)) { _Pragma("unroll") for (int bj = 0; bj < 2; ++bj) _Pragma("unroll") for (int m = 0; m < 4; ++m) _Pragma("unroll") for (int n = 0; n < 2; ++n) \
        acc[ai][bj][m][n] = __builtin_amdgcn_mfma_f32_16x16x32_bf16(FB[bj][n], FA[ai][m], acc[ai][bj][m][n], 0, 0, 0); } __builtin_amdgcn_s_setprio(0); } while (0)
    Unit cur, pun; int ui = 0, pui = 0;
    if (!S.next(0, cur)) return;
    pun = cur;
    const char* pA = (const char*)(pun.sel ? g.A2 : g.A) + (size_t)pun.pm * tstep + (pun.hf == 2 ? hstep : 0); const char* pB = (const char*)(pun.sel ? g.Bt2 : g.Bt) + (size_t)pun.pn * tstep;
    int pk = 0; bool phalf = pun.hf != 0;
#define R4_ISSUE(bufoff) do { R4_STAGE(bufoff, pA + (size_t)pk * 64, pB + (size_t)pk * 64, phalf); if (++pk == ns) { pk = 0; Unit nx_; if (S.next(pui + 1, nx_)) { ++pui; pun = nx_; \
        pA = (const char*)(pun.sel ? g.A2 : g.A) + (size_t)pun.pm * tstep + (pun.hf == 2 ? hstep : 0); pB = (const char*)(pun.sel ? g.Bt2 : g.Bt) + (size_t)pun.pn * tstep; phalf = pun.hf != 0; } } } while (0)
    f32x4 acc[2][2][4][2];
#pragma unroll
    for (int a = 0; a < 2; ++a)
#pragma unroll
        for (int b = 0; b < 2; ++b)
#pragma unroll
            for (int m = 0; m < 4; ++m)
#pragma unroll
                for (int n = 0; n < 2; ++n) acc[a][b][m][n] = (f32x4){0.f, 0.f, 0.f, 0.f};
    bf16x8 FA[2][4], FB[2][2];
    R4_ISSUE(0); R4_ISSUE(32768); R4_ISSUE(65536);
    asm volatile("s_waitcnt vmcnt(8)" ::: "memory"); __builtin_amdgcn_s_barrier();
    if (wr == 1) __builtin_amdgcn_s_barrier();
    unsigned sb = 0;
    bool chalf = cur.hf != 0;
    for (;;) {
        for (int ks = 0; ks < ns; ++ks) {
            R4_READ(FA, FB, sb, chalf); __builtin_amdgcn_sched_barrier(0); R4_ISSUE((sb + 98304u) & 131071u); sb = (sb + 32768u) & 131071u;
            asm volatile("s_waitcnt vmcnt(8)" ::: "memory"); asm volatile("s_waitcnt lgkmcnt(0)" ::: "memory");
            __builtin_amdgcn_s_barrier(); __builtin_amdgcn_sched_barrier(0);
            R4_MMA(FA, FB, chalf);
            __builtin_amdgcn_s_barrier(); __builtin_amdgcn_sched_barrier(0);
        }
        if (wr == 0) __builtin_amdgcn_s_barrier();
        E(acc, cur, wr, wc, fr, fq);
        Unit nxt; if (!S.next(ui + 1, nxt)) break;
#pragma unroll
        for (int a = 0; a < 2; ++a)
#pragma unroll
            for (int b = 0; b < 2; ++b)
#pragma unroll
                for (int m = 0; m < 4; ++m)
#pragma unroll
                    for (int n = 0; n < 2; ++n) acc[a][b][m][n] = (f32x4){0.f, 0.f, 0.f, 0.f};
        cur = nxt; ++ui; chalf = cur.hf != 0;
        if (wr == 1) __builtin_amdgcn_s_barrier();
    }
    asm volatile("s_waitcnt vmcnt(0) lgkmcnt(0)" ::: "memory");
    __builtin_amdgcn_s_barrier();
#undef R4_STAGE
#undef R4_READ
#undef R4_MMA
#undef R4_ISSUE
}
}

#define XB_TMO      128
#define XB_XCNT(j)  (256  + 64 * (j))
#define XB_XSUB(j)  (1280 + 64 * (j))
#define XB_XGEN(j)  (2304 + 64 * (j))
#define XB_TOP      3328
#define XB_TOPGEN   3392
#define XCD_BAR_WORDS 3456
#define XB_SPIN_CAP (1u << 18)
__device__ __forceinline__ unsigned xb_ld(unsigned* p)              { return __hip_atomic_load(p, __ATOMIC_RELAXED, __HIP_MEMORY_SCOPE_AGENT); }
__device__ __forceinline__ unsigned xb_add(unsigned* p, unsigned v) { return __hip_atomic_fetch_add(p, v, __ATOMIC_RELAXED, __HIP_MEMORY_SCOPE_AGENT); }
__device__ __forceinline__ unsigned xb_xcc_id() { return (unsigned)__builtin_amdgcn_s_getreg((3 << 11) | 20) & 0xFu; }
#define XB_SPIN(cond, bar) do { unsigned _sp = 0; while (cond) { __builtin_amdgcn_s_sleep(1); \
    if ((++_sp & 255u) == 0u) { if (xb_ld(&(bar)[XB_TMO])) break; if (_sp > XB_SPIN_CAP) { atomicAdd(&(bar)[XB_TMO], 1u); break; } } } } while (0)
struct XcdBarrier { unsigned* bar; unsigned x; volatile LAS unsigned* st; };
__device__ __forceinline__ XcdBarrier xcd_barrier_post(unsigned* bar, volatile LAS unsigned* st) {
    XcdBarrier b; b.bar = bar; b.x = xb_xcc_id(); b.st = st;
    if (threadIdx.x == 0) (void)xb_add(&bar[XB_XCNT(b.x)], 1u);
    return b;
}
__device__ __forceinline__ void xcd_barrier_complete(unsigned* bar, unsigned x, unsigned& nloc, unsigned& nx) {
    const unsigned G = gridDim.x * gridDim.y * gridDim.z;
    unsigned sum, cnt, mine, sp = 0u;
    for (;;) {
        sum = 0u; cnt = 0u; mine = 0u;
#pragma unroll
        for (unsigned j = 0; j < 16; ++j) { const unsigned c = xb_ld(&bar[XB_XCNT(j)]); sum += c; cnt += (c > 0u) ? 1u : 0u; mine = (j == x) ? c : mine; }
        if (sum == G) break;
        __builtin_amdgcn_s_sleep(1);
        if ((++sp & 255u) == 0u) { if (xb_ld(&bar[XB_TMO])) break; if (sp > XB_SPIN_CAP) { atomicAdd(&bar[XB_TMO], 1u); break; } }
    }
    nloc = mine > 0u ? mine : 1u; nx = cnt > 0u ? cnt : 1u;
}
__device__ __forceinline__ void xcd_barrier(const XcdBarrier& b) {
    asm volatile("s_waitcnt vmcnt(0)" ::: "memory");
    __syncthreads();
    if (threadIdx.x == 0) {
        unsigned* bar = b.bar;
        __builtin_amdgcn_s_waitcnt(0);
        unsigned nloc = b.st[0], nx = b.st[1];
        if (nloc == 0u) { xcd_barrier_complete(bar, b.x, nloc, nx); b.st[0] = nloc; b.st[1] = nx; }
        const unsigned old = xb_add(&bar[XB_XSUB(b.x)], 1u);
        const unsigned gen = old / nloc;
        if (old + 1u == (gen + 1u) * nloc) {
            __builtin_amdgcn_fence(__ATOMIC_RELEASE, "agent");
            asm volatile("s_waitcnt vmcnt(0)" ::: "memory");
            const unsigned og = xb_add(&bar[XB_TOP], 1u);
            const unsigned tg = og / nx;
            if (og + 1u == (tg + 1u) * nx) xb_add(&bar[XB_TOPGEN], 1u);
            else XB_SPIN(xb_ld(&bar[XB_TOPGEN]) == tg, bar);
            __builtin_amdgcn_fence(__ATOMIC_ACQUIRE, "agent");
            xb_add(&bar[XB_XGEN(b.x)], 1u);
            asm volatile("s_waitcnt vmcnt(0)" ::: "memory");
        } else {
            XB_SPIN(xb_ld(&bar[XB_XGEN(b.x)]) == gen, bar);
            __builtin_amdgcn_fence(__ATOMIC_ACQUIRE, "agent");
            asm volatile("s_waitcnt vmcnt(0)" ::: "memory");
        }
    }
    __syncthreads();
}

constexpr int CW_GRP = 65536;
struct GrpBarrier { unsigned* cnt; unsigned* gen; unsigned* tmo; bool cheap; };
struct NoPre { __device__ __forceinline__ void operator()() const {} };
template <class Pre = NoPre>
__device__ __forceinline__ void grp_barrier(const GrpBarrier& b, unsigned want, const Pre& pre = Pre()) {
    asm volatile("s_waitcnt vmcnt(0)" ::: "memory");
    __syncthreads();
    pre();
    if (threadIdx.x == 0) {
        __builtin_amdgcn_s_waitcnt(0);
        if (!b.cheap) { __builtin_amdgcn_fence(__ATOMIC_RELEASE, "agent"); asm volatile("s_waitcnt vmcnt(0)" ::: "memory"); }
        const unsigned old = xb_add(b.cnt, 1u);
        if (old + 1u == 32u * want) xb_add(b.gen, 1u);
        else XB_SPIN(xb_ld(b.gen) < want, b.tmo - XB_TMO);
        __builtin_amdgcn_fence(__ATOMIC_ACQUIRE, "agent");
        asm volatile("s_waitcnt vmcnt(0)" ::: "memory");
    }
    __syncthreads();
}

__device__ __forceinline__ unsigned pk2(float lo, float hi) { return f2bf(lo) | (f2bf(hi) << 16); }
__device__ __forceinline__ int perm32(int rho) { const int n = rho >> 4, i = rho & 15; return 8 * (i >> 2) + 4 * n + (i & 3); }
struct PrepItem { const float* src; const float* gn; bf16* dst; int ldw, K; };
__device__ __forceinline__ PrepItem prep_head(const float* W, int K, int N, const float* gn, bf16* WT, int it) {
    const int nsg = N / 32, kb = it / nsg, sg = it % nsg, pn = sg >> 3, bj = (sg >> 2) & 1, wc = sg & 3;
    PrepItem d; d.src = W + (size_t)(64 * kb) * N + 256 * pn + 64 * wc + 32 * bj; d.gn = gn ? gn + 64 * kb : nullptr; d.dst = WT + (size_t)(32 * sg) * K + 64 * kb; d.ldw = N; d.K = K; return d;
}
__device__ __forceinline__ PrepItem prep_gateup(const float* Wg, const float* Wu, const float* gn, bf16* WT, int it) {
    const int nsg = 2 * FF / 32, kb = it / nsg, sg = it % nsg, pn = sg >> 3, bj = (sg >> 2) & 1, wc = sg & 3;
    PrepItem d; d.src = (bj ? Wu : Wg) + (size_t)(64 * kb) * FF + 128 * pn + 32 * wc; d.gn = gn + 64 * kb; d.dst = WT + (size_t)(32 * sg) * DM + 64 * kb; d.ldw = FF; d.K = DM; return d;
}
__device__ __forceinline__ void prep_load(const PrepItem& d, f32x4 (&v)[8], int lane) {
#pragma unroll
    for (int i = 0; i < 8; ++i) v[i] = __builtin_nontemporal_load((const f32x4*)(d.src + (size_t)(8 * i + (lane >> 3)) * d.ldw + 4 * (lane & 7)));
}
__device__ __forceinline__ void prep_store(const PrepItem& d, const f32x4 (&v)[8], LAS float* scr, int lane) {
#pragma unroll
    for (int i = 0; i < 8; ++i)
#pragma unroll
        for (int j = 0; j < 4; ++j) scr[(8 * i + (lane >> 3)) * 33 + 4 * (lane & 7) + j] = v[i][j];
    const int c = lane & 7;
    f32x4 g0 = (f32x4){1.f, 1.f, 1.f, 1.f}, g1 = g0; if (d.gn) { g0 = *(const f32x4*)(d.gn + 8 * c); g1 = *(const f32x4*)(d.gn + 8 * c + 4); }
    asm volatile("s_waitcnt lgkmcnt(0)" ::: "memory");
#pragma unroll
    for (int j = 0; j < 4; ++j) { const int rr = (lane >> 3) + 8 * j; const LAS float* s = scr + (8 * c) * 33 + perm32(rr);
        u32x4 o; o.x = pk2(s[0 * 33] * g0[0], s[1 * 33] * g0[1]); o.y = pk2(s[2 * 33] * g0[2], s[3 * 33] * g0[3]); o.z = pk2(s[4 * 33] * g1[0], s[5 * 33] * g1[1]); o.w = pk2(s[6 * 33] * g1[2], s[7 * 33] * g1[3]);
        *(u32x4*)(d.dst + (size_t)rr * d.K + 8 * c) = o; }
    asm volatile("s_waitcnt lgkmcnt(0)" ::: "memory");
}
constexpr int I_1C = (DM / 64) * (2 * FF / 32), I_1D = (FF / 64) * (DM / 32), I_IN = (DM / 64) * (INW / 32), I_P = (512 / 64) * (DM / 32), I_O = (DM / 64) * (DM / 32);
constexpr int NITEMS = 2 * I_1C + 2 * I_1D + I_IN + 2 * I_P + I_O;
__device__ __forceinline__ PrepItem prep_get(const __attribute__((address_space(4))) Inputs& I, int l, unsigned char* WB, int r) {
    if (r < I_1C) return prep_gateup(I.ffn1_wg + (size_t)l * DM * FF, I.ffn1_wu + (size_t)l * DM * FF, I.ffn1_norm + l * DM, (bf16*)(WB + WO_1C), r); r -= I_1C;
    if (r < I_1C) return prep_gateup(I.ffn2_wg + (size_t)l * DM * FF, I.ffn2_wu + (size_t)l * DM * FF, I.ffn2_norm + l * DM, (bf16*)(WB + WO_2C), r); r -= I_1C;
    if (r < I_1D) return prep_head(I.ffn1_wd + (size_t)l * FF * DM, FF, DM, nullptr, (bf16*)(WB + WO_1D), r); r -= I_1D;
    if (r < I_1D) return prep_head(I.ffn2_wd + (size_t)l * FF * DM, FF, DM, nullptr, (bf16*)(WB + WO_2D), r); r -= I_1D;
    if (r < I_IN) return prep_head(I.w_in + (size_t)l * DM * INW, DM, INW, I.mix_norm + l * DM, (bf16*)(WB + WO_IN), r); r -= I_IN;
    if (r < I_P) return prep_head(I.w_br_na + (size_t)l * 512 * DM, 512, DM, nullptr, (bf16*)(WB + WO_PA), r); r -= I_P;
    if (r < I_P) return prep_head(I.w_br_sw + (size_t)l * 512 * DM, 512, DM, nullptr, (bf16*)(WB + WO_PB), r); r -= I_P;
    return prep_head(I.w_out + (size_t)l * DM * DM, DM, DM, nullptr, (bf16*)(WB + WO_OUT), r);
}
__device__ __forceinline__ float wave_sum64(float v) {
#pragma unroll
    for (int o = 1; o < 64; o <<= 1) v += __shfl_xor(v, o);
    return v;
}

__device__ __forceinline__ bf16x8 tr_pair(const LAS unsigned char* p0, const LAS unsigned char* p1) {
    typedef short v4i16 __attribute__((ext_vector_type(4)));
    const v4i16 lo = __builtin_amdgcn_ds_read_tr16_b64_v4i16((LAS v4i16*)p0), hi = __builtin_amdgcn_ds_read_tr16_b64_v4i16((LAS v4i16*)p1);
    return (bf16x8){lo[0], lo[1], lo[2], lo[3], hi[0], hi[1], hi[2], hi[3]};
}
__device__ __forceinline__ int fK(int key) { return ((key >> 1) & 1) | (((key >> 3) & 3) << 1); }
__device__ __forceinline__ int fV(int key) { return ((key >> 1) & 1) | (((key >> 3) & 1) << 1); }

template <int NS> __device__ __forceinline__ float softmax_pack(f32x4 (&S)[NS][2], bf16x8 (&pk)[NS], bool has_sink, float sink) {
    float mx = has_sink ? sink : -3.0e38f;
#pragma unroll
    for (int s = 0; s < NS; ++s)
#pragma unroll
        for (int hb = 0; hb < 2; ++hb) mx = fmaxf(mx, fmaxf(fmaxf(S[s][hb][0], S[s][hb][1]), fmaxf(S[s][hb][2], S[s][hb][3])));
    mx = fmaxf(mx, __shfl_xor(mx, 16)); mx = fmaxf(mx, __shfl_xor(mx, 32));
    const float mb = mx * 1.4426950408889634f; float l = 0.f;
#pragma unroll
    for (int s = 0; s < NS; ++s) {
#pragma unroll
        for (int hb = 0; hb < 2; ++hb)
#pragma unroll
            for (int j = 0; j < 4; ++j) { const float e = __builtin_amdgcn_exp2f(S[s][hb][j] * 1.4426950408889634f - mb); S[s][hb][j] = e; l += e; }
        u32x4 w; w.x = cvt_pk_bf16(S[s][0][0], S[s][0][1]); w.y = cvt_pk_bf16(S[s][0][2], S[s][0][3]); w.z = cvt_pk_bf16(S[s][1][0], S[s][1][1]); w.w = cvt_pk_bf16(S[s][1][2], S[s][1][3]);
        pk[s] = __builtin_bit_cast(bf16x8, w);
    }
    l += __shfl_xor(l, 16); l += __shfl_xor(l, 32);
    if (has_sink) l += __builtin_amdgcn_exp2f(sink * 1.4426950408889634f - mb);
    return 1.f / l;
}

constexpr int SW_K_OFF = 0, SW_V_OFF = 49152, SW_LUT_OFF = 98304, SW_LUT_LD = 512;
__device__ __forceinline__ void swa_unit(LAS unsigned char* lds, int b, int g, int nb, const bf16* QKV, const float* t5, const float* sink, bf16* OSW) {
    int tid_ = threadIdx.x; asm volatile("" : "+v"(tid_));
    const int tid = tid_, lane = tid & 63, wid = __builtin_amdgcn_readfirstlane(tid >> 6), fr = lane & 15, fq = lane >> 4;
#pragma unroll
    for (int i = 0; i < 6; ++i) { const int cid = tid + NTHREADS * i, key = cid >> 3, c = cid & 7, kp = 128 * (nb - 1) + key; const bool ok = kp >= 0 && kp < SEQ;
        const bf16* src = QKV + (size_t)(b * SEQ + (ok ? kp : 0)) * NQKV + 64 * g + 8 * c;
        u32x4 kv = (u32x4){0u, 0u, 0u, 0u}, vv = kv; if (ok) { kv = *(const u32x4*)(src + 2048); vv = *(const u32x4*)(src + 2176); }
        *(LAS u32x4*)(lds + SW_K_OFF + key * 128 + ((c ^ fK(key)) << 4)) = kv;
        *(LAS u32x4*)(lds + SW_V_OFF + key * 128 + (((c >> 1) ^ fV(key)) << 5) + ((c & 1) << 4)) = vv; }
    for (int idx = tid; idx < 5 * 512; idx += NTHREADS) { const int hh = idx >> 9, rel = (idx & 511) - 255;
        ((LAS float*)(lds + SW_LUT_OFF))[idx] = (hh < 4 && rel >= -128 && rel <= 128) ? t5[slow::t5_bucket(rel) * 8 + 4 * g + hh] : NEGV; }
    __syncthreads();
    const int fKl = ((fr >> 1) & 1) | ((fr >> 2) << 1);
    const LAS unsigned char* kb0 = lds + SW_K_OFF + (8 * (fr >> 2) + (fr & 3)) * 128 + ((fq ^ fKl) << 4);
    const LAS unsigned char* kb1 = lds + SW_K_OFF + (8 * (fr >> 2) + (fr & 3)) * 128 + (((4 + fq) ^ fKl) << 4);
    const int q4 = (lane & 15) >> 2, p4 = lane & 3, fVl = ((q4 >> 1) & 1) | ((fq & 1) << 1);
    const LAS unsigned char* vb = lds + SW_V_OFF + (8 * fq + q4) * 128 + p4 * 8;
    const int relbase = 8 * fq - 128 - 16 * wid - fr + 255;
    const bool first_bad = (nb == 0), last_bad = (nb == SEQ / 128 - 1);
    const size_t tokq = (size_t)b * SEQ + 128 * nb + 16 * wid + fr; const int s0 = wid >> 1;
    for (int hh = 0; hh < 4; ++hh) {
        const int h = 4 * g + hh;
        const bf16x8 q0 = *(const bf16x8*)(QKV + tokq * NQKV + 1536 + 64 * h + 8 * fq), q1 = *(const bf16x8*)(QKV + tokq * NQKV + 1536 + 64 * h + 32 + 8 * fq);
        const LAS float* lut = (const LAS float*)(lds + SW_LUT_OFF) + hh * SW_LUT_LD + relbase;
        f32x4 S[9][2]; bf16x8 pk[9];
        const LAS unsigned char* kb0s = kb0 + s0 * 4096; const LAS unsigned char* kb1s = kb1 + s0 * 4096; const LAS float* luts = lut + 32 * s0;
#pragma unroll
        for (int s = 0; s < 9; ++s) {
            const bool bad = (s0 + s < 4 && first_bad) || (s0 + s >= 8 && last_bad);
            const LAS float* lp = luts + 32 * s + (bad ? (4 - hh) * SW_LUT_LD : 0);
#pragma unroll
            for (int hb = 0; hb < 2; ++hb) { const bf16x8 k0 = *(const LAS bf16x8*)(kb0s + s * 4096 + hb * 512), k1 = *(const LAS bf16x8*)(kb1s + s * 4096 + hb * 512);
                f32x4 a = (f32x4){lp[4 * hb], lp[4 * hb + 1], lp[4 * hb + 2], lp[4 * hb + 3]};
                a = __builtin_amdgcn_mfma_f32_16x16x32_bf16(k0, q0, a, 0, 0, 0); a = __builtin_amdgcn_mfma_f32_16x16x32_bf16(k1, q1, a, 0, 0, 0);
                S[s][hb] = a; }
            if ((s & 3) == 3) asm volatile("" ::: "memory"); }
        const float rl = softmax_pack<9>(S, pk, true, sink[h]);
        f32x4 O[4];
#pragma unroll
        for (int db = 0; db < 4; ++db) O[db] = (f32x4){0.f, 0.f, 0.f, 0.f};
        const LAS unsigned char* vbs = vb + s0 * 4096;
#pragma unroll
        for (int s = 0; s < 9; ++s) {
#pragma unroll
            for (int db = 0; db < 4; ++db) { const LAS unsigned char* p = vbs + s * 4096 + ((db ^ fVl) << 5); O[db] = __builtin_amdgcn_mfma_f32_16x16x32_bf16(tr_pair(p, p + 512), pk[s], O[db], 0, 0, 0); }
            if ((s & 3) == 3) asm volatile("" ::: "memory"); }
        bf16* dst = OSW + tokq * 512 + 64 * h + 4 * fq;
#pragma unroll
        for (int db = 0; db < 4; ++db) { u32x2 w; w.x = cvt_pk_bf16(O[db][0] * rl, O[db][1] * rl); w.y = cvt_pk_bf16(O[db][2] * rl, O[db][3] * rl); *(u32x2*)(dst + 16 * db) = w; }
    }
    __syncthreads();
}

constexpr int NA_V_OFF = 0, NA_TAB_OFF = 122880;
__device__ __forceinline__ int na_rowstart(int r) { int rs = r - 4; return rs < 0 ? 0 : (rs > ROWS - 8 ? ROWS - 8 : rs); }
__device__ __forceinline__ void na_unit(LAS unsigned char* lds, int b, int h, int rq, const bf16* QKV, const float* rpb, bf16* ONA) {
    int tid_ = threadIdx.x; asm volatile("" : "+v"(tid_));
    const int tid = tid_, lane = tid & 63, wid = __builtin_amdgcn_readfirstlane(tid >> 6), fr = lane & 15, fq = lane >> 4;
    const int kr_lo = na_rowstart(8 * rq), kr_hi = na_rowstart(8 * rq + 7) + 7;
    {
        const int nrows = kr_hi - kr_lo + 1, kloc = tid >> 3, c = tid & 7;
        const bf16* src = QKV + (size_t)(b * SEQ + kr_lo * GRID_W + kloc) * NQKV + 1024 + 64 * h + 8 * c;
        LAS unsigned char* dstp = lds + NA_V_OFF + kloc * 128 + (((c >> 1) ^ fV(kloc)) << 5) + ((c & 1) << 4);
        u32x4 vv[15];
#pragma unroll
        for (int r = 0; r < 15; ++r) if (r < nrows) vv[r] = *(const u32x4*)(src + (size_t)r * GRID_W * NQKV);
#pragma unroll
        for (int r = 0; r < 15; ++r) if (r < nrows) *(LAS u32x4*)(dstp + r * (GRID_W * 128)) = vv[r];
    }
    for (int idx = tid; idx < 15 * 32; idx += NTHREADS) { const int rr_ = idx >> 5, cc_ = idx & 31; ((LAS float*)(lds + NA_TAB_OFF))[idx] = cc_ < 31 ? rpb[h * 465 + rr_ * 31 + cc_] : NEGV; }
    __syncthreads();
    const LAS float* tab = (const LAS float*)(lds + NA_TAB_OFF);
    const int q4 = (lane & 15) >> 2, p4 = lane & 3;
    bf16x8 kf[8][2][2], q0, q1;
#define NA_LOADKQ(pp, slo, shi) do { const int r_ = 8 * rq + ((pp) >> 2), cb_ = (pp) & 3, rs_ = na_rowstart(r_); int kcs_ = 16 * cb_ - 8; kcs_ = kcs_ < 0 ? 0 : (kcs_ > 32 ? 32 : kcs_); \
        const size_t tq_ = (size_t)b * SEQ + r_ * GRID_W + 16 * cb_ + fr; \
        if ((slo) == 0) { q0 = *(const bf16x8*)(QKV + tq_ * NQKV + 64 * h + 8 * fq); q1 = *(const bf16x8*)(QKV + tq_ * NQKV + 64 * h + 32 + 8 * fq); } \
        const bf16* kb_ = QKV + ((size_t)b * SEQ + rs_ * GRID_W + kcs_ + 8 * (fr >> 2) + (fr & 3)) * NQKV + 512 + 64 * h + 8 * fq;     \
        _Pragma("unroll") for (int s_ = (slo); s_ < (shi); ++s_) _Pragma("unroll") for (int hb_ = 0; hb_ < 2; ++hb_) { const bf16* kp_ = kb_ + (size_t)(s_ * GRID_W + 4 * hb_) * NQKV; kf[s_][hb_][0] = *(const bf16x8*)kp_; kf[s_][hb_][1] = *(const bf16x8*)(kp_ + 32); } } while (0)
    for (int i = 0; i < 4; ++i) {
        const int p = wid + 8 * i, r = 8 * rq + (p >> 2), cb = p & 3, rs = na_rowstart(r);
        int kcs = 16 * cb - 8; kcs = kcs < 0 ? 0 : (kcs > 32 ? 32 : kcs);
        const int qcol = 16 * cb + fr; int qcs = qcol - 8; qcs = qcs < 0 ? 0 : (qcs > 48 ? 48 : qcs);
        const size_t tokq = (size_t)b * SEQ + r * GRID_W + qcol;
        f32x4 S[8][2]; bf16x8 pk[8];
        int cidx[2][4];
#pragma unroll
        for (int hb = 0; hb < 2; ++hb)
#pragma unroll
            for (int j = 0; j < 4; ++j) { const int kcol = kcs + 8 * fq + 4 * hb + j; const bool ok = kcol >= qcs && kcol < qcs + 16; cidx[hb][j] = ok ? kcol - qcol + 15 : 31; }
        const LAS float* trow = tab + (rs - r + 7) * 32;
        NA_LOADKQ(p, 0, 8); __builtin_amdgcn_sched_barrier(0);
#pragma unroll
        for (int s = 0; s < 8; ++s) {
#pragma unroll
            for (int hb = 0; hb < 2; ++hb) {
                f32x4 a = (f32x4){0.f, 0.f, 0.f, 0.f}; a = __builtin_amdgcn_mfma_f32_16x16x32_bf16(kf[s][hb][0], q0, a, 0, 0, 0); a = __builtin_amdgcn_mfma_f32_16x16x32_bf16(kf[s][hb][1], q1, a, 0, 0, 0);
#pragma unroll
                for (int j = 0; j < 4; ++j) a[j] += trow[s * 32 + cidx[hb][j]];
                S[s][hb] = a; }
            if ((s & 3) == 3) asm volatile("" ::: "memory"); }
        const float rl = softmax_pack<8>(S, pk, false, 0.f);
        const int fVl = ((q4 >> 1) & 1) | ((((kcs >> 3) + fq) & 1) << 1);
        const LAS unsigned char* vb = lds + NA_V_OFF + ((rs - kr_lo) * GRID_W + kcs + 8 * fq + q4) * 128 + p4 * 8;
        f32x4 O[4];
#pragma unroll
        for (int db = 0; db < 4; ++db) O[db] = (f32x4){0.f, 0.f, 0.f, 0.f};
#pragma unroll
        for (int s = 0; s < 8; ++s) {
#pragma unroll
            for (int db = 0; db < 4; ++db) { const LAS unsigned char* pp = vb + s * (GRID_W * 128) + ((db ^ fVl) << 5); O[db] = __builtin_amdgcn_mfma_f32_16x16x32_bf16(tr_pair(pp, pp + 512), pk[s], O[db], 0, 0, 0); }
            if ((s & 3) == 3) asm volatile("" ::: "memory"); }
        bf16* dst = ONA + tokq * 512 + 64 * h + 4 * fq;
#pragma unroll
        for (int db = 0; db < 4; ++db) { u32x2 w; w.x = cvt_pk_bf16(O[db][0] * rl, O[db][1] * rl); w.y = cvt_pk_bf16(O[db][2] * rl, O[db][3] * rl); *(u32x2*)(dst + 16 * db) = w; }
    }
    __syncthreads();
}

constexpr int NA2_K_OFF = 0, NA2_V_OFF = 61440, NA2_TAB_OFF = 122880;
__device__ __forceinline__ void na_quad(LAS unsigned char* lds, int b, int h, int cb, const bf16* QKV, const float* rpb, bf16* ONA) {
    int tid_ = threadIdx.x; asm volatile("" : "+v"(tid_));
    const int tid = tid_, lane = tid & 63, wid = __builtin_amdgcn_readfirstlane(tid >> 6), fr = lane & 15, fq = lane >> 4;
    int kcs = 16 * cb - 8; kcs = kcs < 0 ? 0 : (kcs > 32 ? 32 : kcs);
    const int isv = tid >> 8, t8 = tid & 255, kc = t8 >> 3, c = t8 & 7;
    const bf16* src0 = QKV + (size_t)(b * SEQ + kcs + kc) * NQKV + (isv ? 1024 : 512) + 64 * h + 8 * c;
    LAS unsigned char* dstp = isv ? lds + NA2_V_OFF + kc * 128 + (((c >> 1) ^ fV(kc)) << 5) + ((c & 1) << 4) : lds + NA2_K_OFF + kc * 128 + ((c ^ fK(kc)) << 4);
    u32x4 vv[15];
#define NA2_LOAD(rq_) do { const int lo_ = na_rowstart(8 * (rq_)), n_ = na_rowstart(8 * (rq_) + 7) + 8 - lo_; \
        _Pragma("unroll") for (int r_ = 0; r_ < 15; ++r_) if (r_ < n_) vv[r_] = *(const u32x4*)(src0 + (size_t)(lo_ + r_) * GRID_W * NQKV); } while (0)
    NA2_LOAD(0);
    for (int idx = tid; idx < 15 * 32; idx += NTHREADS) { const int rr_ = idx >> 5, cc_ = idx & 31; ((LAS float*)(lds + NA2_TAB_OFF))[idx] = cc_ < 31 ? rpb[h * 465 + rr_ * 31 + cc_] : NEGV; }
    const LAS float* tab = (const LAS float*)(lds + NA2_TAB_OFF);
    const int qcol = 16 * cb + fr; int qcs = qcol - 8; qcs = qcs < 0 ? 0 : (qcs > 48 ? 48 : qcs);
    const int fKl = ((fr >> 1) & 1) | ((fr >> 2) << 1);
    const int q4 = (lane & 15) >> 2, p4 = lane & 3, fVl = ((q4 >> 1) & 1) | ((fq & 1) << 1);
    int cidx[2][4];
#pragma unroll
    for (int hb = 0; hb < 2; ++hb)
#pragma unroll
        for (int j = 0; j < 4; ++j) { const int kcol = kcs + 8 * fq + 4 * hb + j; const bool ok = kcol >= qcs && kcol < qcs + 16; cidx[hb][j] = ok ? kcol - qcol + 15 : 31; }
    for (int rq = 0; rq < 4; ++rq) {
        const int kr_lo = na_rowstart(8 * rq), nrows = na_rowstart(8 * rq + 7) + 8 - kr_lo;
#pragma unroll
        for (int r_ = 0; r_ < 15; ++r_) if (r_ < nrows) *(LAS u32x4*)(dstp + r_ * 4096) = vv[r_];
        __syncthreads();
        const int r = 8 * rq + wid, rs = na_rowstart(r), ro = rs - kr_lo;
        const size_t tokq = (size_t)b * SEQ + r * GRID_W + qcol;
        const bf16x8 q0 = *(const bf16x8*)(QKV + tokq * NQKV + 64 * h + 8 * fq), q1 = *(const bf16x8*)(QKV + tokq * NQKV + 64 * h + 32 + 8 * fq);
        __builtin_amdgcn_sched_barrier(0);
        if (rq < 3) NA2_LOAD(rq + 1);
        const LAS unsigned char* kb0 = lds + NA2_K_OFF + ro * 4096 + (8 * (fr >> 2) + (fr & 3)) * 128 + ((fq ^ fKl) << 4);
        const LAS unsigned char* kb1 = lds + NA2_K_OFF + ro * 4096 + (8 * (fr >> 2) + (fr & 3)) * 128 + (((4 + fq) ^ fKl) << 4);
        const LAS unsigned char* vb = lds + NA2_V_OFF + ro * 4096 + (8 * fq + q4) * 128 + p4 * 8;
        const LAS float* trow = tab + (rs - r + 7) * 32;
        f32x4 S[8][2]; bf16x8 pk[8];
#pragma unroll
        for (int s = 0; s < 8; ++s) {
#pragma unroll
            for (int hb = 0; hb < 2; ++hb) { const bf16x8 k0 = *(const LAS bf16x8*)(kb0 + s * 4096 + hb * 512), k1 = *(const LAS bf16x8*)(kb1 + s * 4096 + hb * 512);
                f32x4 a = (f32x4){trow[s * 32 + cidx[hb][0]], trow[s * 32 + cidx[hb][1]], trow[s * 32 + cidx[hb][2]], trow[s * 32 + cidx[hb][3]]};
                a = __builtin_amdgcn_mfma_f32_16x16x32_bf16(k0, q0, a, 0, 0, 0); a = __builtin_amdgcn_mfma_f32_16x16x32_bf16(k1, q1, a, 0, 0, 0);
                S[s][hb] = a; }
            if ((s & 3) == 3) asm volatile("" ::: "memory"); }
        const float rl = softmax_pack<8>(S, pk, false, 0.f);
        f32x4 O[4];
#pragma unroll
        for (int db = 0; db < 4; ++db) O[db] = (f32x4){0.f, 0.f, 0.f, 0.f};
#pragma unroll
        for (int s = 0; s < 8; ++s) {
#pragma unroll
            for (int db = 0; db < 4; ++db) { const LAS unsigned char* pp = vb + s * 4096 + ((db ^ fVl) << 5); O[db] = __builtin_amdgcn_mfma_f32_16x16x32_bf16(tr_pair(pp, pp + 512), pk[s], O[db], 0, 0, 0); }
            if ((s & 3) == 3) asm volatile("" ::: "memory"); }
        bf16* dst = ONA + tokq * 512 + 64 * h + 4 * fq;
#pragma unroll
        for (int db = 0; db < 4; ++db) { u32x2 w; w.x = cvt_pk_bf16(O[db][0] * rl, O[db][1] * rl); w.y = cvt_pk_bf16(O[db][2] * rl, O[db][3] * rl); *(u32x2*)(dst + 16 * db) = w; }
        __syncthreads();
    }
#undef NA2_LOAD
}

#ifndef PG8_SP2
#define PG8_SP2 true
#endif
#ifndef PG8_ALIGN
#define PG8_ALIGN true
#endif
constexpr int N_PHASES = 9 * DEPTH;
struct PhaseBar { XcdBarrier xb; GrpBarrier gb; unsigned want; int mode;
    __device__ __forceinline__ void operator()() const { if (mode == 1) xcd_barrier(xb); else if (mode == 2) grp_barrier(gb, want); }
    template <class Pre> __device__ __forceinline__ bool pre(const Pre& p) const { if (mode == 1) xcd_barrier(xb); else if (mode == 2) { grp_barrier(gb, want, p); return true; } return false; } };
struct Args { Inputs I; float* out; unsigned char* ws; int ph_lo, ph_hi, bar_region, pad; };

__global__ void __launch_bounds__(NTHREADS, 2) mega_fwd(Args args) {
    extern __shared__ __attribute__((aligned(16))) unsigned char lds_raw[];
    LAS unsigned char* lds = (LAS unsigned char*)lds_raw;
    volatile LAS unsigned* MISC = (volatile LAS unsigned*)(lds + MISC_OFF);
    const int tid = threadIdx.x, lane = tid & 63, wave = __builtin_amdgcn_readfirstlane(tid >> 6);
    const int G = gridDim.x, bx = blockIdx.x, vcu = (G % 8 == 0) ? (bx % 8) * (G / 8) + bx / 8 : bx;
    unsigned char* ws0 = args.ws;
    for (int u = tid; u < (LDS_BYTES - RING_BYTES) / 4; u += NTHREADS) ((LAS unsigned*)(lds + RING_BYTES))[u] = 0u;
    __syncthreads();
    const int lo = args.ph_lo, hi = args.ph_hi;
    XcdBarrier bar; bar.bar = (unsigned*)(ws0 + WS_CTL) + 4096 + args.bar_region * XCD_BAR_WORDS; bar.x = 0; bar.st = nullptr;
    if (hi - lo > 1) bar = xcd_barrier_post(bar.bar, MISC + 8);
    const bool use_groups0 = GROUPS && (G == 256) && lo == 0 && hi == N_PHASES;
    const int grp = bx & 7;
    GrpBarrier gbar; { unsigned* gw_ = (unsigned*)(ws0 + WS_CTL) + CW_GRP; gbar.cnt = gw_ + 512 + 64 * grp; gbar.gen = gw_ + 1024 + 64 * grp; gbar.tmo = bar.bar + XB_TMO; gbar.cheap = false;
        if (use_groups0 && tid == 0) atomicOr(gw_ + 64 * grp, 1u << (xb_xcc_id() & 15u)); }

    unsigned t_first = 0, t_prev = 0, t_sel = 0;
    if (PROBE_MASK || PROBE3 || PROBE4 || PROBE2_PHASE >= 0) t_first = t_prev = (unsigned)__builtin_amdgcn_s_memrealtime();
    for (int ph = lo; ph < hi; ++ph) {
        const int l = ph / 9, k = ph % 9;
        typedef const __attribute__((address_space(4))) Args* kargp; kargp ap = (kargp)__builtin_amdgcn_kernarg_segment_ptr(); asm volatile("" : "+s"(ap));
        const __attribute__((address_space(4))) Inputs& I = ap->I; unsigned char* ws = ap->ws; float* out = ap->out;
        int bxl = bx; asm volatile("" : "+s"(bxl));
        const bool use_groups = GROUPS && (G == 256) && ap->ph_lo == 0 && ap->ph_hi == N_PHASES;
        float* SS = (float*)(ws + WS_SS);
        bf16 *XB = (bf16*)(ws + WS_XB), *H, *QKV, *T, *MRG, *GT, *ONA, *OSW;
        if (use_groups) {
            unsigned char* sl = ws + WS_H + (size_t)grp * (21 * MiB); const size_t r0 = (size_t)grp * SEQ;
            QKV = (bf16*)sl - r0 * NQKV; GT = (bf16*)(sl + 9 * MiB) - r0 * NG; ONA = (bf16*)(sl + 17 * MiB) - r0 * 512; OSW = (bf16*)(sl + 19 * MiB) - r0 * 512;
            T = (bf16*)sl - r0 * DM; MRG = (bf16*)(sl + 4 * MiB) - r0 * DM; H = (bf16*)sl - r0 * FF;
        } else { H = (bf16*)(ws + WS_H); QKV = (bf16*)(ws + WS_QKV); T = (bf16*)(ws + WS_T); MRG = (bf16*)(ws + WS_MRG); GT = (bf16*)(ws + WS_G); ONA = (bf16*)(ws + WS_ONA); OSW = (bf16*)(ws + WS_OSW); }
        unsigned char* WB = ws + WS_W;
        unsigned p5c = 0, p5r = 0; if (PROBE5 >= 0 && ph == PROBE5) { p5c = (unsigned)__builtin_amdgcn_s_memtime(); p5r = (unsigned)__builtin_amdgcn_s_memrealtime(); }
        if (PROBE2_PHASE >= 0) { if (tid == 0) MISC[19] = (ph == PROBE2_PHASE) ? 1u : 0u; __syncthreads(); }
        float* ss0 = SS + (size_t)(3 * l + 0) * M; float* ss1 = SS + (size_t)(3 * l + 1) * M; float* ss2 = SS + (size_t)(3 * l + 2) * M; float* ss3 = SS + (size_t)(3 * l + 3) * M;
        if (k == 0 && (CODE_MASK & 1)) {
            int lane_ = tid & 63; asm volatile("" : "+v"(lane_)); const int lane = lane_;
            LAS float* scr = (LAS float*)(lds + wave * 16384);
            const int gw = vcu * NWAVES + wave, NGW = G * NWAVES;
#define PREP_GET(it_) prep_get(I, l, WB, it_)
            {   f32x4 va[8], vb[8];
                int it = gw;
                for (; it + NGW < NITEMS; it += 2 * NGW) { const PrepItem da = PREP_GET(it), db = PREP_GET(it + NGW); prep_load(da, va, lane); prep_load(db, vb, lane); prep_store(da, va, scr, lane); prep_store(db, vb, scr, lane); }
                if (it < NITEMS) { const PrepItem da = PREP_GET(it); prep_load(da, va, lane); prep_store(da, va, scr, lane); }
            }
#undef PREP_GET
            if (l == 0) {
                for (int m = gw; m < M; m += 2 * NGW) { const int m2 = m + NGW;
                    const f32x4* xr = (const f32x4*)(I.x + (size_t)m * DM) + lane; const f32x4* xr2 = (const f32x4*)(I.x + (size_t)m2 * DM) + lane; f32x4 v[4], v2[4];
#pragma unroll
                    for (int j = 0; j < 4; ++j) { v[j] = xr[64 * j]; v2[j] = xr2[64 * j]; }
                    float s = 0.f, s2 = 0.f; u32x2* o8 = (u32x2*)(XB + (size_t)m * DM) + lane; u32x2* o82 = (u32x2*)(XB + (size_t)m2 * DM) + lane;
#pragma unroll
                    for (int j = 0; j < 4; ++j) { s += (v[j][0] * v[j][0] + v[j][1] * v[j][1]) + (v[j][2] * v[j][2] + v[j][3] * v[j][3]); u32x2 w; w.x = pk2(v[j][0], v[j][1]); w.y = pk2(v[j][2], v[j][3]); o8[64 * j] = w;
                        s2 += (v2[j][0] * v2[j][0] + v2[j][1] * v2[j][1]) + (v2[j][2] * v2[j][2] + v2[j][3] * v2[j][3]); u32x2 w2; w2.x = pk2(v2[j][0], v2[j][1]); w2.y = pk2(v2[j][2], v2[j][3]); o82[64 * j] = w2; }
                    s = wave_sum64(s); s2 = wave_sum64(s2); if (lane == 0) { ss0[m] = s; ss0[m2] = s2; } }
            }
            __syncthreads();
        } else if ((k == 1 || k == 7) && (CODE_MASK & 2)) {
            pg8::Gemm g{XB, (const bf16*)(WB + (k == 1 ? WO_1C : WO_2C)), M, 2 * FF, DM, nullptr, nullptr}; pg8::StaticOrder S; S.init(M, 2 * FF, G, bxl, WGM_P1);
            pg8::EpiFfnUp E{H, k == 1 ? ss0 : ss2};
            const PhaseBar pb{bar, gbar, (unsigned)(7 * ((ph - 1) / 9) + (ph - 1) % 9), (k == 7 && ph > lo) ? (use_groups ? 2 : 1) : 0};
            pg8::gemm_phase<pg8::EpiFfnUp, PG8_ALIGN, PG8_SP2, pg8::StaticOrder, PhaseBar>(lds, g, S, E, pb);
        } else if ((k == 2 || k == 8) && (CODE_MASK & 4)) {
            pg8::Gemm g{H, (const bf16*)(WB + (k == 2 ? WO_1D : WO_2D)), M, DM, FF, nullptr, nullptr}; pg8::StaticOrder S; S.init(M, DM, G, bxl);
            const bool fin = (k == 8 && l == DEPTH - 1);
            pg8::EpiResid E{(k == 2 && l == 0) ? I.x : nullptr, fin ? out : nullptr, XB, fin ? nullptr : (k == 2 ? ss1 : ss3), 0.5f};
            const PhaseBar pb{bar, gbar, (unsigned)(7 * ((ph - 1) / 9) + (ph - 1) % 9), ph > lo ? (use_groups ? 2 : 1) : 0};
            pg8::gemm_phase<pg8::EpiResid, false, PG8_SP2, pg8::StaticOrder, PhaseBar>(lds, g, S, E, pb);
        } else if (k == 3 && (CODE_MASK & 8)) {
            LAS float* wtab = (LAS float*)(lds + RING_BYTES + 1024);
            int tl_ = tid; asm volatile("" : "+v"(tl_));
            for (int idx = tl_; idx < NG; idx += NTHREADS) wtab[idx] = I.b_gate[l * NG + idx];
            if (tl_ < 256) { const int t = tl_ >> 6, d = tl_ & 63; wtab[2048 + tl_] = (t == 0 ? I.na_q_norm : t == 1 ? I.na_k_norm : t == 2 ? I.sw_q_norm : I.sw_k_norm)[l * 64 + d]; }
            __syncthreads();
            pg8::Gemm g{XB, (const bf16*)(WB + WO_IN), M, INW, DM, nullptr, nullptr}; pg8::StaticOrder S; S.init(M, INW, G, bxl, WGM_P3);
            pg8::EpiWin E{QKV, GT, ss1, wtab};
            const PhaseBar pb{bar, gbar, (unsigned)(7 * ((ph - 1) / 9) + (ph - 1) % 9), ph > lo ? (use_groups ? 2 : 1) : 0};
            pg8::gemm_phase<pg8::EpiWin, PG8_ALIGN, PG8_SP2, pg8::StaticOrder, PhaseBar>(lds, g, S, E, pb);
        } else if (k == 4 && (CODE_MASK & 48)) {
            unsigned a_t0 = 0, a_t1 = 0; if (PROBE3) a_t0 = (unsigned)__builtin_amdgcn_s_memrealtime();
            if (CODE_MASK & 16) {
                if (NA_V2) { for (int u4 = 4 * vcu; u4 < 1024; u4 += 4 * G) na_quad(lds, u4 >> 7, (u4 >> 4) & 7, (u4 >> 2) & 3, QKV, I.na_rpb + (size_t)l * 8 * 465, ONA); }
                else for (int u = vcu; u < 256; u += G) na_unit(lds, u >> 5, (u >> 2) & 7, u & 3, QKV, I.na_rpb + (size_t)l * 8 * 465, ONA);
            }
            if (PROBE3) a_t1 = (unsigned)__builtin_amdgcn_s_memrealtime();
            if (CODE_MASK & 32) for (int u = vcu; u < 256; u += G) swa_unit(lds, u >> 5, (u >> 4) & 1, u & 15, QKV, I.t5, I.sw_sink + l * 8, OSW);
            if (PROBE3) { const unsigned a_t2 = (unsigned)__builtin_amdgcn_s_memrealtime(); if (tid == 0) { MISC[24] += a_t1 - a_t0; MISC[25] += a_t2 - a_t1; } }
        } else if (k == 5 && (CODE_MASK & 64)) {
            pg8::DualOrder S; S.S.init(M, DM, G, bxl);
            pg8::Gemm g{ONA, (const bf16*)(WB + WO_PA), M, DM, 512, OSW, (const bf16*)(WB + WO_PB)}; pg8::EpiBranch E{MRG, GT};
            const PhaseBar pb{bar, gbar, (unsigned)(7 * ((ph - 1) / 9) + (ph - 1) % 9), ph > lo ? (use_groups ? 2 : 1) : 0};
            pg8::gemm_phase<pg8::EpiBranch, false, PG8_SP2, pg8::DualOrder, PhaseBar>(lds, g, S, E, pb);
        } else if (k == 6 && (CODE_MASK & 128)) {
            pg8::Gemm g{MRG, (const bf16*)(WB + WO_OUT), M, DM, DM, nullptr, nullptr}; pg8::StaticOrder S; S.init(M, DM, G, bxl);
            pg8::EpiResid E{nullptr, nullptr, XB, ss2, 1.0f};
            const PhaseBar pb{bar, gbar, (unsigned)(7 * ((ph - 1) / 9) + (ph - 1) % 9), ph > lo ? (use_groups ? 2 : 1) : 0};
            pg8::gemm_phase<pg8::EpiResid, false, PG8_SP2, pg8::StaticOrder, PhaseBar>(lds, g, S, E, pb);
        }
        if (PROBE5 >= 0 && ph == PROBE5) { const unsigned c1 = (unsigned)__builtin_amdgcn_s_memtime(), r1 = (unsigned)__builtin_amdgcn_s_memrealtime(); if (tid == 0) { MISC[26] = c1 - p5c; MISC[27] = r1 - p5r; } }
        unsigned b_t0 = 0; if (PROBE4) b_t0 = (unsigned)__builtin_amdgcn_s_memrealtime();
        const int kn_ = (ph + 1) % 9; const bool next_resid = (ph + 1 < hi) && (kn_ == 2 || kn_ == 3 || kn_ == 5 || kn_ == 6 || kn_ == 7 || kn_ == 8);
        if ((ph + 1 < hi || PROBE_MASK) && !next_resid) {
            const bool global = !use_groups || (ph % 9 == 0) || ((ph + 1) % 9 == 0) || ph + 1 == hi;
            if (global) { xcd_barrier(bar);
                if (use_groups && ph == 0) { const unsigned mk = xb_ld((unsigned*)(ws0 + WS_CTL) + CW_GRP + 64 * grp); gbar.cheap = !FORCE_FULL_RELEASE && __builtin_popcount(mk) == 1; }
                if (use_groups && STAGGER_TICKS > 0 && (ph % 9) == 0 && ph + 1 < hi) { const unsigned long long t0_ = __builtin_amdgcn_s_memrealtime(); const unsigned long long dl_ = (unsigned long long)(STAGGER_TICKS) * (unsigned)grp;
                    while (__builtin_amdgcn_s_memrealtime() - t0_ < dl_) __builtin_amdgcn_s_sleep(4); } }
            else grp_barrier(gbar, (unsigned)(7 * (ph / 9) + ph % 9));
        }
        if (PROBE4) t_sel += (unsigned)__builtin_amdgcn_s_memrealtime() - b_t0;
        if (PROBE_MASK) { const unsigned t = (unsigned)__builtin_amdgcn_s_memrealtime(); if ((PROBE_MASK >> ph) & 1) t_sel += t - t_prev; t_prev = t; }
    }
    if (PROBE_MASK && bx == 0 && tid == 0) args.out[0] += 100.f * (float)t_sel / (float)(t_prev - t_first);
    if (PROBE5 >= 0) { xcd_barrier(bar); if (bx == 0 && tid == 0) { const float rt_ = (float)MISC[26] / (float)MISC[27]; args.out[0] += rt_ < 15.f ? 20.f : rt_ < 17.f ? 40.f : rt_ < 19.f ? 60.f : rt_ < 21.f ? 80.f : 100.f; } }
    if (PROBE4) { const unsigned t_end = (unsigned)__builtin_amdgcn_s_memrealtime(); xcd_barrier(bar); if (bx == PROBE4 - 1 && tid == 0) args.out[0] += 100.f * (float)t_sel / (float)(t_end - t_first); }
    if (PROBE3) { const unsigned t_end = (unsigned)__builtin_amdgcn_s_memrealtime(); xcd_barrier(bar); if (bx == 0 && tid == 0) args.out[0] += 100.f * (float)MISC[23 + PROBE3] / (float)(t_end - t_first); }
    if (PROBE2_PHASE >= 0) { const unsigned t_end = (unsigned)__builtin_amdgcn_s_memrealtime(); xcd_barrier(bar); if (bx == PROBE_BX && tid == 0) args.out[0] += PROBE2_SEL == 9 ? ({ const float c_ = (float)MISC[20] / (float)MISC[22]; c_ < 2300.f ? 20.f : c_ < 2500.f ? 30.f : c_ < 2700.f ? 40.f : c_ < 2900.f ? 50.f : c_ < 3100.f ? 60.f : c_ < 3300.f ? 70.f : 80.f; }) : 1000.f * (float)MISC[(PROBE2_SEL >= 5 ? 21 : 20 + (PROBE2_SEL & 3))] / (float)(t_end - t_first); }
}
#ifndef FAST_MASK
#define FAST_MASK 0x3ffffu
#endif
#ifndef MERGE_LAUNCHES
#define MERGE_LAUNCHES 1
#endif
static void launch_slow_phase(const Inputs& I, int ph, unsigned char* ws, float* out, hipStream_t stream) {
    const int l = ph / 9, k = ph % 9;
    float* SS = (float*)(ws + WS_SS);
    bf16 *XB = (bf16*)(ws + WS_XB), *H = (bf16*)(ws + WS_H), *QKV = (bf16*)(ws + WS_QKV), *T = (bf16*)(ws + WS_T), *MRG = (bf16*)(ws + WS_MRG), *G = (bf16*)(ws + WS_G),
         *ONA = (bf16*)(ws + WS_ONA), *OSW = (bf16*)(ws + WS_OSW);
    float* ss0 = SS + (size_t)(3 * l + 0) * M; float* ss1 = SS + (size_t)(3 * l + 1) * M; float* ss2 = SS + (size_t)(3 * l + 2) * M; float* ss3 = SS + (size_t)(3 * l + 3) * M;
    switch (k) {
    case 0: if (l == 0) hipLaunchKernelGGL(slow::prep_x, dim3(M), dim3(256), 0, stream, I.x, XB, SS); break;
    case 1: { slow::OpFfnUp op{DM, 0, XB, I.ffn1_wg + (size_t)l * DM * FF, I.ffn1_wu + (size_t)l * DM * FF, I.ffn1_norm + l * DM, ss0, H};
              hipLaunchKernelGGL(slow::gemm<slow::OpFfnUp>, dim3(FF / 64, M / 64), dim3(256), 0, stream, op); } break;
    case 2: { slow::OpResid op{FF, 0.5f, H, I.ffn1_wd + (size_t)l * FF * DM, l == 0 ? I.x : out, out, XB, ss1};
              hipLaunchKernelGGL(slow::gemm<slow::OpResid>, dim3(DM / 64, M / 64), dim3(256), 0, stream, op); } break;
    case 3: { slow::OpWin op{DM, 0, XB, I.w_in + (size_t)l * DM * INW, I.mix_norm + l * DM, ss1, I.b_gate + l * NG, I.na_q_norm + l * 64, I.na_k_norm + l * 64, I.sw_q_norm + l * 64, I.sw_k_norm + l * 64, QKV, G};
              hipLaunchKernelGGL(slow::gemm<slow::OpWin>, dim3(INW / 64, M / 64), dim3(256), 0, stream, op); } break;
    case 4: hipLaunchKernelGGL(slow::attn_na, dim3(M * 8 / 4), dim3(256), 0, stream, QKV, I.na_rpb + (size_t)l * 8 * 15 * 31, ONA);
            hipLaunchKernelGGL(slow::attn_sw, dim3(M * 8 / 4), dim3(256), 0, stream, QKV, I.t5, I.sw_sink + l * 8, OSW); break;
    case 5: { slow::OpBranch op{512, 0, ONA, OSW, G, I.w_br_na + (size_t)l * 512 * DM, I.w_br_sw + (size_t)l * 512 * DM, T, MRG};
              hipLaunchKernelGGL(slow::gemm<slow::OpBranch>, dim3(DM / 64, M / 64), dim3(256), 0, stream, op); } break;
    case 6: { slow::OpResid op{DM, 1.0f, MRG, I.w_out + (size_t)l * DM * DM, out, out, XB, ss2};
              hipLaunchKernelGGL(slow::gemm<slow::OpResid>, dim3(DM / 64, M / 64), dim3(256), 0, stream, op); } break;
    case 7: { slow::OpFfnUp op{DM, 0, XB, I.ffn2_wg + (size_t)l * DM * FF, I.ffn2_wu + (size_t)l * DM * FF, I.ffn2_norm + l * DM, ss2, H};
              hipLaunchKernelGGL(slow::gemm<slow::OpFfnUp>, dim3(FF / 64, M / 64), dim3(256), 0, stream, op); } break;
    default: { const bool last = (l == DEPTH - 1);
              slow::OpResid op{FF, 0.5f, H, I.ffn2_wd + (size_t)l * FF * DM, out, out, last ? nullptr : XB, last ? nullptr : ss3};
              hipLaunchKernelGGL(slow::gemm<slow::OpResid>, dim3(DM / 64, M / 64), dim3(256), 0, stream, op); } break;
    }
}

extern "C" void kernel_launch(void* const* d_in, const int* in_sizes, int n_in, void* d_out, int out_size, void* d_ws, size_t ws_size, hipStream_t stream) {
    static int grid = 0;
    if (grid == 0) {
        if (n_in != 22 || in_sizes[0] != M * DM || out_size != M * DM || ws_size < WS_END) { fprintf(stderr, "kernel_launch: unexpected shapes (n_in %d, in0 %d, out %d, ws %zu)\n", n_in, n_in > 0 ? in_sizes[0] : -1, out_size, ws_size); grid = -1; return; }
        int dev = 0, cus = 0, per_cu = 0;
        if (hipGetDevice(&dev) != hipSuccess || hipDeviceGetAttribute(&cus, hipDeviceAttributeMultiprocessorCount, dev) != hipSuccess) { grid = -1; return; }
        if (hipFuncSetAttribute((const void*)mega_fwd, hipFuncAttributeMaxDynamicSharedMemorySize, LDS_BYTES) != hipSuccess) { fprintf(stderr, "kernel_launch: hipFuncSetAttribute failed\n"); grid = -1; return; }
        if (hipOccupancyMaxActiveBlocksPerMultiprocessor(&per_cu, (const void*)mega_fwd, NTHREADS, LDS_BYTES) != hipSuccess || per_cu < 1) fprintf(stderr, "kernel_launch: occupancy query says %d blocks/CU\n", per_cu);
        (void)hipGetLastError();
        grid = cus;
    }
    if (grid < 0) return;
    Inputs I;
    { const float** p = (const float**)&I; for (int i = 0; i < 22; ++i) p[i] = (const float*)d_in[i]; }
    unsigned char* ws = (unsigned char*)d_ws; float* out = (float*)d_out;
    (void)hipMemsetAsync(ws + WS_CTL, 0, CTL_ZERO_BYTES, stream);
    int region = 0;
#ifndef HOST_PH_END
#define HOST_PH_END N_PHASES
#endif
    for (int ph = 0; ph < HOST_PH_END;) {
        if (!((FAST_MASK >> ph) & 1u)) { launch_slow_phase(I, ph, ws, out, stream); ++ph; continue; }
        int hi = ph + 1;
        if (MERGE_LAUNCHES) while (hi < HOST_PH_END && ((FAST_MASK >> hi) & 1u)) ++hi;
        Args a{};
        a.I = I; a.out = out; a.ws = ws; a.ph_lo = ph; a.ph_hi = hi; a.bar_region = region++; a.pad = 0;
        hipLaunchKernelGGL(mega_fwd, dim3(grid), dim3(NTHREADS), LDS_BYTES, stream, a);
        ph = hi;
    }
}
```

```cpp
#include <hip/hip_runtime.h>
#include <cstdio>
#include <cstdint>

constexpr int BATCH = 8, SEQ = 2048, DM = 1024, DEPTH = 2, FF = 2816;
constexpr int M = BATCH * SEQ;
constexpr int GRID_W = 64, ROWS = SEQ / GRID_W;
constexpr int NQKV = 2304, NG = 2048, INW = NQKV + NG;
constexpr float EPS = 1e-6f;
constexpr float NEGV = -1e30f;

typedef unsigned short bf16;

constexpr size_t MiB = 1u << 20;
constexpr size_t WS_CTL = 0;
constexpr size_t WS_SS = 512 * 1024;
constexpr size_t CTL_ZERO_BYTES = 1 * MiB;
constexpr size_t WS_W = 1 * MiB;
constexpr size_t WS_XB = 47 * MiB;
constexpr size_t WS_H = 79 * MiB;
constexpr size_t WS_QKV = 79 * MiB;
constexpr size_t WS_T = 79 * MiB;
constexpr size_t WS_MRG = 111 * MiB;
constexpr size_t WS_G = 151 * MiB;
constexpr size_t WS_ONA = 215 * MiB;
constexpr size_t WS_OSW = 231 * MiB;
constexpr size_t WS_END = 247 * MiB;

__device__ __forceinline__ unsigned f2bf(float f) { unsigned u = __builtin_bit_cast(unsigned, f); return (u + 0x7fffu + ((u >> 16) & 1u)) >> 16; }
__device__ __forceinline__ float bf2f(unsigned b) { return __builtin_bit_cast(float, b << 16); }
__device__ __forceinline__ float bfr(float f) { return bf2f(f2bf(f)); }

struct Inputs {
    const float *x, *ffn1_norm, *ffn1_wg, *ffn1_wu, *ffn1_wd, *mix_norm, *w_in, *b_gate, *na_q_norm, *na_k_norm, *na_rpb, *sw_q_norm, *sw_k_norm, *sw_sink, *t5,
                *w_br_na, *w_br_sw, *w_out, *ffn2_norm, *ffn2_wg, *ffn2_wu, *ffn2_wd;
};

namespace slow {
template <class Op> __global__ void __launch_bounds__(256) gemm(Op op) {
    constexpr int NS = Op::NSEL;
    __shared__ float As[NS][16][68];
    __shared__ float Bs[NS][16][68];
    __shared__ float Cs[NS][64][65];
    const int tid = threadIdx.x, tx = tid & 15, ty = tid >> 4;
    const int m0 = blockIdx.y * 64, n0 = blockIdx.x * 64;
    float acc[NS][4][4];
#pragma unroll
    for (int s = 0; s < NS; ++s)
#pragma unroll
        for (int i = 0; i < 4; ++i)
#pragma unroll
            for (int j = 0; j < 4; ++j) acc[s][i][j] = 0.f;
    for (int k0 = 0; k0 < op.K; k0 += 16) {
#pragma unroll
        for (int s = 0; s < NS; ++s) {
#pragma unroll
            for (int e = 0; e < 4; ++e) {
                const int idx = tid + e * 256;
                { const int kk = idx & 15, mm = idx >> 4; As[s][kk][mm] = op.a(s, m0 + mm, k0 + kk); }
                { const int nn = idx & 63, kk = idx >> 6; Bs[s][kk][nn] = op.b(s, k0 + kk, n0 + nn); }
            }
        }
        __syncthreads();
#pragma unroll
        for (int kk = 0; kk < 16; ++kk) {
#pragma unroll
            for (int s = 0; s < NS; ++s) {
                float av[4], bv[4];
#pragma unroll
                for (int i = 0; i < 4; ++i) { av[i] = As[s][kk][ty * 4 + i]; bv[i] = Bs[s][kk][tx * 4 + i]; }
#pragma unroll
                for (int i = 0; i < 4; ++i)
#pragma unroll
                    for (int j = 0; j < 4; ++j) acc[s][i][j] += av[i] * bv[j];
            }
        }
        __syncthreads();
    }
#pragma unroll
    for (int s = 0; s < NS; ++s)
#pragma unroll
        for (int i = 0; i < 4; ++i)
#pragma unroll
            for (int j = 0; j < 4; ++j) Cs[s][ty * 4 + i][tx * 4 + j] = acc[s][i][j];
    __syncthreads();
    op.epi(m0, n0, Cs, tid);
}

struct OpFfnUp {
    static constexpr int NSEL = 2; int K, pad_;
    const bf16* xb; const float *wg, *wu, *gn, *ss; bf16* H;
    __device__ float a(int, int m, int k) const { return bf2f(xb[(size_t)m * DM + k]); }
    __device__ float b(int s, int k, int n) const { return bfr(gn[k] * (s ? wu : wg)[(size_t)k * FF + n]); }
    __device__ void epi(int m0, int n0, float (*Cs)[64][65], int tid) const {
        for (int e = tid; e < 4096; e += 256) { const int i = e >> 6, j = e & 63, m = m0 + i;
            const float r = rsqrtf(ss[m] * (1.f / DM) + EPS), zg = r * Cs[0][i][j], zu = r * Cs[1][i][j];
            const float h = zg / (1.f + __expf(-zg)) * zu;
            H[(size_t)m * FF + n0 + j] = (bf16)f2bf(h); }
    }
};
struct OpResid {
    static constexpr int NSEL = 1; int K; float alpha;
    const bf16* A; const float* w; const float* base; float* out; bf16* xb; float* ss;
    __device__ float a(int, int m, int k) const { return bf2f(A[(size_t)m * K + k]); }
    __device__ float b(int, int k, int n) const { return bfr(w[(size_t)k * DM + n]); }
    __device__ void epi(int m0, int n0, float (*Cs)[64][65], int tid) const {
        for (int e = tid; e < 4096; e += 256) { const int i = e >> 6, j = e & 63; const size_t o = (size_t)(m0 + i) * DM + n0 + j;
            const float v = base[o] + alpha * Cs[0][i][j]; out[o] = v; Cs[0][i][j] = v; if (xb) xb[o] = (bf16)f2bf(v); }
        __syncthreads();
        if (ss && tid < 64) { float s = 0.f; for (int j = 0; j < 64; ++j) s += Cs[0][tid][j] * Cs[0][tid][j]; atomicAdd(ss + m0 + tid, s); }
    }
};
struct OpWin {
    static constexpr int NSEL = 1; int K, pad_;
    const bf16* xb; const float *w, *gn, *ss, *bg, *naq, *nak, *swq, *swk; bf16 *QKV, *G;
    __device__ float a(int, int m, int k) const { return bf2f(xb[(size_t)m * DM + k]); }
    __device__ float b(int, int k, int n) const { return bfr(gn[k] * w[(size_t)k * INW + n]); }
    __device__ void epi(int m0, int n0, float (*Cs)[64][65], int tid) const {
        __shared__ float hn[64];
        const int hg = n0 >> 6;
        const float* gain = hg < 8 ? naq : hg < 16 ? nak : (hg >= 24 && hg < 32) ? swq : (hg >= 32 && hg < 34) ? swk : nullptr;
        const float qs = (hg < 8 || (hg >= 24 && hg < 32)) ? 0.125f : 1.f;
        for (int e = tid; e < 4096; e += 256) { const int i = e >> 6, j = e & 63; Cs[0][i][j] *= rsqrtf(ss[m0 + i] * (1.f / DM) + EPS); }
        __syncthreads();
        if (tid < 64) { float s = 0.f; for (int j = 0; j < 64; ++j) s += Cs[0][tid][j] * Cs[0][tid][j]; hn[tid] = rsqrtf(s * (1.f / 64.f) + EPS); }
        __syncthreads();
        for (int e = tid; e < 4096; e += 256) { const int i = e >> 6, j = e & 63, m = m0 + i; float z = Cs[0][i][j];
            if (hg < 36) { if (gain) z = z * hn[i] * gain[j] * qs; QKV[(size_t)m * NQKV + n0 + j] = (bf16)f2bf(z); }
            else { const int c = n0 - NQKV + j; z = 1.f / (1.f + __expf(-(z + bg[c]))); G[(size_t)m * NG + c] = (bf16)f2bf(z); } }
    }
};
struct OpBranch {
    static constexpr int NSEL = 2; int K, pad_;
    const bf16 *ONA, *OSW, *G; const float *pa, *pb; bf16 *T, *MRG;
    __device__ float a(int s, int m, int k) const { return bf2f((s ? OSW : ONA)[(size_t)m * 512 + k]); }
    __device__ float b(int s, int k, int n) const { return bfr((s ? pb : pa)[(size_t)k * DM + n]); }
    __device__ void epi(int m0, int n0, float (*Cs)[64][65], int tid) const {
        for (int e = tid; e < 4096; e += 256) { const int i = e >> 6, j = e & 63, m = m0 + i, n = n0 + j;
            const float gA = bf2f(G[(size_t)m * NG + n]), gB = bf2f(G[(size_t)m * NG + DM + n]);
            const float t = bfr(gA * Cs[0][i][j]); T[(size_t)m * DM + n] = (bf16)f2bf(t);
            MRG[(size_t)m * DM + n] = (bf16)f2bf(t + gB * Cs[1][i][j]); }
    }
};

__global__ void __launch_bounds__(256) prep_x(const float* x, bf16* xb, float* ss) {
    __shared__ float red[256];
    const int m = blockIdx.x, tid = threadIdx.x; float s = 0.f;
    for (int c = tid; c < DM; c += 256) { const float v = x[(size_t)m * DM + c]; xb[(size_t)m * DM + c] = (bf16)f2bf(v); s += v * v; }
    red[tid] = s; __syncthreads();
    for (int o = 128; o > 0; o >>= 1) { if (tid < o) red[tid] += red[tid + o]; __syncthreads(); }
    if (tid == 0) ss[m] = red[0];
}

__device__ __forceinline__ float wave_sum(float v) {
#pragma unroll
    for (int o = 1; o < 64; o <<= 1) v += __shfl_xor(v, o);
    return v;
}
__device__ __forceinline__ float wave_max(float v) {
#pragma unroll
    for (int o = 1; o < 64; o <<= 1) v = fmaxf(v, __shfl_xor(v, o));
    return v;
}
__global__ void __launch_bounds__(256) attn_na(const bf16* QKV, const float* rpb  , bf16* ONA) {
    __shared__ float sc[4][128];
    const int w = threadIdx.x >> 6, lane = threadIdx.x & 63;
    const int item = blockIdx.x * 4 + w;
    const int h = item & 7, tok = item >> 3, b = tok / SEQ, t = tok % SEQ, r = t / GRID_W, c = t % GRID_W;
    int rs = r - 4; rs = rs < 0 ? 0 : (rs > ROWS - 8 ? ROWS - 8 : rs);
    int cs = c - 8; cs = cs < 0 ? 0 : (cs > GRID_W - 16 ? GRID_W - 16 : cs);
    const float q = bf2f(QKV[(size_t)tok * NQKV + h * 64 + lane]);
    for (int j = 0; j < 128; ++j) { const int kr = rs + (j >> 4), kc = cs + (j & 15); const size_t kt = (size_t)b * SEQ + kr * GRID_W + kc;
        float s = wave_sum(q * bf2f(QKV[kt * NQKV + 512 + h * 64 + lane]));
        s += rpb[(h * 15 + (kr - r + 7)) * 31 + (kc - c + 15)];
        if (lane == 0) sc[w][j] = s; }
    __syncthreads();
    const float s0 = sc[w][lane], s1 = sc[w][lane + 64];
    const float mx = wave_max(fmaxf(s0, s1));
    const float e0 = __expf(s0 - mx), e1 = __expf(s1 - mx);
    const float l = wave_sum(e0 + e1);
    __syncthreads();
    sc[w][lane] = bfr(e0); sc[w][lane + 64] = bfr(e1);
    __syncthreads();
    float o = 0.f;
    for (int j = 0; j < 128; ++j) { const int kr = rs + (j >> 4), kc = cs + (j & 15); const size_t kt = (size_t)b * SEQ + kr * GRID_W + kc;
        o += sc[w][j] * bf2f(QKV[kt * NQKV + 1024 + h * 64 + lane]); }
    ONA[(size_t)tok * 512 + h * 64 + lane] = (bf16)f2bf(o / l);
}
__device__ __forceinline__ int t5_bucket(int rel) {
    const int n = rel < 0 ? -rel : rel; int v;
    if (n < 8) v = n; else { int k = 0; while (64 * (2 << k) <= n * n) ++k; v = 8 + k; v = v > 15 ? 15 : v; }
    return (rel > 0 ? 16 : 0) + v;
}
__global__ void __launch_bounds__(256) attn_sw(const bf16* QKV, const float* t5  , const float* sink  , bf16* OSW) {
    __shared__ float sc[4][320];
    const int w = threadIdx.x >> 6, lane = threadIdx.x & 63;
    const int item = blockIdx.x * 4 + w;
    const int h = item & 7, tok = item >> 3, b = tok / SEQ, t = tok % SEQ, g = h >> 2;
    const int k0 = t - 128 < 0 ? 0 : t - 128, k1 = t + 128 > SEQ - 1 ? SEQ - 1 : t + 128, nk = k1 - k0 + 1;
    const float q = bf2f(QKV[(size_t)tok * NQKV + 1536 + h * 64 + lane]);
    for (int j = 0; j < nk; ++j) { const size_t kt = (size_t)b * SEQ + k0 + j;
        float s = wave_sum(q * bf2f(QKV[kt * NQKV + 2048 + g * 64 + lane]));
        s += t5[t5_bucket(k0 + j - t) * 8 + h];
        if (lane == 0) sc[w][j] = s; }
    __syncthreads();
    const float snk = sink[h];
    float mx = snk; for (int j = lane; j < nk; j += 64) mx = fmaxf(mx, sc[w][j]);
    mx = wave_max(mx);
    float l = 0.f; for (int j = lane; j < nk; j += 64) { const float e = __expf(sc[w][j] - mx); l += e; sc[w][j] = bfr(e); }
    l = wave_sum(l) + __expf(snk - mx);
    __syncthreads();
    float o = 0.f;
    for (int j = 0; j < nk; ++j) { const size_t kt = (size_t)b * SEQ + k0 + j; o += sc[w][j] * bf2f(QKV[kt * NQKV + 2176 + g * 64 + lane]); }
    OSW[(size_t)tok * 512 + h * 64 + lane] = (bf16)f2bf(o / l);
}
}

#ifndef CODE_MASK
#define CODE_MASK 255
#endif
#ifndef PROBE2_PHASE
#define PROBE2_PHASE -1
#endif
#ifndef PROBE2_SEL
#define PROBE2_SEL 0
#endif
#ifndef PROBE3
#define PROBE3 0
#endif
#ifndef GROUPS
#define GROUPS 1
#endif
#ifndef PROBE5
#define PROBE5 -1
#endif
#ifndef RELAX_WAITS
#define RELAX_WAITS 1
#endif
#ifndef NA_V2
#define NA_V2 1
#endif
#ifndef RING4
#define RING4 0
#endif
#ifndef FULL_LINES
#define FULL_LINES 0
#endif
#ifndef NT_BASE
#define NT_BASE 0
#endif
#ifndef FORCE_FULL_RELEASE
#define FORCE_FULL_RELEASE 0
#endif
#ifndef WGM_P3
#define WGM_P3 PG8_WGM
#endif
#ifndef WGM_P1
#define WGM_P1 PG8_WGM
#endif
#ifndef STAGGER_TICKS
#define STAGGER_TICKS 0
#endif
#ifndef PROBE4
#define PROBE4 0
#endif
#ifndef PROBE_MASK
#define PROBE_MASK 0
#endif
#define LAS __attribute__((address_space(3)))
#define GAS __attribute__((address_space(1)))
typedef short bf16x8 __attribute__((ext_vector_type(8)));
typedef short s16x4 __attribute__((ext_vector_type(4)));
typedef float f32x4 __attribute__((ext_vector_type(4)));
typedef unsigned u32x4 __attribute__((ext_vector_type(4)));
typedef unsigned u32x2 __attribute__((ext_vector_type(2)));
typedef GAS unsigned gu32;

constexpr int NWAVES = 8, NTHREADS = 512;
constexpr int LDS_BYTES = 147456;
constexpr int RING_BYTES = 131072;
constexpr int MISC_OFF = RING_BYTES + 320;

constexpr size_t WO_1C = 0;
constexpr size_t WO_1D = WO_1C + (size_t)2 * FF * DM * 2;
constexpr size_t WO_IN = WO_1D + (size_t)DM * FF * 2;
constexpr size_t WO_PA = WO_IN + (size_t)INW * DM * 2;
constexpr size_t WO_PB = WO_PA + (size_t)DM * 512 * 2;
constexpr size_t WO_OUT = WO_PB + (size_t)DM * 512 * 2;
constexpr size_t WO_2C = WO_OUT + (size_t)DM * DM * 2;
constexpr size_t WO_2D = WO_2C + (size_t)2 * FF * DM * 2;
constexpr size_t WO_END = WO_2D + (size_t)DM * FF * 2;
static_assert(WS_W + WO_END <= WS_XB, "weight region");

typedef float f32x2_t __attribute__((ext_vector_type(2))); typedef __bf16 bf16x2_t __attribute__((ext_vector_type(2)));
__device__ __forceinline__ unsigned cvt_pk_bf16(float lo, float hi) { const f32x2_t v = {lo, hi}; const bf16x2_t b = __builtin_convertvector(v, bf16x2_t); return __builtin_bit_cast(unsigned, b); }
#ifndef WT_STORES
#define WT_STORES 0
#endif
typedef __amdgpu_buffer_rsrc_t rsrc_t;
__device__ __forceinline__ rsrc_t mk_rsrc(const void* p) { return __builtin_amdgcn_make_buffer_rsrc((void*)p, 0, 0x7fffffff, 0x00020000); }
__device__ __forceinline__ void st16(rsrc_t r, unsigned byteoff, u32x4 v) { __builtin_amdgcn_raw_buffer_store_b128(v, r, (int)byteoff, 0, (WT_STORES & 1) ? 16 : 0); }
__device__ __forceinline__ void st16o(rsrc_t r, unsigned byteoff, u32x4 v) { __builtin_amdgcn_raw_buffer_store_b128(v, r, (int)byteoff, 0, (WT_STORES & 2) ? 16 : (WT_STORES & 4) ? 2 : 0); }
__device__ __forceinline__ float fast_sigmoid(float z) { return __builtin_amdgcn_rcpf(1.f + __builtin_amdgcn_exp2f(-1.4426950408889634f * z)); }
__device__ __forceinline__ float rs_row(const float* ss, int row) { return __builtin_amdgcn_rsqf(ss[row] * (1.f / DM) + EPS); }

namespace pg8 {
#ifndef PG8_WGM
#define PG8_WGM 4
#endif
constexpr int BM = 256, BK = 64, HALF = 128, HTB = HALF * BK * 2, STAGE_BYTES = 8 * HTB, NXCD = 8, WGM = PG8_WGM;
__host__ __device__ __forceinline__ int lds_byte(int r, int c) { const int st = (r >> 4) * 2 + (c >> 5), rr = r & 15, cc = c & 31, ob = rr * 64 + cc * 2; return st * 1024 + (ob ^ (((ob >> 9) & 1) << 5)); }
__host__ __device__ __forceinline__ void stage_rc(int b, int& R, int& C) { const int st = b / 1024, sb = b % 1024, swz = sb ^ (((sb >> 9) & 1) << 5); R = (st >> 1) * 16 + swz / 64; C = (st & 1) * 32 + (swz % 64) / 2; }
struct Unit { int pm, pn, hf, sel; };
struct Gemm { const bf16* A; const bf16* Bt; int M, N, K; const bf16* A2; const bf16* Bt2; };
struct StaticOrder {
    int nM, nN, nwg, G, c, nfull, ntot, wgm;
    __device__ void init(int M_, int N_, int G_, int c_, int wgm_ = WGM) { nM = M_ / BM; nN = N_ / BM; nwg = nM * nN; G = G_; c = c_; wgm = wgm_;
        const int rem = nwg % G; const bool split = rem > 0 && 2 * rem <= G && (nwg % NXCD) == 0 && (rem % NXCD) == 0 && (G % NXCD) == 0;
        nfull = split ? nwg - rem : nwg; ntot = split ? nfull + 2 * rem : nwg; }
    __device__ bool next(int i, Unit& u) const {
        const long L = (long)i * G + c; if (L >= ntot) return false;
        const int q = nwg / NXCD, r = nwg % NXCD; int wgid;
        if (L < nfull) { const int xcd = (int)L % NXCD, off = (int)L / NXCD; wgid = (xcd < r ? xcd * (q + 1) : r * (q + 1) + (xcd - r) * q) + off; u.hf = 0; }
        else { const int Lp = (int)L - nfull, xcd = Lp % NXCD, idx = Lp / NXCD; wgid = xcd * q + nfull / NXCD + (idx >> 1); u.hf = 1 + (idx & 1); }
        const int nig = wgm * nN, gid = wgid / nig, fm = gid * wgm, gsz = (nM - fm) < wgm ? (nM - fm) : wgm;
        u.pm = fm + ((wgid % nig) % gsz); u.pn = (wgid % nig) / gsz; u.sel = 0; return true;
    }
};
struct DualOrder { StaticOrder S;
    __device__ bool next(int i, Unit& u) const { if (!S.next(i >> 1, u)) return false; u.sel = i & 1; return true; } };
struct NoBar { __device__ __forceinline__ void operator()() const {} };
template <class Epi, bool ALIGN_EPI, bool SP2, class Sched = StaticOrder, class Bar = NoBar>
__device__ __forceinline__ void gemm_phase(LAS unsigned char* lds, const Gemm g, const Sched& S, const Epi& E, const Bar& PB = Bar()) {
    int tid_ = threadIdx.x; asm volatile("" : "+v"(tid_));
    const int tid = tid_, wid = __builtin_amdgcn_readfirstlane(tid >> 6), lane = tid & 63, wr = wid >> 2, wc = wid & 3, fr = lane & 15, fq = lane >> 4;
    const int K = g.K, nt = K / BK;
    unsigned voff[2];
#pragma unroll
    for (int i = 0; i < 2; ++i) { int R, C; if (FULL_LINES) { R = 8 * (wid + 8 * i) + (lane >> 3); C = 8 * ((lane & 7) ^ (lane >> 3)); } else stage_rc(tid * 16 + i * 8192, R, C); voff[i] = (unsigned)(R * K + C) * 2u; }
    const size_t kstep = (size_t)(BK * 2), hstep = (size_t)HALF * K * 2, tstep = 2 * hstep;
    const unsigned ldsw = (unsigned)wid * 1024u;
    const int aoff = FULL_LINES ? (8 * wr + (fr >> 3)) * 1024 + (fr & 7) * 128 + ((fq ^ (fr & 7)) << 4) : lds_byte(wr * 64 + fr, fq * 8);
    const int boff = FULL_LINES ? (4 * wc + (fr >> 3)) * 1024 + (fr & 7) * 128 + ((fq ^ (fr & 7)) << 4) : lds_byte(wc * 32 + fr, fq * 8);
    const int aoff1 = FULL_LINES ? (aoff ^ 64) : aoff + 1024, boff1 = FULL_LINES ? (boff ^ 64) : boff + 1024;
#define PG8_SA(b, h) (((b) * 2 + (h)) * HTB)
#define PG8_SB(b, h) ((4 + (b) * 2 + (h)) * HTB)
#define PG8_STAGE(bufoff, gbase) do { _Pragma("unroll") for (int _i = 0; _i < 2; ++_i) \
        __builtin_amdgcn_global_load_lds((const unsigned*)((const char*)(gbase) + voff[_i]), (LAS unsigned*)(lds + (bufoff) + ldsw + _i * 8192), 16, 0, 0); } while (0)
#define PG8_STAGEH(bufoff, gbase, hflag) do { _Pragma("unroll") for (int _i = 0; _i < 2; ++_i) \
        __builtin_amdgcn_global_load_lds((const unsigned*)((const char*)(gbase) + ((hflag) ? 0u : voff[_i])), (LAS unsigned*)(lds + (bufoff) + ldsw + _i * 8192), 16, 0, 0); } while (0)
#define PG8_LDA(dst, b, h) do { _Pragma("unroll") for (int m = 0; m < 4; ++m) _Pragma("unroll") for (int k = 0; k < 2; ++k) dst[m][k] = *(const LAS bf16x8*)(lds + PG8_SA(b, h) + (k ? aoff1 : aoff) + m * 2048); } while (0)
#define PG8_LDB(dst, b, h) do { _Pragma("unroll") for (int n = 0; n < 2; ++n) _Pragma("unroll") for (int k = 0; k < 2; ++k) dst[n][k] = *(const LAS bf16x8*)(lds + PG8_SB(b, h) + (k ? boff1 : boff) + n * 2048); } while (0)
#define PG8_MMA(ai, bj, At, Bt) do { __builtin_amdgcn_s_setprio(1); _Pragma("unroll") for (int m = 0; m < 4; ++m) _Pragma("unroll") for (int n = 0; n < 2; ++n) _Pragma("unroll") for (int k = 0; k < 2; ++k) \
        acc[ai][bj][m][n] = __builtin_amdgcn_mfma_f32_16x16x32_bf16(Bt[n][k], At[m][k], acc[ai][bj][m][n], 0, 0, 0); __builtin_amdgcn_s_setprio(0); } while (0)
#define PG8_WAIT_V(n) asm volatile("s_waitcnt vmcnt(" #n ")" ::: "memory")
#define PG8_WAIT_L(n) asm volatile("s_waitcnt lgkmcnt(" #n ")" ::: "memory")
#define PG8_BAR __builtin_amdgcn_s_barrier()
#define PG8_SCHED __builtin_amdgcn_sched_barrier(0)
#define PG8_TRIP(W12) do { \
            const bool last = (t == nt - 2); \
            const char* a1 = cA + (size_t)(t + 1) * kstep; \
            const char* a2 = last ? nA : cA + (size_t)(t + 2) * kstep; const char* b2 = last ? nB : cB + (size_t)(t + 2) * kstep; \
            const char* a3 = a2 + kstep; const char* b3 = b2 + kstep; const size_t hs2 = last ? nhs : chs; \
            PG8_LDB(B0, 0, 0); PG8_LDB(B1, 0, 1); PG8_SCHED; PG8_LDA(At, 0, 0); PG8_STAGEH(PG8_SA(1, 1), a1 + chs, chalf_st); \
            W12; PG8_WAIT_L(0); PG8_BAR; PG8_MMA(0, 0, At, B0); PG8_MMA(0, 1, At, B1); PG8_BAR; PG8_SCHED; \
            if (!chalf) { PG8_LDA(At, 0, 1); } PG8_STAGE(PG8_SB(0, 0), b2); PG8_STAGE(PG8_SB(0, 1), b2 + hstep); PG8_STAGE(PG8_SA(0, 0), a2); \
            W12; PG8_WAIT_L(0); PG8_BAR; if (!chalf) { PG8_MMA(1, 0, At, B0); PG8_MMA(1, 1, At, B1); } PG8_BAR; PG8_SCHED; \
            PG8_LDB(B0, 1, 0); PG8_LDB(B1, 1, 1); PG8_SCHED; PG8_LDA(At, 1, 0); if (last) chalf_st = nhalf_st; PG8_STAGEH(PG8_SA(0, 1), a2 + hs2, chalf_st); \
            PG8_WAIT_V(8); PG8_WAIT_L(0); PG8_BAR; PG8_MMA(0, 0, At, B0); PG8_MMA(0, 1, At, B1); PG8_BAR; PG8_SCHED; \
            if (!chalf) { PG8_LDA(At, 1, 1); } PG8_STAGE(PG8_SB(1, 0), b3); PG8_STAGE(PG8_SB(1, 1), b3 + hstep); PG8_STAGE(PG8_SA(1, 0), a3); \
            PG8_WAIT_V(8); PG8_WAIT_L(0); PG8_BAR; if (!chalf) { PG8_MMA(1, 0, At, B0); PG8_MMA(1, 1, At, B1); } PG8_BAR; PG8_SCHED; \
        } while (0)
    unsigned pe0 = 0, pe1 = 0; if (PROBE2_PHASE >= 0 && Epi::PROBE && PROBE2_SEL == 6) pe0 = (unsigned)__builtin_amdgcn_s_memrealtime();
    Unit cur, nxt; int ui = 0;
    if (!S.next(0, cur)) { PB(); return; }
    unsigned pa0 = 0, pa1 = 0, pa2 = 0;
    f32x4 acc[2][2][4][2];
    if constexpr (Epi::PRELOAD) { E.preload(acc, cur, wr, wc, fr, fq); PB(); E.prescale(acc); }
    else { PB();
#pragma unroll
    for (int a = 0; a < 2; ++a)
#pragma unroll
        for (int b = 0; b < 2; ++b)
#pragma unroll
            for (int m = 0; m < 4; ++m)
#pragma unroll
                for (int n = 0; n < 2; ++n) acc[a][b][m][n] = (f32x4){0.f, 0.f, 0.f, 0.f};
    }
    bf16x8 At[4][2], B0[2][2], B1[2][2];
    const char* cA = (const char*)(cur.sel ? g.A2 : g.A) + (size_t)cur.pm * tstep + (cur.hf == 2 ? hstep : 0); const char* cB = (const char*)(cur.sel ? g.Bt2 : g.Bt) + (size_t)cur.pn * tstep;
    size_t chs = cur.hf ? 0 : hstep;
    bool chalf_st = cur.hf != 0;
    if constexpr (SP2) {
        PG8_STAGE(PG8_SB(0, 0), cB); PG8_STAGE(PG8_SB(0, 1), cB + hstep); PG8_STAGE(PG8_SA(0, 0), cA); PG8_STAGEH(PG8_SA(0, 1), cA + chs, chalf_st);
        if (wr == 1) PG8_BAR;
        PG8_WAIT_V(2); PG8_BAR;
        PG8_STAGE(PG8_SB(1, 0), cB + kstep); PG8_STAGE(PG8_SA(1, 0), cA + kstep); PG8_STAGE(PG8_SB(1, 1), cB + hstep + kstep);
        PG8_WAIT_V(6); PG8_BAR;
    } else {
        PG8_STAGE(PG8_SB(0, 0), cB); PG8_STAGE(PG8_SA(0, 0), cA); PG8_STAGE(PG8_SB(0, 1), cB + hstep); PG8_STAGEH(PG8_SA(0, 1), cA + chs, chalf_st);
        if (wr == 1) PG8_BAR;
        PG8_WAIT_V(4); PG8_BAR;
        PG8_STAGE(PG8_SB(1, 0), cB + kstep); PG8_STAGE(PG8_SA(1, 0), cA + kstep); PG8_STAGE(PG8_SB(1, 1), cB + hstep + kstep);
        PG8_WAIT_V(6); PG8_BAR;
    }
    for (;;) {
        const bool has_next = S.next(ui + 1, nxt);
        if (PROBE2_PHASE >= 0 && Epi::PROBE && PROBE2_SEL == 6 && ui == 0) pe1 = (unsigned)__builtin_amdgcn_s_memrealtime();
        unsigned p_t0 = 0; if (PROBE2_PHASE >= 0 && Epi::PROBE) p_t0 = PROBE2_SEL == 9 ? (unsigned)__builtin_amdgcn_s_memtime() : (unsigned)__builtin_amdgcn_s_memrealtime();
        const char* nA = has_next ? (const char*)(nxt.sel ? g.A2 : g.A) + (size_t)nxt.pm * tstep + (nxt.hf == 2 ? hstep : 0) : cA; const char* nB = has_next ? (const char*)(nxt.sel ? g.Bt2 : g.Bt) + (size_t)nxt.pn * tstep : cB;
        const size_t nhs = has_next ? (nxt.hf ? 0 : hstep) : chs; const bool chalf = cur.hf != 0;
        const bool nhalf_st = has_next ? (nxt.hf != 0) : chalf_st;
        static_assert(SP2, "only the two-super-phase loop is kept");
        { int t = 0;
          if constexpr (RELAX_WAITS && Epi::MULTI) { if (ui > 0) { PG8_TRIP((void)0); t = 2; } }
          for (; t < nt; t += 2) { PG8_TRIP(PG8_WAIT_V(8)); } }
        unsigned p_t1 = 0; if (PROBE2_PHASE >= 0 && Epi::PROBE) p_t1 = PROBE2_SEL == 9 ? (unsigned)__builtin_amdgcn_s_memtime() : (unsigned)__builtin_amdgcn_s_memrealtime();
        if constexpr (ALIGN_EPI) { if (wr == 0) PG8_BAR; }
        E(acc, cur, wr, wc, fr, fq);
        if (PROBE2_PHASE >= 0 && Epi::PROBE) { const unsigned p_t3 = (unsigned)__builtin_amdgcn_s_memrealtime(); pa0 += p_t1 - p_t0; if (ui == 0 && PROBE2_SEL < 5) pa1 = p_t1 - p_t0; pa2 += (PROBE2_SEL == 9) ? (unsigned)(cur.hf ? 0 : nt) : p_t3 - p_t1; }
        if (!has_next) break;
        if (!Epi::CHAIN || cur.sel != 0) {
#pragma unroll
        for (int a = 0; a < 2; ++a)
#pragma unroll
            for (int b = 0; b < 2; ++b)
#pragma unroll
                for (int m = 0; m < 4; ++m)
#pragma unroll
                    for (int n = 0; n < 2; ++n) acc[a][b][m][n] = (f32x4){0.f, 0.f, 0.f, 0.f};
        }
        cur = nxt; cA = nA; cB = nB; chs = nhs; ++ui;
        if constexpr (ALIGN_EPI) { if (wr == 1) PG8_BAR; }
    }
    unsigned pd0 = 0; if (PROBE2_PHASE >= 0 && Epi::PROBE && PROBE2_SEL == 5) pd0 = (unsigned)__builtin_amdgcn_s_memrealtime();
    PG8_WAIT_V(0);
    if constexpr (!ALIGN_EPI) { if (wr == 0) PG8_BAR; }
    PG8_BAR;
    if (PROBE2_PHASE >= 0 && Epi::PROBE && PROBE2_SEL == 5) pa1 = (unsigned)__builtin_amdgcn_s_memrealtime() - pd0;
    if (PROBE2_PHASE >= 0 && Epi::PROBE && PROBE2_SEL == 6) pa1 = pe1 - pe0;
    if (PROBE2_PHASE >= 0 && Epi::PROBE) { volatile LAS unsigned* PM = (volatile LAS unsigned*)(lds + MISC_OFF); if (tid == 0 && PM[19]) { PM[20] = pa0; PM[21] = pa1; PM[22] = pa2; } }
#undef PG8_TRIP
#undef PG8_SA
#undef PG8_SB
#undef PG8_STAGE
#undef PG8_LDA
#undef PG8_LDB
#undef PG8_MMA
#undef PG8_WAIT_V
#undef PG8_WAIT_L
#undef PG8_BAR
#undef PG8_SCHED
}

typedef f32x4 Acc[2][2][4][2];
struct EpiFfnUp {
    static constexpr bool PROBE = (PROBE2_PHASE % 9 == 1) || (PROBE2_PHASE % 9 == 7), MULTI = true, PRELOAD = false, CHAIN = false;
    bf16* H; const float* ss;
    __device__ __forceinline__ void operator()(const Acc& acc, const Unit& u, int wr, int wc, int fr, int fq) const {
        const int row0 = u.pm * BM + (u.hf == 2 ? HALF : 0) + wr * 64 + fr, col0 = u.pn * 128 + wc * 32 + 8 * fq; const int nai = u.hf ? 1 : 2;
        const rsrc_t rH = mk_rsrc(H);
        float rr[2][4];
#pragma unroll
        for (int ai = 0; ai < 2; ++ai)
#pragma unroll
            for (int m = 0; m < 4; ++m) rr[ai][m] = ss[row0 + (ai < nai ? ai : 0) * HALF + m * 16];
#pragma unroll
        for (int ai = 0; ai < 2; ++ai) if (ai < nai)
#pragma unroll
            for (int m = 0; m < 4; ++m) { const int row = row0 + ai * HALF + m * 16; const float r = __builtin_amdgcn_rsqf(rr[ai][m] * (1.f / DM) + EPS); float h[8];
                typedef float f32x2 __attribute__((ext_vector_type(2)));
                const float r2 = r * r, cneg = -1.4426950408889634f * r;
#pragma unroll
                for (int n = 0; n < 2; ++n)
#pragma unroll
                    for (int jp = 0; jp < 2; ++jp) { const f32x2 gg = (f32x2){acc[ai][0][m][n][2 * jp], acc[ai][0][m][n][2 * jp + 1]}, uu = (f32x2){acc[ai][1][m][n][2 * jp], acc[ai][1][m][n][2 * jp + 1]};
                        const f32x2 pp = (gg * uu) * r2, ea = gg * cneg; const f32x2 dd = (f32x2){__builtin_amdgcn_exp2f(ea[0]), __builtin_amdgcn_exp2f(ea[1])} + 1.f;
                        const f32x2 hh = pp * (f32x2){__builtin_amdgcn_rcpf(dd[0]), __builtin_amdgcn_rcpf(dd[1])}; h[4 * n + 2 * jp] = hh[0]; h[4 * n + 2 * jp + 1] = hh[1]; }
                u32x4 w; w.x = cvt_pk_bf16(h[0], h[1]); w.y = cvt_pk_bf16(h[2], h[3]); w.z = cvt_pk_bf16(h[4], h[5]); w.w = cvt_pk_bf16(h[6], h[7]);
                st16(rH, (unsigned)(row * FF + col0) * 2u, w); }
    }
};
struct EpiResid {
    static constexpr bool PROBE = (PROBE2_PHASE % 9 == 2) || (PROBE2_PHASE % 9 == 6) || (PROBE2_PHASE % 9 == 8), MULTI = false, PRELOAD = false, CHAIN = false;
    const float* basef; float* out; bf16* xb; float* ss; float alpha;
    __device__ __forceinline__ void operator()(const Acc& acc, const Unit& u, int wr, int wc, int fr, int fq) const {
        const int row0 = u.pm * BM + wr * 64 + fr, col0 = u.pn * BM + wc * 64 + 8 * fq;
        const rsrc_t rO = mk_rsrc(out), rX = mk_rsrc(xb);
#pragma unroll
        for (int ai = 0; ai < 2; ++ai) {
            f32x4 bs[4][2][2];
#pragma unroll
            for (int m = 0; m < 4; ++m)
#pragma unroll
                for (int bj = 0; bj < 2; ++bj) { const size_t o = (size_t)(row0 + ai * HALF + m * 16) * DM + col0 + bj * 32;
                    if (basef) { bs[m][bj][0] = *(const f32x4*)(basef + o); bs[m][bj][1] = *(const f32x4*)(basef + o + 4); }
                    else { const u32x4 q = *(const u32x4*)(xb + o);
                        bs[m][bj][0] = (f32x4){__builtin_bit_cast(float, q.x << 16), __builtin_bit_cast(float, q.x & 0xffff0000u), __builtin_bit_cast(float, q.y << 16), __builtin_bit_cast(float, q.y & 0xffff0000u)};
                        bs[m][bj][1] = (f32x4){__builtin_bit_cast(float, q.z << 16), __builtin_bit_cast(float, q.z & 0xffff0000u), __builtin_bit_cast(float, q.w << 16), __builtin_bit_cast(float, q.w & 0xffff0000u)}; } }
#pragma unroll
            for (int m = 0; m < 4; ++m) { const int row = row0 + ai * HALF + m * 16; float part = 0.f;
#pragma unroll
                for (int bj = 0; bj < 2; ++bj) { const size_t o = (size_t)row * DM + col0 + bj * 32;
                    const f32x4 v0 = bs[m][bj][0] + alpha * acc[ai][bj][m][0], v1 = bs[m][bj][1] + alpha * acc[ai][bj][m][1];
                    if (out) { st16o(rO, (unsigned)o * 4u, __builtin_bit_cast(u32x4, v0)); st16o(rO, (unsigned)o * 4u + 16u, __builtin_bit_cast(u32x4, v1)); }
                    else { u32x4 w; w.x = cvt_pk_bf16(v0[0], v0[1]); w.y = cvt_pk_bf16(v0[2], v0[3]); w.z = cvt_pk_bf16(v1[0], v1[1]); w.w = cvt_pk_bf16(v1[2], v1[3]); st16(rX, (unsigned)o * 2u, w);
                        const float r0 = __builtin_bit_cast(float, w.x << 16), r1 = __builtin_bit_cast(float, w.x & 0xffff0000u), r2 = __builtin_bit_cast(float, w.y << 16), r3 = __builtin_bit_cast(float, w.y & 0xffff0000u),
                                    r4 = __builtin_bit_cast(float, w.z << 16), r5 = __builtin_bit_cast(float, w.z & 0xffff0000u), r6 = __builtin_bit_cast(float, w.w << 16), r7 = __builtin_bit_cast(float, w.w & 0xffff0000u);
                        part += (r0 * r0 + r1 * r1) + (r2 * r2 + r3 * r3) + (r4 * r4 + r5 * r5) + (r6 * r6 + r7 * r7); } }
                if (ss) { part += __shfl_xor(part, 16); part += __shfl_xor(part, 32); if (fq == 0) atomicAdd(ss + row, part); }
                __builtin_amdgcn_sched_barrier(0); }
            asm volatile("" ::: "memory"); }
    }
};
struct EpiWin {
    static constexpr bool PROBE = (PROBE2_PHASE % 9 == 3), MULTI = true, PRELOAD = false, CHAIN = false;
    bf16 *QKV, *G; const float* ss; const LAS float* tab;
    __device__ __forceinline__ void operator()(const Acc& acc, const Unit& u, int wr, int wc, int fr, int fq) const {
        const int hg = __builtin_amdgcn_readfirstlane(4 * u.pn + wc);
        const int row0 = u.pm * BM + (u.hf == 2 ? HALF : 0) + wr * 64 + fr; const int nai = u.hf ? 1 : 2;
        const int gt = hg < 8 ? 0 : hg < 16 ? 1 : (hg >= 24 && hg < 32) ? 2 : (hg >= 32 && hg < 34) ? 3 : -1;
        const float qs = (hg < 8 || (hg >= 24 && hg < 32)) ? 0.125f : 1.f;
        const bool gate = hg >= 36;
        const LAS float* gsrc = tab + (gate ? 64 * (hg - 36) : 2048 + 64 * (gt < 0 ? 0 : gt)) + 8 * fq;
        const rsrc_t rD = mk_rsrc(gate ? G : QKV);
        const unsigned dst0 = gate ? (unsigned)(row0 * NG + 64 * (hg - 36) + 8 * fq) * 2u : (unsigned)(row0 * NQKV + 64 * hg + 8 * fq) * 2u;
        const int pitch = gate ? NG : NQKV;
#pragma unroll
        for (int ai = 0; ai < 2; ++ai) if (ai < nai) {
            float rr[4];
#pragma unroll
            for (int m = 0; m < 4; ++m) rr[m] = ss[row0 + ai * HALF + m * 16];
#pragma unroll
            for (int m = 0; m < 4; ++m) { const int ro = ai * HALF + m * 16; const float r = __builtin_amdgcn_rsqf(rr[m] * (1.f / DM) + EPS);
                f32x4 z[2][2]; float q = 0.f;
#pragma unroll
                for (int bj = 0; bj < 2; ++bj)
#pragma unroll
                    for (int n = 0; n < 2; ++n) { z[bj][n] = r * acc[ai][bj][m][n]; const f32x4 t = z[bj][n]; q += (t[0] * t[0] + t[1] * t[1]) + (t[2] * t[2] + t[3] * t[3]); }
                if (gate) {
#pragma unroll
                    for (int bj = 0; bj < 2; ++bj)
#pragma unroll
                        for (int n = 0; n < 2; ++n) { const f32x4 gv = *(const LAS f32x4*)(gsrc + 32 * bj + 4 * n);
#pragma unroll
                            for (int j = 0; j < 4; ++j) z[bj][n][j] = fast_sigmoid(z[bj][n][j] + gv[j]); }
                } else if (gt >= 0) {
                    q += __shfl_xor(q, 16); q += __shfl_xor(q, 32);
                    const float hn = __builtin_amdgcn_rsqf(q * (1.f / 64.f) + EPS) * qs;
#pragma unroll
                    for (int bj = 0; bj < 2; ++bj)
#pragma unroll
                        for (int n = 0; n < 2; ++n) { const f32x4 gv = *(const LAS f32x4*)(gsrc + 32 * bj + 4 * n); z[bj][n] = z[bj][n] * hn * gv; }
                }
                const unsigned dst = dst0 + (unsigned)(ro * pitch) * 2u;
#pragma unroll
                for (int bj = 0; bj < 2; ++bj) { u32x4 w; w.x = cvt_pk_bf16(z[bj][0][0], z[bj][0][1]); w.y = cvt_pk_bf16(z[bj][0][2], z[bj][0][3]); w.z = cvt_pk_bf16(z[bj][1][0], z[bj][1][1]); w.w = cvt_pk_bf16(z[bj][1][2], z[bj][1][3]);
                    st16(rD, dst + 64u * bj, w); }
                } }
    }
};
struct EpiBranch {
    static constexpr bool PROBE = false, MULTI = false, PRELOAD = false, CHAIN = true;
    bf16* MRG; const bf16* G;
    __device__ __forceinline__ void operator()(Acc& acc, const Unit& u, int wr, int wc, int fr, int fq) const {
        const int row0 = u.pm * BM + (u.hf == 2 ? HALF : 0) + wr * 64 + fr, col0 = u.pn * BM + wc * 64 + 8 * fq; const int nai = u.hf ? 1 : 2;
        const bool second = u.sel != 0;
#pragma unroll
        for (int ai = 0; ai < 2; ++ai) if (ai < nai) {
            u32x4 ga[4][2], gb[4][2];
#pragma unroll
            for (int m = 0; m < 4; ++m)
#pragma unroll
                for (int bj = 0; bj < 2; ++bj) { const int row = row0 + ai * HALF + m * 16, c = col0 + 32 * bj;
                    gb[m][bj] = *(const u32x4*)(G + (size_t)row * NG + DM + c);
                    ga[m][bj] = (u32x4){0u, 0u, 0u, 0u}; if (!second) ga[m][bj] = *(const u32x4*)(G + (size_t)row * NG + c); }
#pragma unroll
            for (int m = 0; m < 4; ++m)
#pragma unroll
                for (int bj = 0; bj < 2; ++bj) { const size_t o = (size_t)(row0 + ai * HALF + m * 16) * DM + col0 + 32 * bj;
                    float v[8];
#pragma unroll
                    for (int e = 0; e < 8; ++e) { const unsigned aq = ga[m][bj][e >> 1], bq = gb[m][bj][e >> 1];
                        const float fa = __builtin_bit_cast(float, (e & 1) ? (aq & 0xffff0000u) : (aq << 16)), fb = fmaxf(__builtin_bit_cast(float, (e & 1) ? (bq & 0xffff0000u) : (bq << 16)), 9.5367431640625e-07f);
                        const float f = second ? fb : fa * __builtin_amdgcn_rcpf(fb);
                        v[e] = f * acc[ai][bj][m][e >> 2][e & 3]; acc[ai][bj][m][e >> 2][e & 3] = v[e]; }
                    if (second) { u32x4 w; w.x = cvt_pk_bf16(v[0], v[1]); w.y = cvt_pk_bf16(v[2], v[3]); w.z = cvt_pk_bf16(v[4], v[5]); w.w = cvt_pk_bf16(v[6], v[7]);
                        *(u32x4*)(MRG + o) = w; }
                    __builtin_amdgcn_sched_barrier(0); }
            asm volatile("" ::: "memory"); }
    }
};
}

namespace pg8 {
template <class Epi, class Sched>
__device__ __forceinline__ void gemm_ring4(LAS unsigned char* lds, const Gemm g, const Sched& S, const Epi& E) {
    int tid_ = threadIdx.x; asm volatile("" : "+v"(tid_));
    const int tid = tid_, wid = __builtin_amdgcn_readfirstlane(tid >> 6), lane = tid & 63, wr = wid >> 2, wc = wid & 3, fr = lane & 15, fq = lane >> 4;
    const int K = g.K, ns = K / 32;
    unsigned voff0;
    { const int p = lane * 16, ob = p ^ (((p >> 9) & 1) << 5), R = ob >> 6, C = (ob & 63) >> 1; voff0 = (unsigned)((32 * wid + R) * K + C) * 2u; }
    const size_t pstep = (size_t)16 * K * 2;
    const size_t hstep = (size_t)HALF * K * 2, tstep = 2 * hstep;
    const unsigned ldsw = (unsigned)wid * 2048u;
    const int loff = (fr * 64 + fq * 16) ^ ((((fr * 64 + fq * 16) >> 9) & 1) << 5);
    const int a_base = 4 * wr * 1024 + loff, b_base = 16384 + 2 * wc * 1024 + loff;
#define R4_STAGE(bufoff, gA, gB, khalf) do { _Pragma("unroll") for (int _i = 0; _i < 2; ++_i) { \
        __builtin_amdgcn_global_load_lds((const unsigned*)((const char*)(gA) + (((khalf) && wid >= 4) ? (size_t)0 : _i * pstep + voff0)), (LAS unsigned*)(lds + (bufoff) + ldsw + _i * 1024), 16, 0, 0); \
        __builtin_amdgcn_global_load_lds((const unsigned*)((const char*)(gB) + _i * pstep + voff0), (LAS unsigned*)(lds + (bufoff) + 16384 + ldsw + _i * 1024), 16, 0, 0); } } while (0)
#define R4_READ(FA, FB, bufoff, half) do { _Pragma("unroll") for (int m = 0; m < 4; ++m) { FA[0][m] = *(const LAS bf16x8*)(lds + (bufoff) + a_base + m * 1024); FA[1][m] = *(const LAS bf16x8*)(lds + (bufoff) + a_base + 8192 + m * 1024); } \
        _Pragma("unroll") for (int bj = 0; bj < 2; ++bj) _Pragma("unroll") for (int n = 0; n < 2; ++n) FB[bj][n] = *(const LAS bf16x8*)(lds + (bufoff) + b_base + bj * 8192 + n * 1024); } while (0)
#define R4_MMA(FA, FB, half) do { __builtin_amdgcn_s_setprio(1); _Pragma("unroll") for (int ai = 0; ai < 2; ++ai) if (ai == 0 || !(half)) { _Pragma("unroll") for (int bj = 0; bj < 2; ++bj) _Pragma("unroll") for (int m = 0; m < 4; ++m) _Pragma("unroll") for (int n = 0; n < 2; ++n) \
        acc[ai][bj][m][n] = __builtin_amdgcn_mfma_f32_16x16x32_bf16(FB[bj][n], FA[ai][m], acc[ai][bj][m][n], 0, 0, 0); } __builtin_amdgcn_s_setprio(0); } while (0)
    Unit cur, pun; int ui = 0, pui = 0;
    if (!S.next(0, cur)) return;
    pun = cur;
    const char* pA = (const char*)(pun.sel ? g.A2 : g.A) + (size_t)pun.pm * tstep + (pun.hf == 2 ? hstep : 0); const char* pB = (const char*)(pun.sel ? g.Bt2 : g.Bt) + (size_t)pun.pn * tstep;
    int pk = 0; bool phalf = pun.hf != 0;
#define R4_ISSUE(bufoff) do { R4_STAGE(bufoff, pA + (size_t)pk * 64, pB + (size_t)pk * 64, phalf); if (++pk == ns) { pk = 0; Unit nx_; if (S.next(pui + 1, nx_)) { ++pui; pun = nx_; \
        pA = (const char*)(pun.sel ? g.A2 : g.A) + (size_t)pun.pm * tstep + (pun.hf == 2 ? hstep : 0); pB = (const char*)(pun.sel ? g.Bt2 : g.Bt) + (size_t)pun.pn * tstep; phalf = pun.hf != 0; } } } while (0)
    f32x4 acc[2][2][4][2];
#pragma unroll
    for (int a = 0; a < 2; ++a)
#pragma unroll
        for (int b = 0; b < 2; ++b)
#pragma unroll
            for (int m = 0; m < 4; ++m)
#pragma unroll
                for (int n = 0; n < 2; ++n) acc[a][b][m][n] = (f32x4){0.f, 0.f, 0.f, 0.f};
    bf16x8 FA[2][4], FB[2][2];
    R4_ISSUE(0); R4_ISSUE(32768); R4_ISSUE(65536);
    asm volatile("s_waitcnt vmcnt(8)" ::: "memory"); __builtin_amdgcn_s_barrier();
    if (wr == 1) __builtin_amdgcn_s_barrier();
    unsigned sb = 0;
    bool chalf = cur.hf != 0;
    for (;;) {
        for (int ks = 0; ks < ns; ++ks) {
            R4_READ(FA, FB, sb, chalf); __builtin_amdgcn_sched_barrier(0); R4_ISSUE((sb + 98304u) & 131071u); sb = (sb + 32768u) & 131071u;
            asm volatile("s_waitcnt vmcnt(8)" ::: "memory"); asm volatile("s_waitcnt lgkmcnt(0)" ::: "memory");
            __builtin_amdgcn_s_barrier(); __builtin_amdgcn_sched_barrier(0);
            R4_MMA(FA, FB, chalf);
            __builtin_amdgcn_s_barrier(); __builtin_amdgcn_sched_barrier(0);
        }
        if (wr == 0) __builtin_amdgcn_s_barrier();
        E(acc, cur, wr, wc, fr, fq);
        Unit nxt; if (!S.next(ui + 1, nxt)) break;
#pragma unroll
        for (int a = 0; a < 2; ++a)
#pragma unroll
            for (int b = 0; b < 2; ++b)
#pragma unroll
                for (int m = 0; m < 4; ++m)
#pragma unroll
                    for (int n = 0; n < 2; ++n) acc[a][b][m][n] = (f32x4){0.f, 0.f, 0.f, 0.f};
        cur = nxt; ++ui; chalf = cur.hf != 0;
        if (wr == 1) __builtin_amdgcn_s_barrier();
    }
    asm volatile("s_waitcnt vmcnt(0) lgkmcnt(0)" ::: "memory");
    __builtin_amdgcn_s_barrier();
#undef R4_STAGE
#undef R4_READ
#undef R4_MMA
#undef R4_ISSUE
}
}

#define XB_TMO      128
#define XB_XCNT(j)  (256  + 64 * (j))
#define XB_XSUB(j)  (1280 + 64 * (j))
#define XB_XGEN(j)  (2304 + 64 * (j))
#define XB_TOP      3328
#define XB_TOPGEN   3392
#define XCD_BAR_WORDS 3456
#define XB_SPIN_CAP (1u << 18)
__device__ __forceinline__ unsigned xb_ld(unsigned* p)              { return __hip_atomic_load(p, __ATOMIC_RELAXED, __HIP_MEMORY_SCOPE_AGENT); }
__device__ __forceinline__ unsigned xb_add(unsigned* p, unsigned v) { return __hip_atomic_fetch_add(p, v, __ATOMIC_RELAXED, __HIP_MEMORY_SCOPE_AGENT); }
__device__ __forceinline__ unsigned xb_xcc_id() { return (unsigned)__builtin_amdgcn_s_getreg((3 << 11) | 20) & 0xFu; }
#define XB_SPIN(cond, bar) do { unsigned _sp = 0; while (cond) { __builtin_amdgcn_s_sleep(1); \
    if ((++_sp & 255u) == 0u) { if (xb_ld(&(bar)[XB_TMO])) break; if (_sp > XB_SPIN_CAP) { atomicAdd(&(bar)[XB_TMO], 1u); break; } } } } while (0)
struct XcdBarrier { unsigned* bar; unsigned x; volatile LAS unsigned* st; };
__device__ __forceinline__ XcdBarrier xcd_barrier_post(unsigned* bar, volatile LAS unsigned* st) {
    XcdBarrier b; b.bar = bar; b.x = xb_xcc_id(); b.st = st;
    if (threadIdx.x == 0) (void)xb_add(&bar[XB_XCNT(b.x)], 1u);
    return b;
}
__device__ __forceinline__ void xcd_barrier_complete(unsigned* bar, unsigned x, unsigned& nloc, unsigned& nx) {
    const unsigned G = gridDim.x * gridDim.y * gridDim.z;
    unsigned sum, cnt, mine, sp = 0u;
    for (;;) {
        sum = 0u; cnt = 0u; mine = 0u;
#pragma unroll
        for (unsigned j = 0; j < 16; ++j) { const unsigned c = xb_ld(&bar[XB_XCNT(j)]); sum += c; cnt += (c > 0u) ? 1u : 0u; mine = (j == x) ? c : mine; }
        if (sum == G) break;
        __builtin_amdgcn_s_sleep(1);
        if ((++sp & 255u) == 0u) { if (xb_ld(&bar[XB_TMO])) break; if (sp > XB_SPIN_CAP) { atomicAdd(&bar[XB_TMO], 1u); break; } }
    }
    nloc = mine > 0u ? mine : 1u; nx = cnt > 0u ? cnt : 1u;
}
__device__ __forceinline__ void xcd_barrier(const XcdBarrier& b) {
    asm volatile("s_waitcnt vmcnt(0)" ::: "memory");
    __syncthreads();
    if (threadIdx.x == 0) {
        unsigned* bar = b.bar;
        __builtin_amdgcn_s_waitcnt(0);
        unsigned nloc = b.st[0], nx = b.st[1];
        if (nloc == 0u) { xcd_barrier_complete(bar, b.x, nloc, nx); b.st[0] = nloc; b.st[1] = nx; }
        const unsigned old = xb_add(&bar[XB_XSUB(b.x)], 1u);
        const unsigned gen = old / nloc;
        if (old + 1u == (gen + 1u) * nloc) {
            __builtin_amdgcn_fence(__ATOMIC_RELEASE, "agent");
            asm volatile("s_waitcnt vmcnt(0)" ::: "memory");
            const unsigned og = xb_add(&bar[XB_TOP], 1u);
            const unsigned tg = og / nx;
            if (og + 1u == (tg + 1u) * nx) xb_add(&bar[XB_TOPGEN], 1u);
            else XB_SPIN(xb_ld(&bar[XB_TOPGEN]) == tg, bar);
            __builtin_amdgcn_fence(__ATOMIC_ACQUIRE, "agent");
            xb_add(&bar[XB_XGEN(b.x)], 1u);
            asm volatile("s_waitcnt vmcnt(0)" ::: "memory");
        } else {
            XB_SPIN(xb_ld(&bar[XB_XGEN(b.x)]) == gen, bar);
            __builtin_amdgcn_fence(__ATOMIC_ACQUIRE, "agent");
            asm volatile("s_waitcnt vmcnt(0)" ::: "memory");
        }
    }
    __syncthreads();
}

constexpr int CW_GRP = 65536;
struct GrpBarrier { unsigned* cnt; unsigned* gen; unsigned* tmo; bool cheap; };
__device__ __forceinline__ void grp_barrier(const GrpBarrier& b, unsigned want) {
    asm volatile("s_waitcnt vmcnt(0)" ::: "memory");
    __syncthreads();
    if (threadIdx.x == 0) {
        __builtin_amdgcn_s_waitcnt(0);
        if (!b.cheap) { __builtin_amdgcn_fence(__ATOMIC_RELEASE, "agent"); asm volatile("s_waitcnt vmcnt(0)" ::: "memory"); }
        const unsigned old = xb_add(b.cnt, 1u);
        if (old + 1u == 32u * want) xb_add(b.gen, 1u);
        else XB_SPIN(xb_ld(b.gen) < want, b.tmo - XB_TMO);
        __builtin_amdgcn_fence(__ATOMIC_ACQUIRE, "agent");
        asm volatile("s_waitcnt vmcnt(0)" ::: "memory");
    }
    __syncthreads();
}

__device__ __forceinline__ unsigned pk2(float lo, float hi) { return f2bf(lo) | (f2bf(hi) << 16); }
__device__ __forceinline__ int perm32(int rho) { const int n = rho >> 4, i = rho & 15; return 8 * (i >> 2) + 4 * n + (i & 3); }
struct PrepItem { const float* src; const float* gn; bf16* dst; int ldw, K; };
__device__ __forceinline__ PrepItem prep_head(const float* W, int K, int N, const float* gn, bf16* WT, int it) {
    const int nsg = N / 32, kb = it / nsg, sg = it % nsg, pn = sg >> 3, bj = (sg >> 2) & 1, wc = sg & 3;
    PrepItem d; d.src = W + (size_t)(64 * kb) * N + 256 * pn + 64 * wc + 32 * bj; d.gn = gn ? gn + 64 * kb : nullptr; d.dst = WT + (size_t)(32 * sg) * K + 64 * kb; d.ldw = N; d.K = K; return d;
}
__device__ __forceinline__ PrepItem prep_gateup(const float* Wg, const float* Wu, const float* gn, bf16* WT, int it) {
    const int nsg = 2 * FF / 32, kb = it / nsg, sg = it % nsg, pn = sg >> 3, bj = (sg >> 2) & 1, wc = sg & 3;
    PrepItem d; d.src = (bj ? Wu : Wg) + (size_t)(64 * kb) * FF + 128 * pn + 32 * wc; d.gn = gn + 64 * kb; d.dst = WT + (size_t)(32 * sg) * DM + 64 * kb; d.ldw = FF; d.K = DM; return d;
}
__device__ __forceinline__ void prep_load(const PrepItem& d, f32x4 (&v)[8], int lane) {
#pragma unroll
    for (int i = 0; i < 8; ++i) v[i] = __builtin_nontemporal_load((const f32x4*)(d.src + (size_t)(8 * i + (lane >> 3)) * d.ldw + 4 * (lane & 7)));
}
__device__ __forceinline__ void prep_store(const PrepItem& d, const f32x4 (&v)[8], LAS float* scr, int lane) {
#pragma unroll
    for (int i = 0; i < 8; ++i)
#pragma unroll
        for (int j = 0; j < 4; ++j) scr[(8 * i + (lane >> 3)) * 33 + 4 * (lane & 7) + j] = v[i][j];
    const int c = lane & 7;
    f32x4 g0 = (f32x4){1.f, 1.f, 1.f, 1.f}, g1 = g0; if (d.gn) { g0 = *(const f32x4*)(d.gn + 8 * c); g1 = *(const f32x4*)(d.gn + 8 * c + 4); }
    asm volatile("s_waitcnt lgkmcnt(0)" ::: "memory");
#pragma unroll
    for (int j = 0; j < 4; ++j) { const int rr = (lane >> 3) + 8 * j; const LAS float* s = scr + (8 * c) * 33 + perm32(rr);
        u32x4 o; o.x = pk2(s[0 * 33] * g0[0], s[1 * 33] * g0[1]); o.y = pk2(s[2 * 33] * g0[2], s[3 * 33] * g0[3]); o.z = pk2(s[4 * 33] * g1[0], s[5 * 33] * g1[1]); o.w = pk2(s[6 * 33] * g1[2], s[7 * 33] * g1[3]);
        *(u32x4*)(d.dst + (size_t)rr * d.K + 8 * c) = o; }
    asm volatile("s_waitcnt lgkmcnt(0)" ::: "memory");
}
constexpr int I_1C = (DM / 64) * (2 * FF / 32), I_1D = (FF / 64) * (DM / 32), I_IN = (DM / 64) * (INW / 32), I_P = (512 / 64) * (DM / 32), I_O = (DM / 64) * (DM / 32);
constexpr int NITEMS = 2 * I_1C + 2 * I_1D + I_IN + 2 * I_P + I_O;
__device__ __forceinline__ PrepItem prep_get(const __attribute__((address_space(4))) Inputs& I, int l, unsigned char* WB, int r) {
    if (r < I_1C) return prep_gateup(I.ffn1_wg + (size_t)l * DM * FF, I.ffn1_wu + (size_t)l * DM * FF, I.ffn1_norm + l * DM, (bf16*)(WB + WO_1C), r); r -= I_1C;
    if (r < I_1C) return prep_gateup(I.ffn2_wg + (size_t)l * DM * FF, I.ffn2_wu + (size_t)l * DM * FF, I.ffn2_norm + l * DM, (bf16*)(WB + WO_2C), r); r -= I_1C;
    if (r < I_1D) return prep_head(I.ffn1_wd + (size_t)l * FF * DM, FF, DM, nullptr, (bf16*)(WB + WO_1D), r); r -= I_1D;
    if (r < I_1D) return prep_head(I.ffn2_wd + (size_t)l * FF * DM, FF, DM, nullptr, (bf16*)(WB + WO_2D), r); r -= I_1D;
    if (r < I_IN) return prep_head(I.w_in + (size_t)l * DM * INW, DM, INW, I.mix_norm + l * DM, (bf16*)(WB + WO_IN), r); r -= I_IN;
    if (r < I_P) return prep_head(I.w_br_na + (size_t)l * 512 * DM, 512, DM, nullptr, (bf16*)(WB + WO_PA), r); r -= I_P;
    if (r < I_P) return prep_head(I.w_br_sw + (size_t)l * 512 * DM, 512, DM, nullptr, (bf16*)(WB + WO_PB), r); r -= I_P;
    return prep_head(I.w_out + (size_t)l * DM * DM, DM, DM, nullptr, (bf16*)(WB + WO_OUT), r);
}
__device__ __forceinline__ float wave_sum64(float v) {
#pragma unroll
    for (int o = 1; o < 64; o <<= 1) v += __shfl_xor(v, o);
    return v;
}

__device__ __forceinline__ bf16x8 tr_pair(const LAS unsigned char* p0, const LAS unsigned char* p1) {
    typedef short v4i16 __attribute__((ext_vector_type(4)));
    const v4i16 lo = __builtin_amdgcn_ds_read_tr16_b64_v4i16((LAS v4i16*)p0), hi = __builtin_amdgcn_ds_read_tr16_b64_v4i16((LAS v4i16*)p1);
    return (bf16x8){lo[0], lo[1], lo[2], lo[3], hi[0], hi[1], hi[2], hi[3]};
}
__device__ __forceinline__ int fK(int key) { return ((key >> 1) & 1) | (((key >> 3) & 3) << 1); }
__device__ __forceinline__ int fV(int key) { return ((key >> 1) & 1) | (((key >> 3) & 1) << 1); }

template <int NS> __device__ __forceinline__ float softmax_pack(f32x4 (&S)[NS][2], bf16x8 (&pk)[NS], bool has_sink, float sink) {
    float mx = has_sink ? sink : -3.0e38f;
#pragma unroll
    for (int s = 0; s < NS; ++s)
#pragma unroll
        for (int hb = 0; hb < 2; ++hb) mx = fmaxf(mx, fmaxf(fmaxf(S[s][hb][0], S[s][hb][1]), fmaxf(S[s][hb][2], S[s][hb][3])));
    mx = fmaxf(mx, __shfl_xor(mx, 16)); mx = fmaxf(mx, __shfl_xor(mx, 32));
    const float mb = mx * 1.4426950408889634f; float l = 0.f;
#pragma unroll
    for (int s = 0; s < NS; ++s) {
#pragma unroll
        for (int hb = 0; hb < 2; ++hb)
#pragma unroll
            for (int j = 0; j < 4; ++j) { const float e = __builtin_amdgcn_exp2f(S[s][hb][j] * 1.4426950408889634f - mb); S[s][hb][j] = e; l += e; }
        u32x4 w; w.x = cvt_pk_bf16(S[s][0][0], S[s][0][1]); w.y = cvt_pk_bf16(S[s][0][2], S[s][0][3]); w.z = cvt_pk_bf16(S[s][1][0], S[s][1][1]); w.w = cvt_pk_bf16(S[s][1][2], S[s][1][3]);
        pk[s] = __builtin_bit_cast(bf16x8, w);
    }
    l += __shfl_xor(l, 16); l += __shfl_xor(l, 32);
    if (has_sink) l += __builtin_amdgcn_exp2f(sink * 1.4426950408889634f - mb);
    return 1.f / l;
}

constexpr int SW_K_OFF = 0, SW_V_OFF = 49152, SW_LUT_OFF = 98304, SW_LUT_LD = 512;
__device__ __forceinline__ void swa_unit(LAS unsigned char* lds, int b, int g, int nb, const bf16* QKV, const float* t5, const float* sink, bf16* OSW) {
    int tid_ = threadIdx.x; asm volatile("" : "+v"(tid_));
    const int tid = tid_, lane = tid & 63, wid = __builtin_amdgcn_readfirstlane(tid >> 6), fr = lane & 15, fq = lane >> 4;
#pragma unroll
    for (int i = 0; i < 6; ++i) { const int cid = tid + NTHREADS * i, key = cid >> 3, c = cid & 7, kp = 128 * (nb - 1) + key; const bool ok = kp >= 0 && kp < SEQ;
        const bf16* src = QKV + (size_t)(b * SEQ + (ok ? kp : 0)) * NQKV + 64 * g + 8 * c;
        u32x4 kv = (u32x4){0u, 0u, 0u, 0u}, vv = kv; if (ok) { kv = *(const u32x4*)(src + 2048); vv = *(const u32x4*)(src + 2176); }
        *(LAS u32x4*)(lds + SW_K_OFF + key * 128 + ((c ^ fK(key)) << 4)) = kv;
        *(LAS u32x4*)(lds + SW_V_OFF + key * 128 + (((c >> 1) ^ fV(key)) << 5) + ((c & 1) << 4)) = vv; }
    for (int idx = tid; idx < 5 * 512; idx += NTHREADS) { const int hh = idx >> 9, rel = (idx & 511) - 255;
        ((LAS float*)(lds + SW_LUT_OFF))[idx] = (hh < 4 && rel >= -128 && rel <= 128) ? t5[slow::t5_bucket(rel) * 8 + 4 * g + hh] : NEGV; }
    __syncthreads();
    const int fKl = ((fr >> 1) & 1) | ((fr >> 2) << 1);
    const LAS unsigned char* kb0 = lds + SW_K_OFF + (8 * (fr >> 2) + (fr & 3)) * 128 + ((fq ^ fKl) << 4);
    const LAS unsigned char* kb1 = lds + SW_K_OFF + (8 * (fr >> 2) + (fr & 3)) * 128 + (((4 + fq) ^ fKl) << 4);
    const int q4 = (lane & 15) >> 2, p4 = lane & 3, fVl = ((q4 >> 1) & 1) | ((fq & 1) << 1);
    const LAS unsigned char* vb = lds + SW_V_OFF + (8 * fq + q4) * 128 + p4 * 8;
    const int relbase = 8 * fq - 128 - 16 * wid - fr + 255;
    const bool first_bad = (nb == 0), last_bad = (nb == SEQ / 128 - 1);
    const size_t tokq = (size_t)b * SEQ + 128 * nb + 16 * wid + fr; const int s0 = wid >> 1;
    for (int hh = 0; hh < 4; ++hh) {
        const int h = 4 * g + hh;
        const bf16x8 q0 = *(const bf16x8*)(QKV + tokq * NQKV + 1536 + 64 * h + 8 * fq), q1 = *(const bf16x8*)(QKV + tokq * NQKV + 1536 + 64 * h + 32 + 8 * fq);
        const LAS float* lut = (const LAS float*)(lds + SW_LUT_OFF) + hh * SW_LUT_LD + relbase;
        f32x4 S[9][2]; bf16x8 pk[9];
        const LAS unsigned char* kb0s = kb0 + s0 * 4096; const LAS unsigned char* kb1s = kb1 + s0 * 4096; const LAS float* luts = lut + 32 * s0;
#pragma unroll
        for (int s = 0; s < 9; ++s) {
            const bool bad = (s0 + s < 4 && first_bad) || (s0 + s >= 8 && last_bad);
            const LAS float* lp = luts + 32 * s + (bad ? (4 - hh) * SW_LUT_LD : 0);
#pragma unroll
            for (int hb = 0; hb < 2; ++hb) { const bf16x8 k0 = *(const LAS bf16x8*)(kb0s + s * 4096 + hb * 512), k1 = *(const LAS bf16x8*)(kb1s + s * 4096 + hb * 512);
                f32x4 a = (f32x4){lp[4 * hb], lp[4 * hb + 1], lp[4 * hb + 2], lp[4 * hb + 3]};
                a = __builtin_amdgcn_mfma_f32_16x16x32_bf16(k0, q0, a, 0, 0, 0); a = __builtin_amdgcn_mfma_f32_16x16x32_bf16(k1, q1, a, 0, 0, 0);
                S[s][hb] = a; }
            if ((s & 3) == 3) asm volatile("" ::: "memory"); }
        const float rl = softmax_pack<9>(S, pk, true, sink[h]);
        f32x4 O[4];
#pragma unroll
        for (int db = 0; db < 4; ++db) O[db] = (f32x4){0.f, 0.f, 0.f, 0.f};
        const LAS unsigned char* vbs = vb + s0 * 4096;
#pragma unroll
        for (int s = 0; s < 9; ++s) {
#pragma unroll
            for (int db = 0; db < 4; ++db) { const LAS unsigned char* p = vbs + s * 4096 + ((db ^ fVl) << 5); O[db] = __builtin_amdgcn_mfma_f32_16x16x32_bf16(tr_pair(p, p + 512), pk[s], O[db], 0, 0, 0); }
            if ((s & 3) == 3) asm volatile("" ::: "memory"); }
        bf16* dst = OSW + tokq * 512 + 64 * h + 4 * fq;
#pragma unroll
        for (int db = 0; db < 4; ++db) { u32x2 w; w.x = cvt_pk_bf16(O[db][0] * rl, O[db][1] * rl); w.y = cvt_pk_bf16(O[db][2] * rl, O[db][3] * rl); *(u32x2*)(dst + 16 * db) = w; }
    }
    __syncthreads();
}

constexpr int NA_V_OFF = 0, NA_TAB_OFF = 122880;
__device__ __forceinline__ int na_rowstart(int r) { int rs = r - 4; return rs < 0 ? 0 : (rs > ROWS - 8 ? ROWS - 8 : rs); }
__device__ __forceinline__ void na_unit(LAS unsigned char* lds, int b, int h, int rq, const bf16* QKV, const float* rpb, bf16* ONA) {
    int tid_ = threadIdx.x; asm volatile("" : "+v"(tid_));
    const int tid = tid_, lane = tid & 63, wid = __builtin_amdgcn_readfirstlane(tid >> 6), fr = lane & 15, fq = lane >> 4;
    const int kr_lo = na_rowstart(8 * rq), kr_hi = na_rowstart(8 * rq + 7) + 7;
    {
        const int nrows = kr_hi - kr_lo + 1, kloc = tid >> 3, c = tid & 7;
        const bf16* src = QKV + (size_t)(b * SEQ + kr_lo * GRID_W + kloc) * NQKV + 1024 + 64 * h + 8 * c;
        LAS unsigned char* dstp = lds + NA_V_OFF + kloc * 128 + (((c >> 1) ^ fV(kloc)) << 5) + ((c & 1) << 4);
        u32x4 vv[15];
#pragma unroll
        for (int r = 0; r < 15; ++r) if (r < nrows) vv[r] = *(const u32x4*)(src + (size_t)r * GRID_W * NQKV);
#pragma unroll
        for (int r = 0; r < 15; ++r) if (r < nrows) *(LAS u32x4*)(dstp + r * (GRID_W * 128)) = vv[r];
    }
    for (int idx = tid; idx < 15 * 32; idx += NTHREADS) { const int rr_ = idx >> 5, cc_ = idx & 31; ((LAS float*)(lds + NA_TAB_OFF))[idx] = cc_ < 31 ? rpb[h * 465 + rr_ * 31 + cc_] : NEGV; }
    __syncthreads();
    const LAS float* tab = (const LAS float*)(lds + NA_TAB_OFF);
    const int q4 = (lane & 15) >> 2, p4 = lane & 3;
    bf16x8 kf[8][2][2], q0, q1;
#define NA_LOADKQ(pp, slo, shi) do { const int r_ = 8 * rq + ((pp) >> 2), cb_ = (pp) & 3, rs_ = na_rowstart(r_); int kcs_ = 16 * cb_ - 8; kcs_ = kcs_ < 0 ? 0 : (kcs_ > 32 ? 32 : kcs_); \
        const size_t tq_ = (size_t)b * SEQ + r_ * GRID_W + 16 * cb_ + fr; \
        if ((slo) == 0) { q0 = *(const bf16x8*)(QKV + tq_ * NQKV + 64 * h + 8 * fq); q1 = *(const bf16x8*)(QKV + tq_ * NQKV + 64 * h + 32 + 8 * fq); } \
        const bf16* kb_ = QKV + ((size_t)b * SEQ + rs_ * GRID_W + kcs_ + 8 * (fr >> 2) + (fr & 3)) * NQKV + 512 + 64 * h + 8 * fq;     \
        _Pragma("unroll") for (int s_ = (slo); s_ < (shi); ++s_) _Pragma("unroll") for (int hb_ = 0; hb_ < 2; ++hb_) { const bf16* kp_ = kb_ + (size_t)(s_ * GRID_W + 4 * hb_) * NQKV; kf[s_][hb_][0] = *(const bf16x8*)kp_; kf[s_][hb_][1] = *(const bf16x8*)(kp_ + 32); } } while (0)
    for (int i = 0; i < 4; ++i) {
        const int p = wid + 8 * i, r = 8 * rq + (p >> 2), cb = p & 3, rs = na_rowstart(r);
        int kcs = 16 * cb - 8; kcs = kcs < 0 ? 0 : (kcs > 32 ? 32 : kcs);
        const int qcol = 16 * cb + fr; int qcs = qcol - 8; qcs = qcs < 0 ? 0 : (qcs > 48 ? 48 : qcs);
        const size_t tokq = (size_t)b * SEQ + r * GRID_W + qcol;
        f32x4 S[8][2]; bf16x8 pk[8];
        int cidx[2][4];
#pragma unroll
        for (int hb = 0; hb < 2; ++hb)
#pragma unroll
            for (int j = 0; j < 4; ++j) { const int kcol = kcs + 8 * fq + 4 * hb + j; const bool ok = kcol >= qcs && kcol < qcs + 16; cidx[hb][j] = ok ? kcol - qcol + 15 : 31; }
        const LAS float* trow = tab + (rs - r + 7) * 32;
        NA_LOADKQ(p, 0, 8); __builtin_amdgcn_sched_barrier(0);
#pragma unroll
        for (int s = 0; s < 8; ++s) {
#pragma unroll
            for (int hb = 0; hb < 2; ++hb) {
                f32x4 a = (f32x4){0.f, 0.f, 0.f, 0.f}; a = __builtin_amdgcn_mfma_f32_16x16x32_bf16(kf[s][hb][0], q0, a, 0, 0, 0); a = __builtin_amdgcn_mfma_f32_16x16x32_bf16(kf[s][hb][1], q1, a, 0, 0, 0);
#pragma unroll
                for (int j = 0; j < 4; ++j) a[j] += trow[s * 32 + cidx[hb][j]];
                S[s][hb] = a; }
            if ((s & 3) == 3) asm volatile("" ::: "memory"); }
        const float rl = softmax_pack<8>(S, pk, false, 0.f);
        const int fVl = ((q4 >> 1) & 1) | ((((kcs >> 3) + fq) & 1) << 1);
        const LAS unsigned char* vb = lds + NA_V_OFF + ((rs - kr_lo) * GRID_W + kcs + 8 * fq + q4) * 128 + p4 * 8;
        f32x4 O[4];
#pragma unroll
        for (int db = 0; db < 4; ++db) O[db] = (f32x4){0.f, 0.f, 0.f, 0.f};
#pragma unroll
        for (int s = 0; s < 8; ++s) {
#pragma unroll
            for (int db = 0; db < 4; ++db) { const LAS unsigned char* pp = vb + s * (GRID_W * 128) + ((db ^ fVl) << 5); O[db] = __builtin_amdgcn_mfma_f32_16x16x32_bf16(tr_pair(pp, pp + 512), pk[s], O[db], 0, 0, 0); }
            if ((s & 3) == 3) asm volatile("" ::: "memory"); }
        bf16* dst = ONA + tokq * 512 + 64 * h + 4 * fq;
#pragma unroll
        for (int db = 0; db < 4; ++db) { u32x2 w; w.x = cvt_pk_bf16(O[db][0] * rl, O[db][1] * rl); w.y = cvt_pk_bf16(O[db][2] * rl, O[db][3] * rl); *(u32x2*)(dst + 16 * db) = w; }
    }
    __syncthreads();
}

constexpr int NA2_K_OFF = 0, NA2_V_OFF = 61440, NA2_TAB_OFF = 122880;
__device__ __forceinline__ void na_quad(LAS unsigned char* lds, int b, int h, int cb, const bf16* QKV, const float* rpb, bf16* ONA) {
    int tid_ = threadIdx.x; asm volatile("" : "+v"(tid_));
    const int tid = tid_, lane = tid & 63, wid = __builtin_amdgcn_readfirstlane(tid >> 6), fr = lane & 15, fq = lane >> 4;
    int kcs = 16 * cb - 8; kcs = kcs < 0 ? 0 : (kcs > 32 ? 32 : kcs);
    const int isv = tid >> 8, t8 = tid & 255, kc = t8 >> 3, c = t8 & 7;
    const bf16* src0 = QKV + (size_t)(b * SEQ + kcs + kc) * NQKV + (isv ? 1024 : 512) + 64 * h + 8 * c;
    LAS unsigned char* dstp = isv ? lds + NA2_V_OFF + kc * 128 + (((c >> 1) ^ fV(kc)) << 5) + ((c & 1) << 4) : lds + NA2_K_OFF + kc * 128 + ((c ^ fK(kc)) << 4);
    u32x4 vv[15];
#define NA2_LOAD(rq_) do { const int lo_ = na_rowstart(8 * (rq_)), n_ = na_rowstart(8 * (rq_) + 7) + 8 - lo_; \
        _Pragma("unroll") for (int r_ = 0; r_ < 15; ++r_) if (r_ < n_) vv[r_] = *(const u32x4*)(src0 + (size_t)(lo_ + r_) * GRID_W * NQKV); } while (0)
    NA2_LOAD(0);
    for (int idx = tid; idx < 15 * 32; idx += NTHREADS) { const int rr_ = idx >> 5, cc_ = idx & 31; ((LAS float*)(lds + NA2_TAB_OFF))[idx] = cc_ < 31 ? rpb[h * 465 + rr_ * 31 + cc_] : NEGV; }
    const LAS float* tab = (const LAS float*)(lds + NA2_TAB_OFF);
    const int qcol = 16 * cb + fr; int qcs = qcol - 8; qcs = qcs < 0 ? 0 : (qcs > 48 ? 48 : qcs);
    const int fKl = ((fr >> 1) & 1) | ((fr >> 2) << 1);
    const int q4 = (lane & 15) >> 2, p4 = lane & 3, fVl = ((q4 >> 1) & 1) | ((fq & 1) << 1);
    int cidx[2][4];
#pragma unroll
    for (int hb = 0; hb < 2; ++hb)
#pragma unroll
        for (int j = 0; j < 4; ++j) { const int kcol = kcs + 8 * fq + 4 * hb + j; const bool ok = kcol >= qcs && kcol < qcs + 16; cidx[hb][j] = ok ? kcol - qcol + 15 : 31; }
    for (int rq = 0; rq < 4; ++rq) {
        const int kr_lo = na_rowstart(8 * rq), nrows = na_rowstart(8 * rq + 7) + 8 - kr_lo;
#pragma unroll
        for (int r_ = 0; r_ < 15; ++r_) if (r_ < nrows) *(LAS u32x4*)(dstp + r_ * 4096) = vv[r_];
        __syncthreads();
        const int r = 8 * rq + wid, rs = na_rowstart(r), ro = rs - kr_lo;
        const size_t tokq = (size_t)b * SEQ + r * GRID_W + qcol;
        const bf16x8 q0 = *(const bf16x8*)(QKV + tokq * NQKV + 64 * h + 8 * fq), q1 = *(const bf16x8*)(QKV + tokq * NQKV + 64 * h + 32 + 8 * fq);
        __builtin_amdgcn_sched_barrier(0);
        if (rq < 3) NA2_LOAD(rq + 1);
        const LAS unsigned char* kb0 = lds + NA2_K_OFF + ro * 4096 + (8 * (fr >> 2) + (fr & 3)) * 128 + ((fq ^ fKl) << 4);
        const LAS unsigned char* kb1 = lds + NA2_K_OFF + ro * 4096 + (8 * (fr >> 2) + (fr & 3)) * 128 + (((4 + fq) ^ fKl) << 4);
        const LAS unsigned char* vb = lds + NA2_V_OFF + ro * 4096 + (8 * fq + q4) * 128 + p4 * 8;
        const LAS float* trow = tab + (rs - r + 7) * 32;
        f32x4 S[8][2]; bf16x8 pk[8];
#pragma unroll
        for (int s = 0; s < 8; ++s) {
#pragma unroll
            for (int hb = 0; hb < 2; ++hb) { const bf16x8 k0 = *(const LAS bf16x8*)(kb0 + s * 4096 + hb * 512), k1 = *(const LAS bf16x8*)(kb1 + s * 4096 + hb * 512);
                f32x4 a = (f32x4){trow[s * 32 + cidx[hb][0]], trow[s * 32 + cidx[hb][1]], trow[s * 32 + cidx[hb][2]], trow[s * 32 + cidx[hb][3]]};
                a = __builtin_amdgcn_mfma_f32_16x16x32_bf16(k0, q0, a, 0, 0, 0); a = __builtin_amdgcn_mfma_f32_16x16x32_bf16(k1, q1, a, 0, 0, 0);
                S[s][hb] = a; }
            if ((s & 3) == 3) asm volatile("" ::: "memory"); }
        const float rl = softmax_pack<8>(S, pk, false, 0.f);
        f32x4 O[4];
#pragma unroll
        for (int db = 0; db < 4; ++db) O[db] = (f32x4){0.f, 0.f, 0.f, 0.f};
#pragma unroll
        for (int s = 0; s < 8; ++s) {
#pragma unroll
            for (int db = 0; db < 4; ++db) { const LAS unsigned char* pp = vb + s * 4096 + ((db ^ fVl) << 5); O[db] = __builtin_amdgcn_mfma_f32_16x16x32_bf16(tr_pair(pp, pp + 512), pk[s], O[db], 0, 0, 0); }
            if ((s & 3) == 3) asm volatile("" ::: "memory"); }
        bf16* dst = ONA + tokq * 512 + 64 * h + 4 * fq;
#pragma unroll
        for (int db = 0; db < 4; ++db) { u32x2 w; w.x = cvt_pk_bf16(O[db][0] * rl, O[db][1] * rl); w.y = cvt_pk_bf16(O[db][2] * rl, O[db][3] * rl); *(u32x2*)(dst + 16 * db) = w; }
        __syncthreads();
    }
#undef NA2_LOAD
}

#ifndef PG8_SP2
#define PG8_SP2 true
#endif
#ifndef PG8_ALIGN
#define PG8_ALIGN true
#endif
constexpr int N_PHASES = 9 * DEPTH;
struct PhaseBar { XcdBarrier xb; GrpBarrier gb; unsigned want; int mode;
    __device__ __forceinline__ void operator()() const { if (mode == 1) xcd_barrier(xb); else if (mode == 2) grp_barrier(gb, want); } };
struct Args { Inputs I; float* out; unsigned char* ws; int ph_lo, ph_hi, bar_region, pad; };

__global__ void __launch_bounds__(NTHREADS, 2) mega_fwd(Args args) {
    extern __shared__ __attribute__((aligned(16))) unsigned char lds_raw[];
    LAS unsigned char* lds = (LAS unsigned char*)lds_raw;
    volatile LAS unsigned* MISC = (volatile LAS unsigned*)(lds + MISC_OFF);
    const int tid = threadIdx.x, lane = tid & 63, wave = __builtin_amdgcn_readfirstlane(tid >> 6);
    const int G = gridDim.x, bx = blockIdx.x, vcu = (G % 8 == 0) ? (bx % 8) * (G / 8) + bx / 8 : bx;
    unsigned char* ws0 = args.ws;
    for (int u = tid; u < (LDS_BYTES - RING_BYTES) / 4; u += NTHREADS) ((LAS unsigned*)(lds + RING_BYTES))[u] = 0u;
    __syncthreads();
    const int lo = args.ph_lo, hi = args.ph_hi;
    XcdBarrier bar; bar.bar = (unsigned*)(ws0 + WS_CTL) + 4096 + args.bar_region * XCD_BAR_WORDS; bar.x = 0; bar.st = nullptr;
    if (hi - lo > 1) bar = xcd_barrier_post(bar.bar, MISC + 8);
    const bool use_groups0 = GROUPS && (G == 256) && lo == 0 && hi == N_PHASES;
    const int grp = bx & 7;
    GrpBarrier gbar; { unsigned* gw_ = (unsigned*)(ws0 + WS_CTL) + CW_GRP; gbar.cnt = gw_ + 512 + 64 * grp; gbar.gen = gw_ + 1024 + 64 * grp; gbar.tmo = bar.bar + XB_TMO; gbar.cheap = false;
        if (use_groups0 && tid == 0) atomicOr(gw_ + 64 * grp, 1u << (xb_xcc_id() & 15u)); }

    unsigned t_first = 0, t_prev = 0, t_sel = 0;
    if (PROBE_MASK || PROBE3 || PROBE4 || PROBE2_PHASE >= 0) t_first = t_prev = (unsigned)__builtin_amdgcn_s_memrealtime();
    for (int ph = lo; ph < hi; ++ph) {
        const int l = ph / 9, k = ph % 9;
        typedef const __attribute__((address_space(4))) Args* kargp; kargp ap = (kargp)__builtin_amdgcn_kernarg_segment_ptr(); asm volatile("" : "+s"(ap));
        const __attribute__((address_space(4))) Inputs& I = ap->I; unsigned char* ws = ap->ws; float* out = ap->out;
        int bxl = bx; asm volatile("" : "+s"(bxl));
        const bool use_groups = GROUPS && (G == 256) && ap->ph_lo == 0 && ap->ph_hi == N_PHASES;
        float* SS = (float*)(ws + WS_SS);
        bf16 *XB = (bf16*)(ws + WS_XB), *H, *QKV, *T, *MRG, *GT, *ONA, *OSW;
        if (use_groups) {
            unsigned char* sl = ws + WS_H + (size_t)grp * (21 * MiB); const size_t r0 = (size_t)grp * SEQ;
            QKV = (bf16*)sl - r0 * NQKV; GT = (bf16*)(sl + 9 * MiB) - r0 * NG; ONA = (bf16*)(sl + 17 * MiB) - r0 * 512; OSW = (bf16*)(sl + 19 * MiB) - r0 * 512;
            T = (bf16*)sl - r0 * DM; MRG = (bf16*)(sl + 4 * MiB) - r0 * DM; H = (bf16*)sl - r0 * FF;
        } else { H = (bf16*)(ws + WS_H); QKV = (bf16*)(ws + WS_QKV); T = (bf16*)(ws + WS_T); MRG = (bf16*)(ws + WS_MRG); GT = (bf16*)(ws + WS_G); ONA = (bf16*)(ws + WS_ONA); OSW = (bf16*)(ws + WS_OSW); }
        unsigned char* WB = ws + WS_W;
        unsigned p5c = 0, p5r = 0; if (PROBE5 >= 0 && ph == PROBE5) { p5c = (unsigned)__builtin_amdgcn_s_memtime(); p5r = (unsigned)__builtin_amdgcn_s_memrealtime(); }
        if (PROBE2_PHASE >= 0) { if (tid == 0) MISC[19] = (ph == PROBE2_PHASE) ? 1u : 0u; __syncthreads(); }
        float* ss0 = SS + (size_t)(3 * l + 0) * M; float* ss1 = SS + (size_t)(3 * l + 1) * M; float* ss2 = SS + (size_t)(3 * l + 2) * M; float* ss3 = SS + (size_t)(3 * l + 3) * M;
        if (k == 0 && (CODE_MASK & 1)) {
            int lane_ = tid & 63; asm volatile("" : "+v"(lane_)); const int lane = lane_;
            LAS float* scr = (LAS float*)(lds + wave * 16384);
            const int gw = vcu * NWAVES + wave, NGW = G * NWAVES;
#define PREP_GET(it_) prep_get(I, l, WB, it_)
            {   f32x4 va[8], vb[8];
                int it = gw;
                for (; it + NGW < NITEMS; it += 2 * NGW) { const PrepItem da = PREP_GET(it), db = PREP_GET(it + NGW); prep_load(da, va, lane); prep_load(db, vb, lane); prep_store(da, va, scr, lane); prep_store(db, vb, scr, lane); }
                if (it < NITEMS) { const PrepItem da = PREP_GET(it); prep_load(da, va, lane); prep_store(da, va, scr, lane); }
            }
#undef PREP_GET
            if (l == 0) {
                for (int m = gw; m < M; m += 2 * NGW) { const int m2 = m + NGW;
                    const f32x4* xr = (const f32x4*)(I.x + (size_t)m * DM) + lane; const f32x4* xr2 = (const f32x4*)(I.x + (size_t)m2 * DM) + lane; f32x4 v[4], v2[4];
#pragma unroll
                    for (int j = 0; j < 4; ++j) { v[j] = xr[64 * j]; v2[j] = xr2[64 * j]; }
                    float s = 0.f, s2 = 0.f; u32x2* o8 = (u32x2*)(XB + (size_t)m * DM) + lane; u32x2* o82 = (u32x2*)(XB + (size_t)m2 * DM) + lane;
#pragma unroll
                    for (int j = 0; j < 4; ++j) { s += (v[j][0] * v[j][0] + v[j][1] * v[j][1]) + (v[j][2] * v[j][2] + v[j][3] * v[j][3]); u32x2 w; w.x = pk2(v[j][0], v[j][1]); w.y = pk2(v[j][2], v[j][3]); o8[64 * j] = w;
                        s2 += (v2[j][0] * v2[j][0] + v2[j][1] * v2[j][1]) + (v2[j][2] * v2[j][2] + v2[j][3] * v2[j][3]); u32x2 w2; w2.x = pk2(v2[j][0], v2[j][1]); w2.y = pk2(v2[j][2], v2[j][3]); o82[64 * j] = w2; }
                    s = wave_sum64(s); s2 = wave_sum64(s2); if (lane == 0) { ss0[m] = s; ss0[m2] = s2; } }
            }
            __syncthreads();
        } else if ((k == 1 || k == 7) && (CODE_MASK & 2)) {
            pg8::Gemm g{XB, (const bf16*)(WB + (k == 1 ? WO_1C : WO_2C)), M, 2 * FF, DM, nullptr, nullptr}; pg8::StaticOrder S; S.init(M, 2 * FF, G, bxl, WGM_P1);
            pg8::EpiFfnUp E{H, k == 1 ? ss0 : ss2};
            if (RING4) pg8::gemm_ring4<pg8::EpiFfnUp, pg8::StaticOrder>(lds, g, S, E); else pg8::gemm_phase<pg8::EpiFfnUp, PG8_ALIGN, PG8_SP2>(lds, g, S, E);
        } else if ((k == 2 || k == 8) && (CODE_MASK & 4)) {
            pg8::Gemm g{H, (const bf16*)(WB + (k == 2 ? WO_1D : WO_2D)), M, DM, FF, nullptr, nullptr}; pg8::StaticOrder S; S.init(M, DM, G, bxl);
            const bool fin = (k == 8 && l == DEPTH - 1);
            pg8::EpiResid E{(k == 2 && l == 0) ? I.x : nullptr, fin ? out : nullptr, XB, fin ? nullptr : (k == 2 ? ss1 : ss3), 0.5f};
            const PhaseBar pb{bar, gbar, (unsigned)(7 * ((ph - 1) / 9) + (ph - 1) % 9), ph > lo ? (use_groups ? 2 : 1) : 0};
            pg8::gemm_phase<pg8::EpiResid, false, PG8_SP2, pg8::StaticOrder, PhaseBar>(lds, g, S, E, pb);
        } else if (k == 3 && (CODE_MASK & 8)) {
            LAS float* wtab = (LAS float*)(lds + RING_BYTES + 1024);
            int tl_ = tid; asm volatile("" : "+v"(tl_));
            for (int idx = tl_; idx < NG; idx += NTHREADS) wtab[idx] = I.b_gate[l * NG + idx];
            if (tl_ < 256) { const int t = tl_ >> 6, d = tl_ & 63; wtab[2048 + tl_] = (t == 0 ? I.na_q_norm : t == 1 ? I.na_k_norm : t == 2 ? I.sw_q_norm : I.sw_k_norm)[l * 64 + d]; }
            __syncthreads();
            pg8::Gemm g{XB, (const bf16*)(WB + WO_IN), M, INW, DM, nullptr, nullptr}; pg8::StaticOrder S; S.init(M, INW, G, bxl, WGM_P3);
            pg8::EpiWin E{QKV, GT, ss1, wtab};
            if (RING4) pg8::gemm_ring4<pg8::EpiWin, pg8::StaticOrder>(lds, g, S, E); else pg8::gemm_phase<pg8::EpiWin, PG8_ALIGN, PG8_SP2>(lds, g, S, E);
        } else if (k == 4 && (CODE_MASK & 48)) {
            unsigned a_t0 = 0, a_t1 = 0; if (PROBE3) a_t0 = (unsigned)__builtin_amdgcn_s_memrealtime();
            if (CODE_MASK & 16) {
                if (NA_V2) { for (int u4 = 4 * vcu; u4 < 1024; u4 += 4 * G) na_quad(lds, u4 >> 7, (u4 >> 4) & 7, (u4 >> 2) & 3, QKV, I.na_rpb + (size_t)l * 8 * 465, ONA); }
                else for (int u = vcu; u < 256; u += G) na_unit(lds, u >> 5, (u >> 2) & 7, u & 3, QKV, I.na_rpb + (size_t)l * 8 * 465, ONA);
            }
            if (PROBE3) a_t1 = (unsigned)__builtin_amdgcn_s_memrealtime();
            if (CODE_MASK & 32) for (int u = vcu; u < 256; u += G) swa_unit(lds, u >> 5, (u >> 4) & 1, u & 15, QKV, I.t5, I.sw_sink + l * 8, OSW);
            if (PROBE3) { const unsigned a_t2 = (unsigned)__builtin_amdgcn_s_memrealtime(); if (tid == 0) { MISC[24] += a_t1 - a_t0; MISC[25] += a_t2 - a_t1; } }
        } else if (k == 5 && (CODE_MASK & 64)) {
            pg8::DualOrder S; S.S.init(M, DM, G, bxl);
            pg8::Gemm g{ONA, (const bf16*)(WB + WO_PA), M, DM, 512, OSW, (const bf16*)(WB + WO_PB)}; pg8::EpiBranch E{MRG, GT};
            pg8::gemm_phase<pg8::EpiBranch, false, PG8_SP2, pg8::DualOrder>(lds, g, S, E);
        } else if (k == 6 && (CODE_MASK & 128)) {
            pg8::Gemm g{MRG, (const bf16*)(WB + WO_OUT), M, DM, DM, nullptr, nullptr}; pg8::StaticOrder S; S.init(M, DM, G, bxl);
            pg8::EpiResid E{nullptr, nullptr, XB, ss2, 1.0f};
            const PhaseBar pb{bar, gbar, (unsigned)(7 * ((ph - 1) / 9) + (ph - 1) % 9), ph > lo ? (use_groups ? 2 : 1) : 0};
            pg8::gemm_phase<pg8::EpiResid, false, PG8_SP2, pg8::StaticOrder, PhaseBar>(lds, g, S, E, pb);
        }
        if (PROBE5 >= 0 && ph == PROBE5) { const unsigned c1 = (unsigned)__builtin_amdgcn_s_memtime(), r1 = (unsigned)__builtin_amdgcn_s_memrealtime(); if (tid == 0) { MISC[26] = c1 - p5c; MISC[27] = r1 - p5r; } }
        unsigned b_t0 = 0; if (PROBE4) b_t0 = (unsigned)__builtin_amdgcn_s_memrealtime();
        const int kn_ = (ph + 1) % 9; const bool next_resid = (ph + 1 < hi) && (kn_ == 2 || kn_ == 6 || kn_ == 8);
        if ((ph + 1 < hi || PROBE_MASK) && !next_resid) {
            const bool global = !use_groups || (ph % 9 == 0) || ((ph + 1) % 9 == 0) || ph + 1 == hi;
            if (global) { xcd_barrier(bar);
                if (use_groups && ph == 0) { const unsigned mk = xb_ld((unsigned*)(ws0 + WS_CTL) + CW_GRP + 64 * grp); gbar.cheap = !FORCE_FULL_RELEASE && __builtin_popcount(mk) == 1; }
                if (use_groups && STAGGER_TICKS > 0 && (ph % 9) == 0 && ph + 1 < hi) { const unsigned long long t0_ = __builtin_amdgcn_s_memrealtime(); const unsigned long long dl_ = (unsigned long long)(STAGGER_TICKS) * (unsigned)grp;
                    while (__builtin_amdgcn_s_memrealtime() - t0_ < dl_) __builtin_amdgcn_s_sleep(4); } }
            else grp_barrier(gbar, (unsigned)(7 * (ph / 9) + ph % 9));
        }
        if (PROBE4) t_sel += (unsigned)__builtin_amdgcn_s_memrealtime() - b_t0;
        if (PROBE_MASK) { const unsigned t = (unsigned)__builtin_amdgcn_s_memrealtime(); if ((PROBE_MASK >> ph) & 1) t_sel += t - t_prev; t_prev = t; }
    }
    if (PROBE_MASK && bx == 0 && tid == 0) args.out[0] += 100.f * (float)t_sel / (float)(t_prev - t_first);
    if (PROBE5 >= 0) { xcd_barrier(bar); if (bx == 0 && tid == 0) { const float rt_ = (float)MISC[26] / (float)MISC[27]; args.out[0] += rt_ < 15.f ? 20.f : rt_ < 17.f ? 40.f : rt_ < 19.f ? 60.f : rt_ < 21.f ? 80.f : 100.f; } }
    if (PROBE4) { const unsigned t_end = (unsigned)__builtin_amdgcn_s_memrealtime(); xcd_barrier(bar); if (bx == PROBE4 - 1 && tid == 0) args.out[0] += 100.f * (float)t_sel / (float)(t_end - t_first); }
    if (PROBE3) { const unsigned t_end = (unsigned)__builtin_amdgcn_s_memrealtime(); xcd_barrier(bar); if (bx == 0 && tid == 0) args.out[0] += 100.f * (float)MISC[23 + PROBE3] / (float)(t_end - t_first); }
    if (PROBE2_PHASE >= 0) { const unsigned t_end = (unsigned)__builtin_amdgcn_s_memrealtime(); xcd_barrier(bar); if (bx == 0 && tid == 0) args.out[0] += PROBE2_SEL == 9 ? ({ const float c_ = (float)MISC[20] / (float)MISC[22]; c_ < 2300.f ? 20.f : c_ < 2500.f ? 30.f : c_ < 2700.f ? 40.f : c_ < 2900.f ? 50.f : c_ < 3100.f ? 60.f : c_ < 3300.f ? 70.f : 80.f; }) : 1000.f * (float)MISC[(PROBE2_SEL >= 5 ? 21 : 20 + (PROBE2_SEL & 3))] / (float)(t_end - t_first); }
}
#ifndef FAST_MASK
#define FAST_MASK 0x3ffffu
#endif
#ifndef MERGE_LAUNCHES
#define MERGE_LAUNCHES 1
#endif
static void launch_slow_phase(const Inputs& I, int ph, unsigned char* ws, float* out, hipStream_t stream) {
    const int l = ph / 9, k = ph % 9;
    float* SS = (float*)(ws + WS_SS);
    bf16 *XB = (bf16*)(ws + WS_XB), *H = (bf16*)(ws + WS_H), *QKV = (bf16*)(ws + WS_QKV), *T = (bf16*)(ws + WS_T), *MRG = (bf16*)(ws + WS_MRG), *G = (bf16*)(ws + WS_G),
         *ONA = (bf16*)(ws + WS_ONA), *OSW = (bf16*)(ws + WS_OSW);
    float* ss0 = SS + (size_t)(3 * l + 0) * M; float* ss1 = SS + (size_t)(3 * l + 1) * M; float* ss2 = SS + (size_t)(3 * l + 2) * M; float* ss3 = SS + (size_t)(3 * l + 3) * M;
    switch (k) {
    case 0: if (l == 0) hipLaunchKernelGGL(slow::prep_x, dim3(M), dim3(256), 0, stream, I.x, XB, SS); break;
    case 1: { slow::OpFfnUp op{DM, 0, XB, I.ffn1_wg + (size_t)l * DM * FF, I.ffn1_wu + (size_t)l * DM * FF, I.ffn1_norm + l * DM, ss0, H};
              hipLaunchKernelGGL(slow::gemm<slow::OpFfnUp>, dim3(FF / 64, M / 64), dim3(256), 0, stream, op); } break;
    case 2: { slow::OpResid op{FF, 0.5f, H, I.ffn1_wd + (size_t)l * FF * DM, l == 0 ? I.x : out, out, XB, ss1};
              hipLaunchKernelGGL(slow::gemm<slow::OpResid>, dim3(DM / 64, M / 64), dim3(256), 0, stream, op); } break;
    case 3: { slow::OpWin op{DM, 0, XB, I.w_in + (size_t)l * DM * INW, I.mix_norm + l * DM, ss1, I.b_gate + l * NG, I.na_q_norm + l * 64, I.na_k_norm + l * 64, I.sw_q_norm + l * 64, I.sw_k_norm + l * 64, QKV, G};
              hipLaunchKernelGGL(slow::gemm<slow::OpWin>, dim3(INW / 64, M / 64), dim3(256), 0, stream, op); } break;
    case 4: hipLaunchKernelGGL(slow::attn_na, dim3(M * 8 / 4), dim3(256), 0, stream, QKV, I.na_rpb + (size_t)l * 8 * 15 * 31, ONA);
            hipLaunchKernelGGL(slow::attn_sw, dim3(M * 8 / 4), dim3(256), 0, stream, QKV, I.t5, I.sw_sink + l * 8, OSW); break;
    case 5: { slow::OpBranch op{512, 0, ONA, OSW, G, I.w_br_na + (size_t)l * 512 * DM, I.w_br_sw + (size_t)l * 512 * DM, T, MRG};
              hipLaunchKernelGGL(slow::gemm<slow::OpBranch>, dim3(DM / 64, M / 64), dim3(256), 0, stream, op); } break;
    case 6: { slow::OpResid op{DM, 1.0f, MRG, I.w_out + (size_t)l * DM * DM, out, out, XB, ss2};
              hipLaunchKernelGGL(slow::gemm<slow::OpResid>, dim3(DM / 64, M / 64), dim3(256), 0, stream, op); } break;
    case 7: { slow::OpFfnUp op{DM, 0, XB, I.ffn2_wg + (size_t)l * DM * FF, I.ffn2_wu + (size_t)l * DM * FF, I.ffn2_norm + l * DM, ss2, H};
              hipLaunchKernelGGL(slow::gemm<slow::OpFfnUp>, dim3(FF / 64, M / 64), dim3(256), 0, stream, op); } break;
    default: { const bool last = (l == DEPTH - 1);
              slow::OpResid op{FF, 0.5f, H, I.ffn2_wd + (size_t)l * FF * DM, out, out, last ? nullptr : XB, last ? nullptr : ss3};
              hipLaunchKernelGGL(slow::gemm<slow::OpResid>, dim3(DM / 64, M / 64), dim3(256), 0, stream, op); } break;
    }
}

extern "C" void kernel_launch(void* const* d_in, const int* in_sizes, int n_in, void* d_out, int out_size, void* d_ws, size_t ws_size, hipStream_t stream) {
    static int grid = 0;
    if (grid == 0) {
        if (n_in != 22 || in_sizes[0] != M * DM || out_size != M * DM || ws_size < WS_END) { fprintf(stderr, "kernel_launch: unexpected shapes (n_in %d, in0 %d, out %d, ws %zu)\n", n_in, n_in > 0 ? in_sizes[0] : -1, out_size, ws_size); grid = -1; return; }
        int dev = 0, cus = 0, per_cu = 0;
        if (hipGetDevice(&dev) != hipSuccess || hipDeviceGetAttribute(&cus, hipDeviceAttributeMultiprocessorCount, dev) != hipSuccess) { grid = -1; return; }
        if (hipFuncSetAttribute((const void*)mega_fwd, hipFuncAttributeMaxDynamicSharedMemorySize, LDS_BYTES) != hipSuccess) { fprintf(stderr, "kernel_launch: hipFuncSetAttribute failed\n"); grid = -1; return; }
        if (hipOccupancyMaxActiveBlocksPerMultiprocessor(&per_cu, (const void*)mega_fwd, NTHREADS, LDS_BYTES) != hipSuccess || per_cu < 1) fprintf(stderr, "kernel_launch: occupancy query says %d blocks/CU\n", per_cu);
        (void)hipGetLastError();
        grid = cus;
    }
    if (grid < 0) return;
    Inputs I;
    { const float** p = (const float**)&I; for (int i = 0; i < 22; ++i) p[i] = (const float*)d_in[i]; }
    unsigned char* ws = (unsigned char*)d_ws; float* out = (float*)d_out;
    (void)hipMemsetAsync(ws + WS_CTL, 0, CTL_ZERO_BYTES, stream);
    int region = 0;
#ifndef HOST_PH_END
#define HOST_PH_END N_PHASES
#endif
    for (int ph = 0; ph < HOST_PH_END;) {
        if (!((FAST_MASK >> ph) & 1u)) { launch_slow_phase(I, ph, ws, out, stream); ++ph; continue; }
        int hi = ph + 1;
        if (MERGE_LAUNCHES) while (hi < HOST_PH_END && ((FAST_MASK >> hi) & 1u)) ++hi;
        Args a{};
        a.I = I; a.out = out; a.ws = ws; a.ph_lo = ph; a.ph_hi = hi; a.bar_region = region++; a.pad = 0;
        hipLaunchKernelGGL(mega_fwd, dim3(grid), dim3(NTHREADS), LDS_BYTES, stream, a);
        ph = hi;
    }
}
```

```cpp
#include <hip/hip_runtime.h>
#include <cstdio>
#include <cstdint>

constexpr int BATCH = 8, SEQ = 2048, DM = 1024, DEPTH = 2, FF = 2816;
constexpr int M = BATCH * SEQ;
constexpr int GRID_W = 64, ROWS = SEQ / GRID_W;
constexpr int NQKV = 2304, NG = 2048, INW = NQKV + NG;
constexpr float EPS = 1e-6f;
constexpr float NEGV = -1e30f;

typedef unsigned short bf16;

constexpr size_t MiB = 1u << 20;
constexpr size_t WS_CTL = 0;
constexpr size_t WS_SS = 512 * 1024;
constexpr size_t CTL_ZERO_BYTES = 1 * MiB;
constexpr size_t WS_W = 1 * MiB;
constexpr size_t WS_XB = 47 * MiB;
constexpr size_t WS_H = 79 * MiB;
constexpr size_t WS_QKV = 79 * MiB;
constexpr size_t WS_T = 79 * MiB;
constexpr size_t WS_MRG = 111 * MiB;
constexpr size_t WS_G = 151 * MiB;
constexpr size_t WS_ONA = 215 * MiB;
constexpr size_t WS_OSW = 231 * MiB;
constexpr size_t WS_END = 247 * MiB;

__device__ __forceinline__ unsigned f2bf(float f) { unsigned u = __builtin_bit_cast(unsigned, f); return (u + 0x7fffu + ((u >> 16) & 1u)) >> 16; }
__device__ __forceinline__ float bf2f(unsigned b) { return __builtin_bit_cast(float, b << 16); }
__device__ __forceinline__ float bfr(float f) { return bf2f(f2bf(f)); }

struct Inputs {
    const float *x, *ffn1_norm, *ffn1_wg, *ffn1_wu, *ffn1_wd, *mix_norm, *w_in, *b_gate, *na_q_norm, *na_k_norm, *na_rpb, *sw_q_norm, *sw_k_norm, *sw_sink, *t5,
                *w_br_na, *w_br_sw, *w_out, *ffn2_norm, *ffn2_wg, *ffn2_wu, *ffn2_wd;
};

namespace slow {
template <class Op> __global__ void __launch_bounds__(256) gemm(Op op) {
    constexpr int NS = Op::NSEL;
    __shared__ float As[NS][16][68];
    __shared__ float Bs[NS][16][68];
    __shared__ float Cs[NS][64][65];
    const int tid = threadIdx.x, tx = tid & 15, ty = tid >> 4;
    const int m0 = blockIdx.y * 64, n0 = blockIdx.x * 64;
    float acc[NS][4][4];
#pragma unroll
    for (int s = 0; s < NS; ++s)
#pragma unroll
        for (int i = 0; i < 4; ++i)
#pragma unroll
            for (int j = 0; j < 4; ++j) acc[s][i][j] = 0.f;
    for (int k0 = 0; k0 < op.K; k0 += 16) {
#pragma unroll
        for (int s = 0; s < NS; ++s) {
#pragma unroll
            for (int e = 0; e < 4; ++e) {
                const int idx = tid + e * 256;
                { const int kk = idx & 15, mm = idx >> 4; As[s][kk][mm] = op.a(s, m0 + mm, k0 + kk); }
                { const int nn = idx & 63, kk = idx >> 6; Bs[s][kk][nn] = op.b(s, k0 + kk, n0 + nn); }
            }
        }
        __syncthreads();
#pragma unroll
        for (int kk = 0; kk < 16; ++kk) {
#pragma unroll
            for (int s = 0; s < NS; ++s) {
                float av[4], bv[4];
#pragma unroll
                for (int i = 0; i < 4; ++i) { av[i] = As[s][kk][ty * 4 + i]; bv[i] = Bs[s][kk][tx * 4 + i]; }
#pragma unroll
                for (int i = 0; i < 4; ++i)
#pragma unroll
                    for (int j = 0; j < 4; ++j) acc[s][i][j] += av[i] * bv[j];
            }
        }
        __syncthreads();
    }
#pragma unroll
    for (int s = 0; s < NS; ++s)
#pragma unroll
        for (int i = 0; i < 4; ++i)
#pragma unroll
            for (int j = 0; j < 4; ++j) Cs[s][ty * 4 + i][tx * 4 + j] = acc[s][i][j];
    __syncthreads();
    op.epi(m0, n0, Cs, tid);
}

struct OpFfnUp {
    static constexpr int NSEL = 2; int K, pad_;
    const bf16* xb; const float *wg, *wu, *gn, *ss; bf16* H;
    __device__ float a(int, int m, int k) const { return bf2f(xb[(size_t)m * DM + k]); }
    __device__ float b(int s, int k, int n) const { return bfr(gn[k] * (s ? wu : wg)[(size_t)k * FF + n]); }
    __device__ void epi(int m0, int n0, float (*Cs)[64][65], int tid) const {
        for (int e = tid; e < 4096; e += 256) { const int i = e >> 6, j = e & 63, m = m0 + i;
            const float r = rsqrtf(ss[m] * (1.f / DM) + EPS), zg = r * Cs[0][i][j], zu = r * Cs[1][i][j];
            const float h = zg / (1.f + __expf(-zg)) * zu;
            H[(size_t)m * FF + n0 + j] = (bf16)f2bf(h); }
    }
};
struct OpResid {
    static constexpr int NSEL = 1; int K; float alpha;
    const bf16* A; const float* w; const float* base; float* out; bf16* xb; float* ss;
    __device__ float a(int, int m, int k) const { return bf2f(A[(size_t)m * K + k]); }
    __device__ float b(int, int k, int n) const { return bfr(w[(size_t)k * DM + n]); }
    __device__ void epi(int m0, int n0, float (*Cs)[64][65], int tid) const {
        for (int e = tid; e < 4096; e += 256) { const int i = e >> 6, j = e & 63; const size_t o = (size_t)(m0 + i) * DM + n0 + j;
            const float v = base[o] + alpha * Cs[0][i][j]; out[o] = v; Cs[0][i][j] = v; if (xb) xb[o] = (bf16)f2bf(v); }
        __syncthreads();
        if (ss && tid < 64) { float s = 0.f; for (int j = 0; j < 64; ++j) s += Cs[0][tid][j] * Cs[0][tid][j]; atomicAdd(ss + m0 + tid, s); }
    }
};
struct OpWin {
    static constexpr int NSEL = 1; int K, pad_;
    const bf16* xb; const float *w, *gn, *ss, *bg, *naq, *nak, *swq, *swk; bf16 *QKV, *G;
    __device__ float a(int, int m, int k) const { return bf2f(xb[(size_t)m * DM + k]); }
    __device__ float b(int, int k, int n) const { return bfr(gn[k] * w[(size_t)k * INW + n]); }
    __device__ void epi(int m0, int n0, float (*Cs)[64][65], int tid) const {
        __shared__ float hn[64];
        const int hg = n0 >> 6;
        const float* gain = hg < 8 ? naq : hg < 16 ? nak : (hg >= 24 && hg < 32) ? swq : (hg >= 32 && hg < 34) ? swk : nullptr;
        const float qs = (hg < 8 || (hg >= 24 && hg < 32)) ? 0.125f : 1.f;
        for (int e = tid; e < 4096; e += 256) { const int i = e >> 6, j = e & 63; Cs[0][i][j] *= rsqrtf(ss[m0 + i] * (1.f / DM) + EPS); }
        __syncthreads();
        if (tid < 64) { float s = 0.f; for (int j = 0; j < 64; ++j) s += Cs[0][tid][j] * Cs[0][tid][j]; hn[tid] = rsqrtf(s * (1.f / 64.f) + EPS); }
        __syncthreads();
        for (int e = tid; e < 4096; e += 256) { const int i = e >> 6, j = e & 63, m = m0 + i; float z = Cs[0][i][j];
            if (hg < 36) { if (gain) z = z * hn[i] * gain[j] * qs; QKV[(size_t)m * NQKV + n0 + j] = (bf16)f2bf(z); }
            else { const int c = n0 - NQKV + j; z = 1.f / (1.f + __expf(-(z + bg[c]))); G[(size_t)m * NG + c] = (bf16)f2bf(z); } }
    }
};
struct OpBranch {
    static constexpr int NSEL = 2; int K, pad_;
    const bf16 *ONA, *OSW, *G; const float *pa, *pb; bf16 *T, *MRG;
    __device__ float a(int s, int m, int k) const { return bf2f((s ? OSW : ONA)[(size_t)m * 512 + k]); }
    __device__ float b(int s, int k, int n) const { return bfr((s ? pb : pa)[(size_t)k * DM + n]); }
    __device__ void epi(int m0, int n0, float (*Cs)[64][65], int tid) const {
        for (int e = tid; e < 4096; e += 256) { const int i = e >> 6, j = e & 63, m = m0 + i, n = n0 + j;
            const float gA = bf2f(G[(size_t)m * NG + n]), gB = bf2f(G[(size_t)m * NG + DM + n]);
            const float t = bfr(gA * Cs[0][i][j]); T[(size_t)m * DM + n] = (bf16)f2bf(t);
            MRG[(size_t)m * DM + n] = (bf16)f2bf(t + gB * Cs[1][i][j]); }
    }
};

__global__ void __launch_bounds__(256) prep_x(const float* x, bf16* xb, float* ss) {
    __shared__ float red[256];
    const int m = blockIdx.x, tid = threadIdx.x; float s = 0.f;
    for (int c = tid; c < DM; c += 256) { const float v = x[(size_t)m * DM + c]; xb[(size_t)m * DM + c] = (bf16)f2bf(v); s += v * v; }
    red[tid] = s; __syncthreads();
    for (int o = 128; o > 0; o >>= 1) { if (tid < o) red[tid] += red[tid + o]; __syncthreads(); }
    if (tid == 0) ss[m] = red[0];
}

__device__ __forceinline__ float wave_sum(float v) {
#pragma unroll
    for (int o = 1; o < 64; o <<= 1) v += __shfl_xor(v, o);
    return v;
}
__device__ __forceinline__ float wave_max(float v) {
#pragma unroll
    for (int o = 1; o < 64; o <<= 1) v = fmaxf(v, __shfl_xor(v, o));
    return v;
}
__global__ void __launch_bounds__(256) attn_na(const bf16* QKV, const float* rpb  , bf16* ONA) {
    __shared__ float sc[4][128];
    const int w = threadIdx.x >> 6, lane = threadIdx.x & 63;
    const int item = blockIdx.x * 4 + w;
    const int h = item & 7, tok = item >> 3, b = tok / SEQ, t = tok % SEQ, r = t / GRID_W, c = t % GRID_W;
    int rs = r - 4; rs = rs < 0 ? 0 : (rs > ROWS - 8 ? ROWS - 8 : rs);
    int cs = c - 8; cs = cs < 0 ? 0 : (cs > GRID_W - 16 ? GRID_W - 16 : cs);
    const float q = bf2f(QKV[(size_t)tok * NQKV + h * 64 + lane]);
    for (int j = 0; j < 128; ++j) { const int kr = rs + (j >> 4), kc = cs + (j & 15); const size_t kt = (size_t)b * SEQ + kr * GRID_W + kc;
        float s = wave_sum(q * bf2f(QKV[kt * NQKV + 512 + h * 64 + lane]));
        s += rpb[(h * 15 + (kr - r + 7)) * 31 + (kc - c + 15)];
        if (lane == 0) sc[w][j] = s; }
    __syncthreads();
    const float s0 = sc[w][lane], s1 = sc[w][lane + 64];
    const float mx = wave_max(fmaxf(s0, s1));
    const float e0 = __expf(s0 - mx), e1 = __expf(s1 - mx);
    const float l = wave_sum(e0 + e1);
    __syncthreads();
    sc[w][lane] = bfr(e0); sc[w][lane + 64] = bfr(e1);
    __syncthreads();
    float o = 0.f;
    for (int j = 0; j < 128; ++j) { const int kr = rs + (j >> 4), kc = cs + (j & 15); const size_t kt = (size_t)b * SEQ + kr * GRID_W + kc;
        o += sc[w][j] * bf2f(QKV[kt * NQKV + 1024 + h * 64 + lane]); }
    ONA[(size_t)tok * 512 + h * 64 + lane] = (bf16)f2bf(o / l);
}
__device__ __forceinline__ int t5_bucket(int rel) {
    const int n = rel < 0 ? -rel : rel; int v;
    if (n < 8) v = n; else { int k = 0; while (64 * (2 << k) <= n * n) ++k; v = 8 + k; v = v > 15 ? 15 : v; }
    return (rel > 0 ? 16 : 0) + v;
}
__global__ void __launch_bounds__(256) attn_sw(const bf16* QKV, const float* t5  , const float* sink  , bf16* OSW) {
    __shared__ float sc[4][320];
    const int w = threadIdx.x >> 6, lane = threadIdx.x & 63;
    const int item = blockIdx.x * 4 + w;
    const int h = item & 7, tok = item >> 3, b = tok / SEQ, t = tok % SEQ, g = h >> 2;
    const int k0 = t - 128 < 0 ? 0 : t - 128, k1 = t + 128 > SEQ - 1 ? SEQ - 1 : t + 128, nk = k1 - k0 + 1;
    const float q = bf2f(QKV[(size_t)tok * NQKV + 1536 + h * 64 + lane]);
    for (int j = 0; j < nk; ++j) { const size_t kt = (size_t)b * SEQ + k0 + j;
        float s = wave_sum(q * bf2f(QKV[kt * NQKV + 2048 + g * 64 + lane]));
        s += t5[t5_bucket(k0 + j - t) * 8 + h];
        if (lane == 0) sc[w][j] = s; }
    __syncthreads();
    const float snk = sink[h];
    float mx = snk; for (int j = lane; j < nk; j += 64) mx = fmaxf(mx, sc[w][j]);
    mx = wave_max(mx);
    float l = 0.f; for (int j = lane; j < nk; j += 64) { const float e = __expf(sc[w][j] - mx); l += e; sc[w][j] = bfr(e); }
    l = wave_sum(l) + __expf(snk - mx);
    __syncthreads();
    float o = 0.f;
    for (int j = 0; j < nk; ++j) { const size_t kt = (size_t)b * SEQ + k0 + j; o += sc[w][j] * bf2f(QKV[kt * NQKV + 2176 + g * 64 + lane]); }
    OSW[(size_t)tok * 512 + h * 64 + lane] = (bf16)f2bf(o / l);
}
}

#ifndef CODE_MASK
#define CODE_MASK 255
#endif
#ifndef PROBE2_PHASE
#define PROBE2_PHASE -1
#endif
#ifndef PROBE2_SEL
#define PROBE2_SEL 0
#endif
#ifndef PROBE3
#define PROBE3 0
#endif
#ifndef GROUPS
#define GROUPS 1
#endif
#ifndef PROBE5
#define PROBE5 -1
#endif
#ifndef RELAX_WAITS
#define RELAX_WAITS 1
#endif
#ifndef NA_V2
#define NA_V2 1
#endif
#ifndef RING4
#define RING4 0
#endif
#ifndef FULL_LINES
#define FULL_LINES 0
#endif
#ifndef NT_BASE
#define NT_BASE 0
#endif
#ifndef FORCE_FULL_RELEASE
#define FORCE_FULL_RELEASE 0
#endif
#ifndef WGM_P3
#define WGM_P3 PG8_WGM
#endif
#ifndef WGM_P1
#define WGM_P1 PG8_WGM
#endif
#ifndef STAGGER_TICKS
#define STAGGER_TICKS 0
#endif
#ifndef PROBE4
#define PROBE4 0
#endif
#ifndef PROBE_MASK
#define PROBE_MASK 0
#endif
#define LAS __attribute__((address_space(3)))
#define GAS __attribute__((address_space(1)))
typedef short bf16x8 __attribute__((ext_vector_type(8)));
typedef short s16x4 __attribute__((ext_vector_type(4)));
typedef float f32x4 __attribute__((ext_vector_type(4)));
typedef unsigned u32x4 __attribute__((ext_vector_type(4)));
typedef unsigned u32x2 __attribute__((ext_vector_type(2)));
typedef GAS unsigned gu32;

constexpr int NWAVES = 8, NTHREADS = 512;
constexpr int LDS_BYTES = 147456;
constexpr int RING_BYTES = 131072;
constexpr int MISC_OFF = RING_BYTES + 320;

constexpr size_t WO_1C = 0;
constexpr size_t WO_1D = WO_1C + (size_t)2 * FF * DM * 2;
constexpr size_t WO_IN = WO_1D + (size_t)DM * FF * 2;
constexpr size_t WO_PA = WO_IN + (size_t)INW * DM * 2;
constexpr size_t WO_PB = WO_PA + (size_t)DM * 512 * 2;
constexpr size_t WO_OUT = WO_PB + (size_t)DM * 512 * 2;
constexpr size_t WO_2C = WO_OUT + (size_t)DM * DM * 2;
constexpr size_t WO_2D = WO_2C + (size_t)2 * FF * DM * 2;
constexpr size_t WO_END = WO_2D + (size_t)DM * FF * 2;
static_assert(WS_W + WO_END <= WS_XB, "weight region");

typedef float f32x2_t __attribute__((ext_vector_type(2))); typedef __bf16 bf16x2_t __attribute__((ext_vector_type(2)));
__device__ __forceinline__ unsigned cvt_pk_bf16(float lo, float hi) { const f32x2_t v = {lo, hi}; const bf16x2_t b = __builtin_convertvector(v, bf16x2_t); return __builtin_bit_cast(unsigned, b); }
#ifndef WT_STORES
#define WT_STORES 0
#endif
typedef __amdgpu_buffer_rsrc_t rsrc_t;
__device__ __forceinline__ rsrc_t mk_rsrc(const void* p) { return __builtin_amdgcn_make_buffer_rsrc((void*)p, 0, 0x7fffffff, 0x00020000); }
__device__ __forceinline__ void st16(rsrc_t r, unsigned byteoff, u32x4 v) { __builtin_amdgcn_raw_buffer_store_b128(v, r, (int)byteoff, 0, (WT_STORES & 1) ? 16 : 0); }
__device__ __forceinline__ void st16o(rsrc_t r, unsigned byteoff, u32x4 v) { __builtin_amdgcn_raw_buffer_store_b128(v, r, (int)byteoff, 0, (WT_STORES & 2) ? 16 : (WT_STORES & 4) ? 2 : 0); }
__device__ __forceinline__ float fast_sigmoid(float z) { return __builtin_amdgcn_rcpf(1.f + __builtin_amdgcn_exp2f(-1.4426950408889634f * z)); }
__device__ __forceinline__ float rs_row(const float* ss, int row) { return __builtin_amdgcn_rsqf(ss[row] * (1.f / DM) + EPS); }

namespace pg8 {
#ifndef PG8_WGM
#define PG8_WGM 4
#endif
constexpr int BM = 256, BK = 64, HALF = 128, HTB = HALF * BK * 2, STAGE_BYTES = 8 * HTB, NXCD = 8, WGM = PG8_WGM;
__host__ __device__ __forceinline__ int lds_byte(int r, int c) { const int st = (r >> 4) * 2 + (c >> 5), rr = r & 15, cc = c & 31, ob = rr * 64 + cc * 2; return st * 1024 + (ob ^ (((ob >> 9) & 1) << 5)); }
__host__ __device__ __forceinline__ void stage_rc(int b, int& R, int& C) { const int st = b / 1024, sb = b % 1024, swz = sb ^ (((sb >> 9) & 1) << 5); R = (st >> 1) * 16 + swz / 64; C = (st & 1) * 32 + (swz % 64) / 2; }
struct Unit { int pm, pn, hf, sel; };
struct Gemm { const bf16* A; const bf16* Bt; int M, N, K; const bf16* A2; const bf16* Bt2; };
struct StaticOrder {
    int nM, nN, nwg, G, c, nfull, ntot, wgm;
    __device__ void init(int M_, int N_, int G_, int c_, int wgm_ = WGM) { nM = M_ / BM; nN = N_ / BM; nwg = nM * nN; G = G_; c = c_; wgm = wgm_;
        const int rem = nwg % G; const bool split = rem > 0 && 2 * rem <= G && (nwg % NXCD) == 0 && (rem % NXCD) == 0 && (G % NXCD) == 0;
        nfull = split ? nwg - rem : nwg; ntot = split ? nfull + 2 * rem : nwg; }
    __device__ bool next(int i, Unit& u) const {
        const long L = (long)i * G + c; if (L >= ntot) return false;
        const int q = nwg / NXCD, r = nwg % NXCD; int wgid;
        if (L < nfull) { const int xcd = (int)L % NXCD, off = (int)L / NXCD; wgid = (xcd < r ? xcd * (q + 1) : r * (q + 1) + (xcd - r) * q) + off; u.hf = 0; }
        else { const int Lp = (int)L - nfull, xcd = Lp % NXCD, idx = Lp / NXCD; wgid = xcd * q + nfull / NXCD + (idx >> 1); u.hf = 1 + (idx & 1); }
        const int nig = wgm * nN, gid = wgid / nig, fm = gid * wgm, gsz = (nM - fm) < wgm ? (nM - fm) : wgm;
        u.pm = fm + ((wgid % nig) % gsz); u.pn = (wgid % nig) / gsz; u.sel = 0; return true;
    }
};
struct DualOrder { StaticOrder S;
    __device__ bool next(int i, Unit& u) const { if (!S.next(i >> 1, u)) return false; u.sel = i & 1; return true; } };
struct NoBar { __device__ __forceinline__ void operator()() const {} template <class Hook> __device__ __forceinline__ void run(const Hook& h) const { h(); } };
template <class Epi, class AccT> struct PreloadHook { const Epi& E; AccT& acc; const Unit& u; int wr, wc, fr, fq; __device__ __forceinline__ void operator()() const { E.preload(acc, u, wr, wc, fr, fq); } };
template <class Epi, bool ALIGN_EPI, bool SP2, class Sched = StaticOrder, class Bar = NoBar>
__device__ __forceinline__ void gemm_phase(LAS unsigned char* lds, const Gemm g, const Sched& S, const Epi& E, const Bar& PB = Bar()) {
    int tid_ = threadIdx.x; asm volatile("" : "+v"(tid_));
    const int tid = tid_, wid = __builtin_amdgcn_readfirstlane(tid >> 6), lane = tid & 63, wr = wid >> 2, wc = wid & 3, fr = lane & 15, fq = lane >> 4;
    const int K = g.K, nt = K / BK;
    unsigned voff[2];
#pragma unroll
    for (int i = 0; i < 2; ++i) { int R, C; if (FULL_LINES) { R = 8 * (wid + 8 * i) + (lane >> 3); C = 8 * ((lane & 7) ^ (lane >> 3)); } else stage_rc(tid * 16 + i * 8192, R, C); voff[i] = (unsigned)(R * K + C) * 2u; }
    const size_t kstep = (size_t)(BK * 2), hstep = (size_t)HALF * K * 2, tstep = 2 * hstep;
    const unsigned ldsw = (unsigned)wid * 1024u;
    const int aoff = FULL_LINES ? (8 * wr + (fr >> 3)) * 1024 + (fr & 7) * 128 + ((fq ^ (fr & 7)) << 4) : lds_byte(wr * 64 + fr, fq * 8);
    const int boff = FULL_LINES ? (4 * wc + (fr >> 3)) * 1024 + (fr & 7) * 128 + ((fq ^ (fr & 7)) << 4) : lds_byte(wc * 32 + fr, fq * 8);
    const int aoff1 = FULL_LINES ? (aoff ^ 64) : aoff + 1024, boff1 = FULL_LINES ? (boff ^ 64) : boff + 1024;
#define PG8_SA(b, h) (((b) * 2 + (h)) * HTB)
#define PG8_SB(b, h) ((4 + (b) * 2 + (h)) * HTB)
#define PG8_STAGE(bufoff, gbase) do { _Pragma("unroll") for (int _i = 0; _i < 2; ++_i) \
        __builtin_amdgcn_global_load_lds((const unsigned*)((const char*)(gbase) + voff[_i]), (LAS unsigned*)(lds + (bufoff) + ldsw + _i * 8192), 16, 0, 0); } while (0)
#define PG8_STAGEH(bufoff, gbase, hflag) do { _Pragma("unroll") for (int _i = 0; _i < 2; ++_i) \
        __builtin_amdgcn_global_load_lds((const unsigned*)((const char*)(gbase) + ((hflag) ? 0u : voff[_i])), (LAS unsigned*)(lds + (bufoff) + ldsw + _i * 8192), 16, 0, 0); } while (0)
#define PG8_LDA(dst, b, h) do { _Pragma("unroll") for (int m = 0; m < 4; ++m) _Pragma("unroll") for (int k = 0; k < 2; ++k) dst[m][k] = *(const LAS bf16x8*)(lds + PG8_SA(b, h) + (k ? aoff1 : aoff) + m * 2048); } while (0)
#define PG8_LDB(dst, b, h) do { _Pragma("unroll") for (int n = 0; n < 2; ++n) _Pragma("unroll") for (int k = 0; k < 2; ++k) dst[n][k] = *(const LAS bf16x8*)(lds + PG8_SB(b, h) + (k ? boff1 : boff) + n * 2048); } while (0)
#define PG8_MMA(ai, bj, At, Bt) do { __builtin_amdgcn_s_setprio(1); _Pragma("unroll") for (int m = 0; m < 4; ++m) _Pragma("unroll") for (int n = 0; n < 2; ++n) _Pragma("unroll") for (int k = 0; k < 2; ++k) \
        acc[ai][bj][m][n] = __builtin_amdgcn_mfma_f32_16x16x32_bf16(Bt[n][k], At[m][k], acc[ai][bj][m][n], 0, 0, 0); __builtin_amdgcn_s_setprio(0); } while (0)
#define PG8_WAIT_V(n) asm volatile("s_waitcnt vmcnt(" #n ")" ::: "memory")
#define PG8_WAIT_L(n) asm volatile("s_waitcnt lgkmcnt(" #n ")" ::: "memory")
#define PG8_BAR __builtin_amdgcn_s_barrier()
#define PG8_SCHED __builtin_amdgcn_sched_barrier(0)
#define PG8_TRIP(W12) do { \
            const bool last = (t == nt - 2); \
            const char* a1 = cA + (size_t)(t + 1) * kstep; \
            const char* a2 = last ? nA : cA + (size_t)(t + 2) * kstep; const char* b2 = last ? nB : cB + (size_t)(t + 2) * kstep; \
            const char* a3 = a2 + kstep; const char* b3 = b2 + kstep; const size_t hs2 = last ? nhs : chs; \
            PG8_LDB(B0, 0, 0); PG8_LDB(B1, 0, 1); PG8_SCHED; PG8_LDA(At, 0, 0); PG8_STAGEH(PG8_SA(1, 1), a1 + chs, chalf_st); \
            W12; PG8_WAIT_L(0); PG8_BAR; PG8_MMA(0, 0, At, B0); PG8_MMA(0, 1, At, B1); PG8_BAR; PG8_SCHED; \
            if (!chalf) { PG8_LDA(At, 0, 1); } PG8_STAGE(PG8_SB(0, 0), b2); PG8_STAGE(PG8_SB(0, 1), b2 + hstep); PG8_STAGE(PG8_SA(0, 0), a2); \
            W12; PG8_WAIT_L(0); PG8_BAR; if (!chalf) { PG8_MMA(1, 0, At, B0); PG8_MMA(1, 1, At, B1); } PG8_BAR; PG8_SCHED; \
            PG8_LDB(B0, 1, 0); PG8_LDB(B1, 1, 1); PG8_SCHED; PG8_LDA(At, 1, 0); if (last) chalf_st = nhalf_st; PG8_STAGEH(PG8_SA(0, 1), a2 + hs2, chalf_st); \
            PG8_WAIT_V(8); PG8_WAIT_L(0); PG8_BAR; PG8_MMA(0, 0, At, B0); PG8_MMA(0, 1, At, B1); PG8_BAR; PG8_SCHED; \
            if (!chalf) { PG8_LDA(At, 1, 1); } PG8_STAGE(PG8_SB(1, 0), b3); PG8_STAGE(PG8_SB(1, 1), b3 + hstep); PG8_STAGE(PG8_SA(1, 0), a3); \
            PG8_WAIT_V(8); PG8_WAIT_L(0); PG8_BAR; if (!chalf) { PG8_MMA(1, 0, At, B0); PG8_MMA(1, 1, At, B1); } PG8_BAR; PG8_SCHED; \
        } while (0)
    unsigned pe0 = 0, pe1 = 0; if (PROBE2_PHASE >= 0 && Epi::PROBE && PROBE2_SEL == 6) pe0 = (unsigned)__builtin_amdgcn_s_memrealtime();
    Unit cur, nxt; int ui = 0;
    if (!S.next(0, cur)) { PB(); return; }
    unsigned pa0 = 0, pa1 = 0, pa2 = 0;
    f32x4 acc[2][2][4][2];
    if constexpr (Epi::PRELOAD) { PB.run(PreloadHook<Epi, decltype(acc)>{E, acc, cur, wr, wc, fr, fq}); E.prescale(acc); }
    else { PB();
#pragma unroll
    for (int a = 0; a < 2; ++a)
#pragma unroll
        for (int b = 0; b < 2; ++b)
#pragma unroll
            for (int m = 0; m < 4; ++m)
#pragma unroll
                for (int n = 0; n < 2; ++n) acc[a][b][m][n] = (f32x4){0.f, 0.f, 0.f, 0.f};
    }
    bf16x8 At[4][2], B0[2][2], B1[2][2];
    const char* cA = (const char*)(cur.sel ? g.A2 : g.A) + (size_t)cur.pm * tstep + (cur.hf == 2 ? hstep : 0); const char* cB = (const char*)(cur.sel ? g.Bt2 : g.Bt) + (size_t)cur.pn * tstep;
    size_t chs = cur.hf ? 0 : hstep;
    bool chalf_st = cur.hf != 0;
    if constexpr (SP2) {
        PG8_STAGE(PG8_SB(0, 0), cB); PG8_STAGE(PG8_SB(0, 1), cB + hstep); PG8_STAGE(PG8_SA(0, 0), cA); PG8_STAGEH(PG8_SA(0, 1), cA + chs, chalf_st);
        if (wr == 1) PG8_BAR;
        PG8_WAIT_V(2); PG8_BAR;
        PG8_STAGE(PG8_SB(1, 0), cB + kstep); PG8_STAGE(PG8_SA(1, 0), cA + kstep); PG8_STAGE(PG8_SB(1, 1), cB + hstep + kstep);
        PG8_WAIT_V(6); PG8_BAR;
    } else {
        PG8_STAGE(PG8_SB(0, 0), cB); PG8_STAGE(PG8_SA(0, 0), cA); PG8_STAGE(PG8_SB(0, 1), cB + hstep); PG8_STAGEH(PG8_SA(0, 1), cA + chs, chalf_st);
        if (wr == 1) PG8_BAR;
        PG8_WAIT_V(4); PG8_BAR;
        PG8_STAGE(PG8_SB(1, 0), cB + kstep); PG8_STAGE(PG8_SA(1, 0), cA + kstep); PG8_STAGE(PG8_SB(1, 1), cB + hstep + kstep);
        PG8_WAIT_V(6); PG8_BAR;
    }
    for (;;) {
        const bool has_next = S.next(ui + 1, nxt);
        if (PROBE2_PHASE >= 0 && Epi::PROBE && PROBE2_SEL == 6 && ui == 0) pe1 = (unsigned)__builtin_amdgcn_s_memrealtime();
        unsigned p_t0 = 0; if (PROBE2_PHASE >= 0 && Epi::PROBE) p_t0 = PROBE2_SEL == 9 ? (unsigned)__builtin_amdgcn_s_memtime() : (unsigned)__builtin_amdgcn_s_memrealtime();
        const char* nA = has_next ? (const char*)(nxt.sel ? g.A2 : g.A) + (size_t)nxt.pm * tstep + (nxt.hf == 2 ? hstep : 0) : cA; const char* nB = has_next ? (const char*)(nxt.sel ? g.Bt2 : g.Bt) + (size_t)nxt.pn * tstep : cB;
        const size_t nhs = has_next ? (nxt.hf ? 0 : hstep) : chs; const bool chalf = cur.hf != 0;
        const bool nhalf_st = has_next ? (nxt.hf != 0) : chalf_st;
        static_assert(SP2, "only the two-super-phase loop is kept");
        { int t = 0;
          if constexpr (RELAX_WAITS && Epi::MULTI) { if (ui > 0) { PG8_TRIP((void)0); t = 2; } }
          for (; t < nt; t += 2) { PG8_TRIP(PG8_WAIT_V(8)); } }
        unsigned p_t1 = 0; if (PROBE2_PHASE >= 0 && Epi::PROBE) p_t1 = PROBE2_SEL == 9 ? (unsigned)__builtin_amdgcn_s_memtime() : (unsigned)__builtin_amdgcn_s_memrealtime();
        if constexpr (ALIGN_EPI) { if (wr == 0) PG8_BAR; }
        E(acc, cur, wr, wc, fr, fq);
        if (PROBE2_PHASE >= 0 && Epi::PROBE) { const unsigned p_t3 = (unsigned)__builtin_amdgcn_s_memrealtime(); pa0 += p_t1 - p_t0; if (ui == 0 && PROBE2_SEL < 5) pa1 = p_t1 - p_t0; pa2 += (PROBE2_SEL == 9) ? (unsigned)(cur.hf ? 0 : nt) : p_t3 - p_t1; }
        if (!has_next) break;
        if (!Epi::CHAIN || cur.sel != 0) {
#pragma unroll
        for (int a = 0; a < 2; ++a)
#pragma unroll
            for (int b = 0; b < 2; ++b)
#pragma unroll
                for (int m = 0; m < 4; ++m)
#pragma unroll
                    for (int n = 0; n < 2; ++n) acc[a][b][m][n] = (f32x4){0.f, 0.f, 0.f, 0.f};
        }
        cur = nxt; cA = nA; cB = nB; chs = nhs; ++ui;
        if constexpr (ALIGN_EPI) { if (wr == 1) PG8_BAR; }
    }
    unsigned pd0 = 0; if (PROBE2_PHASE >= 0 && Epi::PROBE && PROBE2_SEL == 5) pd0 = (unsigned)__builtin_amdgcn_s_memrealtime();
    PG8_WAIT_V(0);
    if constexpr (!ALIGN_EPI) { if (wr == 0) PG8_BAR; }
    PG8_BAR;
    if (PROBE2_PHASE >= 0 && Epi::PROBE && PROBE2_SEL == 5) pa1 = (unsigned)__builtin_amdgcn_s_memrealtime() - pd0;
    if (PROBE2_PHASE >= 0 && Epi::PROBE && PROBE2_SEL == 6) pa1 = pe1 - pe0;
    if (PROBE2_PHASE >= 0 && Epi::PROBE) { volatile LAS unsigned* PM = (volatile LAS unsigned*)(lds + MISC_OFF); if (tid == 0 && PM[19]) { PM[20] = pa0; PM[21] = pa1; PM[22] = pa2; } }
#undef PG8_TRIP
#undef PG8_SA
#undef PG8_SB
#undef PG8_STAGE
#undef PG8_LDA
#undef PG8_LDB
#undef PG8_MMA
#undef PG8_WAIT_V
#undef PG8_WAIT_L
#undef PG8_BAR
#undef PG8_SCHED
}

typedef f32x4 Acc[2][2][4][2];
struct EpiFfnUp {
    static constexpr bool PROBE = (PROBE2_PHASE % 9 == 1) || (PROBE2_PHASE % 9 == 7), MULTI = true, PRELOAD = false, CHAIN = false;
    bf16* H; const float* ss;
    __device__ __forceinline__ void operator()(const Acc& acc, const Unit& u, int wr, int wc, int fr, int fq) const {
        const int row0 = u.pm * BM + (u.hf == 2 ? HALF : 0) + wr * 64 + fr, col0 = u.pn * 128 + wc * 32 + 8 * fq; const int nai = u.hf ? 1 : 2;
        const rsrc_t rH = mk_rsrc(H);
        float rr[2][4];
#pragma unroll
        for (int ai = 0; ai < 2; ++ai)
#pragma unroll
            for (int m = 0; m < 4; ++m) rr[ai][m] = ss[row0 + (ai < nai ? ai : 0) * HALF + m * 16];
#pragma unroll
        for (int ai = 0; ai < 2; ++ai) if (ai < nai)
#pragma unroll
            for (int m = 0; m < 4; ++m) { const int row = row0 + ai * HALF + m * 16; const float r = __builtin_amdgcn_rsqf(rr[ai][m] * (1.f / DM) + EPS); float h[8];
#pragma unroll
                for (int n = 0; n < 2; ++n)
#pragma unroll
                    for (int j = 0; j < 4; ++j) { const float zg = r * acc[ai][0][m][n][j], zu = r * acc[ai][1][m][n][j]; h[4 * n + j] = zg * fast_sigmoid(zg) * zu; }
                u32x4 w; w.x = cvt_pk_bf16(h[0], h[1]); w.y = cvt_pk_bf16(h[2], h[3]); w.z = cvt_pk_bf16(h[4], h[5]); w.w = cvt_pk_bf16(h[6], h[7]);
                st16(rH, (unsigned)(row * FF + col0) * 2u, w); }
    }
};
template <bool FB> struct EpiResidT {
    static constexpr bool PROBE = (PROBE2_PHASE % 9 == 2) || (PROBE2_PHASE % 9 == 6) || (PROBE2_PHASE % 9 == 8), MULTI = false, PRELOAD = true, CHAIN = false;
    const float* basef; float* out; bf16* xb; float* ss; float alpha;
    __device__ __forceinline__ void preload(Acc& acc, const Unit& u, int wr, int wc, int fr, int fq) const {
        const int row0 = u.pm * BM + wr * 64 + fr, col0 = u.pn * BM + wc * 64 + 8 * fq;
        const unsigned o0 = (unsigned)(row0 * DM + col0);
        if constexpr (FB) { const rsrc_t rB = mk_rsrc(basef);
#pragma unroll
            for (int ai = 0; ai < 2; ++ai)
#pragma unroll
                for (int m = 0; m < 4; ++m)
#pragma unroll
                    for (int bj = 0; bj < 2; ++bj) { const unsigned o = o0 + (unsigned)((ai * HALF + m * 16) * DM + bj * 32);
                        acc[ai][bj][m][0] = __builtin_bit_cast(f32x4, __builtin_amdgcn_raw_buffer_load_b128(rB, (int)(o * 4u), 0, 0)); acc[ai][bj][m][1] = __builtin_bit_cast(f32x4, __builtin_amdgcn_raw_buffer_load_b128(rB, (int)(o * 4u + 16u), 0, 0)); }
        } else { const rsrc_t rX = mk_rsrc(xb);
#pragma unroll
            for (int ai = 0; ai < 2; ++ai)
#pragma unroll
                for (int m = 0; m < 4; ++m)
#pragma unroll
                    for (int bj = 0; bj < 2; ++bj) { const unsigned o = o0 + (unsigned)((ai * HALF + m * 16) * DM + bj * 32);
                        acc[ai][bj][m][0] = __builtin_bit_cast(f32x4, __builtin_amdgcn_raw_buffer_load_b128(rX, (int)(o * 2u), 0, 0)); }
        }
    }
    __device__ __forceinline__ void prescale(Acc& acc) const {
        const float ia = 1.0f / alpha;
#pragma unroll
        for (int ai = 0; ai < 2; ++ai)
#pragma unroll
            for (int bj = 0; bj < 2; ++bj)
#pragma unroll
                for (int m = 0; m < 4; ++m) {
                    if constexpr (!FB) { const u32x4 q = __builtin_bit_cast(u32x4, acc[ai][bj][m][0]);
                        acc[ai][bj][m][0] = (f32x4){__builtin_bit_cast(float, q.x << 16), __builtin_bit_cast(float, q.x & 0xffff0000u), __builtin_bit_cast(float, q.y << 16), __builtin_bit_cast(float, q.y & 0xffff0000u)};
                        acc[ai][bj][m][1] = (f32x4){__builtin_bit_cast(float, q.z << 16), __builtin_bit_cast(float, q.z & 0xffff0000u), __builtin_bit_cast(float, q.w << 16), __builtin_bit_cast(float, q.w & 0xffff0000u)}; }
                    acc[ai][bj][m][0] = acc[ai][bj][m][0] * ia; acc[ai][bj][m][1] = acc[ai][bj][m][1] * ia; }
    }
    __device__ __forceinline__ void operator()(const Acc& acc, const Unit& u, int wr, int wc, int fr, int fq) const {
        const int row0 = u.pm * BM + wr * 64 + fr, col0 = u.pn * BM + wc * 64 + 8 * fq;
        const rsrc_t rO = mk_rsrc(out), rX = mk_rsrc(xb);
#pragma unroll
        for (int ai = 0; ai < 2; ++ai) {
#pragma unroll
            for (int m = 0; m < 4; ++m) { const int row = row0 + ai * HALF + m * 16; float part = 0.f;
#pragma unroll
                for (int bj = 0; bj < 2; ++bj) { const size_t o = (size_t)row * DM + col0 + bj * 32;
                    const f32x4 v0 = alpha * acc[ai][bj][m][0], v1 = alpha * acc[ai][bj][m][1];
                    if (out) { st16o(rO, (unsigned)o * 4u, __builtin_bit_cast(u32x4, v0)); st16o(rO, (unsigned)o * 4u + 16u, __builtin_bit_cast(u32x4, v1)); }
                    else { u32x4 w; w.x = cvt_pk_bf16(v0[0], v0[1]); w.y = cvt_pk_bf16(v0[2], v0[3]); w.z = cvt_pk_bf16(v1[0], v1[1]); w.w = cvt_pk_bf16(v1[2], v1[3]); st16(rX, (unsigned)o * 2u, w);
                        const float r0 = __builtin_bit_cast(float, w.x << 16), r1 = __builtin_bit_cast(float, w.x & 0xffff0000u), r2 = __builtin_bit_cast(float, w.y << 16), r3 = __builtin_bit_cast(float, w.y & 0xffff0000u),
                                    r4 = __builtin_bit_cast(float, w.z << 16), r5 = __builtin_bit_cast(float, w.z & 0xffff0000u), r6 = __builtin_bit_cast(float, w.w << 16), r7 = __builtin_bit_cast(float, w.w & 0xffff0000u);
                        part += (r0 * r0 + r1 * r1) + (r2 * r2 + r3 * r3) + (r4 * r4 + r5 * r5) + (r6 * r6 + r7 * r7); } }
                if (ss) { part += __shfl_xor(part, 16); part += __shfl_xor(part, 32); if (fq == 0) atomicAdd(ss + row, part); }
                __builtin_amdgcn_sched_barrier(0); }
            asm volatile("" ::: "memory"); }
    }
};
struct EpiWin {
    static constexpr bool PROBE = (PROBE2_PHASE % 9 == 3), MULTI = true, PRELOAD = false, CHAIN = false;
    bf16 *QKV, *G; const float* ss; const LAS float* tab;
    __device__ __forceinline__ void operator()(const Acc& acc, const Unit& u, int wr, int wc, int fr, int fq) const {
        const int hg = __builtin_amdgcn_readfirstlane(4 * u.pn + wc);
        const int row0 = u.pm * BM + (u.hf == 2 ? HALF : 0) + wr * 64 + fr; const int nai = u.hf ? 1 : 2;
        const int gt = hg < 8 ? 0 : hg < 16 ? 1 : (hg >= 24 && hg < 32) ? 2 : (hg >= 32 && hg < 34) ? 3 : -1;
        const float qs = (hg < 8 || (hg >= 24 && hg < 32)) ? 0.125f : 1.f;
        const bool gate = hg >= 36;
        const LAS float* gsrc = tab + (gate ? 64 * (hg - 36) : 2048 + 64 * (gt < 0 ? 0 : gt)) + 8 * fq;
        const rsrc_t rD = mk_rsrc(gate ? G : QKV);
        const unsigned dst0 = gate ? (unsigned)(row0 * NG + 64 * (hg - 36) + 8 * fq) * 2u : (unsigned)(row0 * NQKV + 64 * hg + 8 * fq) * 2u;
        const int pitch = gate ? NG : NQKV;
#pragma unroll
        for (int ai = 0; ai < 2; ++ai) if (ai < nai) {
            float rr[4];
#pragma unroll
            for (int m = 0; m < 4; ++m) rr[m] = ss[row0 + ai * HALF + m * 16];
#pragma unroll
            for (int m = 0; m < 4; ++m) { const int ro = ai * HALF + m * 16; const float r = __builtin_amdgcn_rsqf(rr[m] * (1.f / DM) + EPS);
                f32x4 z[2][2]; float q = 0.f;
#pragma unroll
                for (int bj = 0; bj < 2; ++bj)
#pragma unroll
                    for (int n = 0; n < 2; ++n) { z[bj][n] = r * acc[ai][bj][m][n]; const f32x4 t = z[bj][n]; q += (t[0] * t[0] + t[1] * t[1]) + (t[2] * t[2] + t[3] * t[3]); }
                if (gate) {
#pragma unroll
                    for (int bj = 0; bj < 2; ++bj)
#pragma unroll
                        for (int n = 0; n < 2; ++n) { const f32x4 gv = *(const LAS f32x4*)(gsrc + 32 * bj + 4 * n);
#pragma unroll
                            for (int j = 0; j < 4; ++j) z[bj][n][j] = fast_sigmoid(z[bj][n][j] + gv[j]); }
                } else if (gt >= 0) {
                    q += __shfl_xor(q, 16); q += __shfl_xor(q, 32);
                    const float hn = __builtin_amdgcn_rsqf(q * (1.f / 64.f) + EPS) * qs;
#pragma unroll
                    for (int bj = 0; bj < 2; ++bj)
#pragma unroll
                        for (int n = 0; n < 2; ++n) { const f32x4 gv = *(const LAS f32x4*)(gsrc + 32 * bj + 4 * n); z[bj][n] = z[bj][n] * hn * gv; }
                }
                const unsigned dst = dst0 + (unsigned)(ro * pitch) * 2u;
#pragma unroll
                for (int bj = 0; bj < 2; ++bj) { u32x4 w; w.x = cvt_pk_bf16(z[bj][0][0], z[bj][0][1]); w.y = cvt_pk_bf16(z[bj][0][2], z[bj][0][3]); w.z = cvt_pk_bf16(z[bj][1][0], z[bj][1][1]); w.w = cvt_pk_bf16(z[bj][1][2], z[bj][1][3]);
                    st16(rD, dst + 64u * bj, w); }
                } }
    }
};
struct EpiBranch {
    static constexpr bool PROBE = false, MULTI = false, PRELOAD = false, CHAIN = true;
    bf16* MRG; const bf16* G;
    __device__ __forceinline__ void operator()(Acc& acc, const Unit& u, int wr, int wc, int fr, int fq) const {
        const int row0 = u.pm * BM + (u.hf == 2 ? HALF : 0) + wr * 64 + fr, col0 = u.pn * BM + wc * 64 + 8 * fq; const int nai = u.hf ? 1 : 2;
        const bool second = u.sel != 0;
#pragma unroll
        for (int ai = 0; ai < 2; ++ai) if (ai < nai) {
            u32x4 ga[4][2], gb[4][2];
#pragma unroll
            for (int m = 0; m < 4; ++m)
#pragma unroll
                for (int bj = 0; bj < 2; ++bj) { const int row = row0 + ai * HALF + m * 16, c = col0 + 32 * bj;
                    gb[m][bj] = *(const u32x4*)(G + (size_t)row * NG + DM + c);
                    ga[m][bj] = (u32x4){0u, 0u, 0u, 0u}; if (!second) ga[m][bj] = *(const u32x4*)(G + (size_t)row * NG + c); }
#pragma unroll
            for (int m = 0; m < 4; ++m)
#pragma unroll
                for (int bj = 0; bj < 2; ++bj) { const size_t o = (size_t)(row0 + ai * HALF + m * 16) * DM + col0 + 32 * bj;
                    float v[8];
#pragma unroll
                    for (int e = 0; e < 8; ++e) { const unsigned aq = ga[m][bj][e >> 1], bq = gb[m][bj][e >> 1];
                        const float fa = __builtin_bit_cast(float, (e & 1) ? (aq & 0xffff0000u) : (aq << 16)), fb = fmaxf(__builtin_bit_cast(float, (e & 1) ? (bq & 0xffff0000u) : (bq << 16)), 9.5367431640625e-07f);
                        const float f = second ? fb : fa * __builtin_amdgcn_rcpf(fb);
                        v[e] = f * acc[ai][bj][m][e >> 2][e & 3]; acc[ai][bj][m][e >> 2][e & 3] = v[e]; }
                    if (second) { u32x4 w; w.x = cvt_pk_bf16(v[0], v[1]); w.y = cvt_pk_bf16(v[2], v[3]); w.z = cvt_pk_bf16(v[4], v[5]); w.w = cvt_pk_bf16(v[6], v[7]);
                        *(u32x4*)(MRG + o) = w; }
                    __builtin_amdgcn_sched_barrier(0); }
            asm volatile("" ::: "memory"); }
    }
};
}

namespace pg8 {
template <class Epi, class Sched>
__device__ __forceinline__ void gemm_ring4(LAS unsigned char* lds, const Gemm g, const Sched& S, const Epi& E) {
    int tid_ = threadIdx.x; asm volatile("" : "+v"(tid_));
    const int tid = tid_, wid = __builtin_amdgcn_readfirstlane(tid >> 6), lane = tid & 63, wr = wid >> 2, wc = wid & 3, fr = lane & 15, fq = lane >> 4;
    const int K = g.K, ns = K / 32;
    unsigned voff0;
    { const int p = lane * 16, ob = p ^ (((p >> 9) & 1) << 5), R = ob >> 6, C = (ob & 63) >> 1; voff0 = (unsigned)((32 * wid + R) * K + C) * 2u; }
    const size_t pstep = (size_t)16 * K * 2;
    const size_t hstep = (size_t)HALF * K * 2, tstep = 2 * hstep;
    const unsigned ldsw = (unsigned)wid * 2048u;
    const int loff = (fr * 64 + fq * 16) ^ ((((fr * 64 + fq * 16) >> 9) & 1) << 5);
    const int a_base = 4 * wr * 1024 + loff, b_base = 16384 + 2 * wc * 1024 + loff;
#define R4_STAGE(bufoff, gA, gB, khalf) do { _Pragma("unroll") for (int _i = 0; _i < 2; ++_i) { \
        __builtin_amdgcn_global_load_lds((const unsigned*)((const char*)(gA) + (((khalf) && wid >= 4) ? (size_t)0 : _i * pstep + voff0)), (LAS unsigned*)(lds + (bufoff) + ldsw + _i * 1024), 16, 0, 0); \
        __builtin_amdgcn_global_load_lds((const unsigned*)((const char*)(gB) + _i * pstep + voff0), (LAS unsigned*)(lds + (bufoff) + 16384 + ldsw + _i * 1024), 16, 0, 0); } } while (0)
#define R4_READ(FA, FB, bufoff, half) do { _Pragma("unroll") for (int m = 0; m < 4; ++m) { FA[0][m] = *(const LAS bf16x8*)(lds + (bufoff) + a_base + m * 1024); FA[1][m] = *(const LAS bf16x8*)(lds + (bufoff) + a_base + 8192 + m * 1024); } \
        _Pragma("unroll") for (int bj = 0; bj < 2; ++bj) _Pragma("unroll") for (int n = 0; n < 2; ++n) FB[bj][n] = *(const LAS bf16x8*)(lds + (bufoff) + b_base + bj * 8192 + n * 1024); } while (0)
#define R4_MMA(FA, FB, half) do { __builtin_amdgcn_s_setprio(1); _Pragma("unroll") for (int ai = 0; ai < 2; ++ai) if (ai == 0 || !(half)) { _Pragma("unroll") for (int bj = 0; bj < 2; ++bj) _Pragma("unroll") for (int m = 0; m < 4; ++m) _Pragma("unroll") for (int n = 0; n < 2; ++n) \
        acc[ai][bj][m][n] = __builtin_amdgcn_mfma_f32_16x16x32_bf16(FB[bj][n], FA[ai][m], acc[ai][bj][m][n], 0, 0, 0); } __builtin_amdgcn_s_setprio(0); } while (0)
    Unit cur, pun; int ui = 0, pui = 0;
    if (!S.next(0, cur)) return;
    pun = cur;
    const char* pA = (const char*)(pun.sel ? g.A2 : g.A) + (size_t)pun.pm * tstep + (pun.hf == 2 ? hstep : 0); const char* pB = (const char*)(pun.sel ? g.Bt2 : g.Bt) + (size_t)pun.pn * tstep;
    int pk = 0; bool phalf = pun.hf != 0;
#define R4_ISSUE(bufoff) do { R4_STAGE(bufoff, pA + (size_t)pk * 64, pB + (size_t)pk * 64, phalf); if (++pk == ns) { pk = 0; Unit nx_; if (S.next(pui + 1, nx_)) { ++pui; pun = nx_; \
        pA = (const char*)(pun.sel ? g.A2 : g.A) + (size_t)pun.pm * tstep + (pun.hf == 2 ? hstep : 0); pB = (const char*)(pun.sel ? g.Bt2 : g.Bt) + (size_t)pun.pn * tstep; phalf = pun.hf != 0; } } } while (0)
    f32x4 acc[2][2][4][2];
#pragma unroll
    for (int a = 0; a < 2; ++a)
#pragma unroll
        for (int b = 0; b < 2; ++b)
#pragma unroll
            for (int m = 0; m < 4; ++m)
#pragma unroll
                for (int n = 0; n < 2; ++n) acc[a][b][m][n] = (f32x4){0.f, 0.f, 0.f, 0.f};
    bf16x8 FA[2][4], FB[2][2];
    R4_ISSUE(0); R4_ISSUE(32768); R4_ISSUE(65536);
    asm volatile("s_waitcnt vmcnt(8)" ::: "memory"); __builtin_amdgcn_s_barrier();
    if (wr == 1) __builtin_amdgcn_s_barrier();
    unsigned sb = 0;
    bool chalf = cur.hf != 0;
    for (;;) {
        for (int ks = 0; ks < ns; ++ks) {
            R4_READ(FA, FB, sb, chalf); __builtin_amdgcn_sched_barrier(0); R4_ISSUE((sb + 98304u) & 131071u); sb = (sb + 32768u) & 131071u;
            asm volatile("s_waitcnt vmcnt(8)" ::: "memory"); asm volatile("s_waitcnt lgkmcnt(0)" ::: "memory");
            __builtin_amdgcn_s_barrier(); __builtin_amdgcn_sched_barrier(0);
            R4_MMA(FA, FB, chalf);
            __builtin_amdgcn_s_barrier(); __builtin_amdgcn_sched_barrier(0);
        }
        if (wr == 0) __builtin_amdgcn_s_barrier();
        E(acc, cur, wr, wc, fr, fq);
        Unit nxt; if (!S.next(ui + 1, nxt)) break;
#pragma unroll
        for (int a = 0; a < 2; ++a)
#pragma unroll
            for (int b = 0; b < 2; ++b)
#pragma unroll
                for (int m = 0; m < 4; ++m)
#pragma unroll
                    for (int n = 0; n < 2; ++n) acc[a][b][m][n] = (f32x4){0.f, 0.f, 0.f, 0.f};
        cur = nxt; ++ui; chalf = cur.hf != 0;
        if (wr == 1) __builtin_amdgcn_s_barrier();
    }
    asm volatile("s_waitcnt vmcnt(0) lgkmcnt(0)" ::: "memory");
    __builtin_amdgcn_s_barrier();
#undef R4_STAGE
#undef R4_READ
#undef R4_MMA
#undef R4_ISSUE
}
}

#define XB_TMO      128
#define XB_XCNT(j)  (256  + 64 * (j))
#define XB_XSUB(j)  (1280 + 64 * (j))
#define XB_XGEN(j)  (2304 + 64 * (j))
#define XB_TOP      3328
#define XB_TOPGEN   3392
#define XCD_BAR_WORDS 3456
#define XB_SPIN_CAP (1u << 18)
__device__ __forceinline__ unsigned xb_ld(unsigned* p)              { return __hip_atomic_load(p, __ATOMIC_RELAXED, __HIP_MEMORY_SCOPE_AGENT); }
__device__ __forceinline__ unsigned xb_add(unsigned* p, unsigned v) { return __hip_atomic_fetch_add(p, v, __ATOMIC_RELAXED, __HIP_MEMORY_SCOPE_AGENT); }
__device__ __forceinline__ unsigned xb_xcc_id() { return (unsigned)__builtin_amdgcn_s_getreg((3 << 11) | 20) & 0xFu; }
#define XB_SPIN(cond, bar) do { unsigned _sp = 0; while (cond) { __builtin_amdgcn_s_sleep(1); \
    if ((++_sp & 255u) == 0u) { if (xb_ld(&(bar)[XB_TMO])) break; if (_sp > XB_SPIN_CAP) { atomicAdd(&(bar)[XB_TMO], 1u); break; } } } } while (0)
struct XcdBarrier { unsigned* bar; unsigned x; volatile LAS unsigned* st; };
__device__ __forceinline__ XcdBarrier xcd_barrier_post(unsigned* bar, volatile LAS unsigned* st) {
    XcdBarrier b; b.bar = bar; b.x = xb_xcc_id(); b.st = st;
    if (threadIdx.x == 0) (void)xb_add(&bar[XB_XCNT(b.x)], 1u);
    return b;
}
__device__ __forceinline__ void xcd_barrier_complete(unsigned* bar, unsigned x, unsigned& nloc, unsigned& nx) {
    const unsigned G = gridDim.x * gridDim.y * gridDim.z;
    unsigned sum, cnt, mine, sp = 0u;
    for (;;) {
        sum = 0u; cnt = 0u; mine = 0u;
#pragma unroll
        for (unsigned j = 0; j < 16; ++j) { const unsigned c = xb_ld(&bar[XB_XCNT(j)]); sum += c; cnt += (c > 0u) ? 1u : 0u; mine = (j == x) ? c : mine; }
        if (sum == G) break;
        __builtin_amdgcn_s_sleep(1);
        if ((++sp & 255u) == 0u) { if (xb_ld(&bar[XB_TMO])) break; if (sp > XB_SPIN_CAP) { atomicAdd(&bar[XB_TMO], 1u); break; } }
    }
    nloc = mine > 0u ? mine : 1u; nx = cnt > 0u ? cnt : 1u;
}
__device__ __forceinline__ void xcd_barrier(const XcdBarrier& b) {
    asm volatile("s_waitcnt vmcnt(0)" ::: "memory");
    __syncthreads();
    if (threadIdx.x == 0) {
        unsigned* bar = b.bar;
        __builtin_amdgcn_s_waitcnt(0);
        unsigned nloc = b.st[0], nx = b.st[1];
        if (nloc == 0u) { xcd_barrier_complete(bar, b.x, nloc, nx); b.st[0] = nloc; b.st[1] = nx; }
        const unsigned old = xb_add(&bar[XB_XSUB(b.x)], 1u);
        const unsigned gen = old / nloc;
        if (old + 1u == (gen + 1u) * nloc) {
            __builtin_amdgcn_fence(__ATOMIC_RELEASE, "agent");
            asm volatile("s_waitcnt vmcnt(0)" ::: "memory");
            const unsigned og = xb_add(&bar[XB_TOP], 1u);
            const unsigned tg = og / nx;
            if (og + 1u == (tg + 1u) * nx) xb_add(&bar[XB_TOPGEN], 1u);
            else XB_SPIN(xb_ld(&bar[XB_TOPGEN]) == tg, bar);
            __builtin_amdgcn_fence(__ATOMIC_ACQUIRE, "agent");
            xb_add(&bar[XB_XGEN(b.x)], 1u);
            asm volatile("s_waitcnt vmcnt(0)" ::: "memory");
        } else {
            XB_SPIN(xb_ld(&bar[XB_XGEN(b.x)]) == gen, bar);
            __builtin_amdgcn_fence(__ATOMIC_ACQUIRE, "agent");
            asm volatile("s_waitcnt vmcnt(0)" ::: "memory");
        }
    }
    __syncthreads();
}

constexpr int CW_GRP = 65536;
struct GrpBarrier { unsigned* cnt; unsigned* gen; unsigned* tmo; bool cheap; };
struct NoHook { __device__ __forceinline__ void operator()() const {} };
template <class Hook = NoHook>
__device__ __forceinline__ void grp_barrier(const GrpBarrier& b, unsigned want, const Hook& hook = Hook()) {
    asm volatile("s_waitcnt vmcnt(0)" ::: "memory");
    __syncthreads();
    unsigned old = 0;
    if (threadIdx.x == 0) {
        __builtin_amdgcn_s_waitcnt(0);
        if (!b.cheap) { __builtin_amdgcn_fence(__ATOMIC_RELEASE, "agent"); asm volatile("s_waitcnt vmcnt(0)" ::: "memory"); }
        old = xb_add(b.cnt, 1u);
    }
    hook();
    if (threadIdx.x == 0) {
        if (old + 1u == 32u * want) xb_add(b.gen, 1u);
        else XB_SPIN(xb_ld(b.gen) < want, b.tmo - XB_TMO);
        __builtin_amdgcn_fence(__ATOMIC_ACQUIRE, "agent");
        asm volatile("s_waitcnt vmcnt(0)" ::: "memory");
    }
    __syncthreads();
}

__device__ __forceinline__ unsigned pk2(float lo, float hi) { return f2bf(lo) | (f2bf(hi) << 16); }
__device__ __forceinline__ int perm32(int rho) { const int n = rho >> 4, i = rho & 15; return 8 * (i >> 2) + 4 * n + (i & 3); }
struct PrepItem { const float* src; const float* gn; bf16* dst; int ldw, K; };
__device__ __forceinline__ PrepItem prep_head(const float* W, int K, int N, const float* gn, bf16* WT, int it) {
    const int nsg = N / 32, kb = it / nsg, sg = it % nsg, pn = sg >> 3, bj = (sg >> 2) & 1, wc = sg & 3;
    PrepItem d; d.src = W + (size_t)(64 * kb) * N + 256 * pn + 64 * wc + 32 * bj; d.gn = gn ? gn + 64 * kb : nullptr; d.dst = WT + (size_t)(32 * sg) * K + 64 * kb; d.ldw = N; d.K = K; return d;
}
__device__ __forceinline__ PrepItem prep_gateup(const float* Wg, const float* Wu, const float* gn, bf16* WT, int it) {
    const int nsg = 2 * FF / 32, kb = it / nsg, sg = it % nsg, pn = sg >> 3, bj = (sg >> 2) & 1, wc = sg & 3;
    PrepItem d; d.src = (bj ? Wu : Wg) + (size_t)(64 * kb) * FF + 128 * pn + 32 * wc; d.gn = gn + 64 * kb; d.dst = WT + (size_t)(32 * sg) * DM + 64 * kb; d.ldw = FF; d.K = DM; return d;
}
__device__ __forceinline__ void prep_load(const PrepItem& d, f32x4 (&v)[8], int lane) {
#pragma unroll
    for (int i = 0; i < 8; ++i) v[i] = __builtin_nontemporal_load((const f32x4*)(d.src + (size_t)(8 * i + (lane >> 3)) * d.ldw + 4 * (lane & 7)));
}
__device__ __forceinline__ void prep_store(const PrepItem& d, const f32x4 (&v)[8], LAS float* scr, int lane) {
#pragma unroll
    for (int i = 0; i < 8; ++i)
#pragma unroll
        for (int j = 0; j < 4; ++j) scr[(8 * i + (lane >> 3)) * 33 + 4 * (lane & 7) + j] = v[i][j];
    const int c = lane & 7;
    f32x4 g0 = (f32x4){1.f, 1.f, 1.f, 1.f}, g1 = g0; if (d.gn) { g0 = *(const f32x4*)(d.gn + 8 * c); g1 = *(const f32x4*)(d.gn + 8 * c + 4); }
    asm volatile("s_waitcnt lgkmcnt(0)" ::: "memory");
#pragma unroll
    for (int j = 0; j < 4; ++j) { const int rr = (lane >> 3) + 8 * j; const LAS float* s = scr + (8 * c) * 33 + perm32(rr);
        u32x4 o; o.x = pk2(s[0 * 33] * g0[0], s[1 * 33] * g0[1]); o.y = pk2(s[2 * 33] * g0[2], s[3 * 33] * g0[3]); o.z = pk2(s[4 * 33] * g1[0], s[5 * 33] * g1[1]); o.w = pk2(s[6 * 33] * g1[2], s[7 * 33] * g1[3]);
        *(u32x4*)(d.dst + (size_t)rr * d.K + 8 * c) = o; }
    asm volatile("s_waitcnt lgkmcnt(0)" ::: "memory");
}
constexpr int I_1C = (DM / 64) * (2 * FF / 32), I_1D = (FF / 64) * (DM / 32), I_IN = (DM / 64) * (INW / 32), I_P = (512 / 64) * (DM / 32), I_O = (DM / 64) * (DM / 32);
constexpr int NITEMS = 2 * I_1C + 2 * I_1D + I_IN + 2 * I_P + I_O;
__device__ __forceinline__ PrepItem prep_get(const __attribute__((address_space(4))) Inputs& I, int l, unsigned char* WB, int r) {
    if (r < I_1C) return prep_gateup(I.ffn1_wg + (size_t)l * DM * FF, I.ffn1_wu + (size_t)l * DM * FF, I.ffn1_norm + l * DM, (bf16*)(WB + WO_1C), r); r -= I_1C;
    if (r < I_1C) return prep_gateup(I.ffn2_wg + (size_t)l * DM * FF, I.ffn2_wu + (size_t)l * DM * FF, I.ffn2_norm + l * DM, (bf16*)(WB + WO_2C), r); r -= I_1C;
    if (r < I_1D) return prep_head(I.ffn1_wd + (size_t)l * FF * DM, FF, DM, nullptr, (bf16*)(WB + WO_1D), r); r -= I_1D;
    if (r < I_1D) return prep_head(I.ffn2_wd + (size_t)l * FF * DM, FF, DM, nullptr, (bf16*)(WB + WO_2D), r); r -= I_1D;
    if (r < I_IN) return prep_head(I.w_in + (size_t)l * DM * INW, DM, INW, I.mix_norm + l * DM, (bf16*)(WB + WO_IN), r); r -= I_IN;
    if (r < I_P) return prep_head(I.w_br_na + (size_t)l * 512 * DM, 512, DM, nullptr, (bf16*)(WB + WO_PA), r); r -= I_P;
    if (r < I_P) return prep_head(I.w_br_sw + (size_t)l * 512 * DM, 512, DM, nullptr, (bf16*)(WB + WO_PB), r); r -= I_P;
    return prep_head(I.w_out + (size_t)l * DM * DM, DM, DM, nullptr, (bf16*)(WB + WO_OUT), r);
}
__device__ __forceinline__ float wave_sum64(float v) {
#pragma unroll
    for (int o = 1; o < 64; o <<= 1) v += __shfl_xor(v, o);
    return v;
}

__device__ __forceinline__ bf16x8 tr_pair(const LAS unsigned char* p0, const LAS unsigned char* p1) {
    typedef short v4i16 __attribute__((ext_vector_type(4)));
    const v4i16 lo = __builtin_amdgcn_ds_read_tr16_b64_v4i16((LAS v4i16*)p0), hi = __builtin_amdgcn_ds_read_tr16_b64_v4i16((LAS v4i16*)p1);
    return (bf16x8){lo[0], lo[1], lo[2], lo[3], hi[0], hi[1], hi[2], hi[3]};
}
__device__ __forceinline__ int fK(int key) { return ((key >> 1) & 1) | (((key >> 3) & 3) << 1); }
__device__ __forceinline__ int fV(int key) { return ((key >> 1) & 1) | (((key >> 3) & 1) << 1); }

template <int NS> __device__ __forceinline__ float softmax_pack(f32x4 (&S)[NS][2], bf16x8 (&pk)[NS], bool has_sink, float sink) {
    float mx = has_sink ? sink : -3.0e38f;
#pragma unroll
    for (int s = 0; s < NS; ++s)
#pragma unroll
        for (int hb = 0; hb < 2; ++hb) mx = fmaxf(mx, fmaxf(fmaxf(S[s][hb][0], S[s][hb][1]), fmaxf(S[s][hb][2], S[s][hb][3])));
    mx = fmaxf(mx, __shfl_xor(mx, 16)); mx = fmaxf(mx, __shfl_xor(mx, 32));
    const float mb = mx * 1.4426950408889634f; float l = 0.f;
#pragma unroll
    for (int s = 0; s < NS; ++s) {
#pragma unroll
        for (int hb = 0; hb < 2; ++hb)
#pragma unroll
            for (int j = 0; j < 4; ++j) { const float e = __builtin_amdgcn_exp2f(S[s][hb][j] * 1.4426950408889634f - mb); S[s][hb][j] = e; l += e; }
        u32x4 w; w.x = cvt_pk_bf16(S[s][0][0], S[s][0][1]); w.y = cvt_pk_bf16(S[s][0][2], S[s][0][3]); w.z = cvt_pk_bf16(S[s][1][0], S[s][1][1]); w.w = cvt_pk_bf16(S[s][1][2], S[s][1][3]);
        pk[s] = __builtin_bit_cast(bf16x8, w);
    }
    l += __shfl_xor(l, 16); l += __shfl_xor(l, 32);
    if (has_sink) l += __builtin_amdgcn_exp2f(sink * 1.4426950408889634f - mb);
    return 1.f / l;
}

constexpr int SW_K_OFF = 0, SW_V_OFF = 49152, SW_LUT_OFF = 98304, SW_LUT_LD = 512;
__device__ __forceinline__ void swa_unit(LAS unsigned char* lds, int b, int g, int nb, const bf16* QKV, const float* t5, const float* sink, bf16* OSW) {
    int tid_ = threadIdx.x; asm volatile("" : "+v"(tid_));
    const int tid = tid_, lane = tid & 63, wid = __builtin_amdgcn_readfirstlane(tid >> 6), fr = lane & 15, fq = lane >> 4;
#pragma unroll
    for (int i = 0; i < 6; ++i) { const int cid = tid + NTHREADS * i, key = cid >> 3, c = cid & 7, kp = 128 * (nb - 1) + key; const bool ok = kp >= 0 && kp < SEQ;
        const bf16* src = QKV + (size_t)(b * SEQ + (ok ? kp : 0)) * NQKV + 64 * g + 8 * c;
        u32x4 kv = (u32x4){0u, 0u, 0u, 0u}, vv = kv; if (ok) { kv = *(const u32x4*)(src + 2048); vv = *(const u32x4*)(src + 2176); }
        *(LAS u32x4*)(lds + SW_K_OFF + key * 128 + ((c ^ fK(key)) << 4)) = kv;
        *(LAS u32x4*)(lds + SW_V_OFF + key * 128 + (((c >> 1) ^ fV(key)) << 5) + ((c & 1) << 4)) = vv; }
    for (int idx = tid; idx < 5 * 512; idx += NTHREADS) { const int hh = idx >> 9, rel = (idx & 511) - 255;
        ((LAS float*)(lds + SW_LUT_OFF))[idx] = (hh < 4 && rel >= -128 && rel <= 128) ? t5[slow::t5_bucket(rel) * 8 + 4 * g + hh] : NEGV; }
    __syncthreads();
    const int fKl = ((fr >> 1) & 1) | ((fr >> 2) << 1);
    const LAS unsigned char* kb0 = lds + SW_K_OFF + (8 * (fr >> 2) + (fr & 3)) * 128 + ((fq ^ fKl) << 4);
    const LAS unsigned char* kb1 = lds + SW_K_OFF + (8 * (fr >> 2) + (fr & 3)) * 128 + (((4 + fq) ^ fKl) << 4);
    const int q4 = (lane & 15) >> 2, p4 = lane & 3, fVl = ((q4 >> 1) & 1) | ((fq & 1) << 1);
    const LAS unsigned char* vb = lds + SW_V_OFF + (8 * fq + q4) * 128 + p4 * 8;
    const int relbase = 8 * fq - 128 - 16 * wid - fr + 255;
    const bool first_bad = (nb == 0), last_bad = (nb == SEQ / 128 - 1);
    const size_t tokq = (size_t)b * SEQ + 128 * nb + 16 * wid + fr; const int s0 = wid >> 1;
    for (int hh = 0; hh < 4; ++hh) {
        const int h = 4 * g + hh;
        const bf16x8 q0 = *(const bf16x8*)(QKV + tokq * NQKV + 1536 + 64 * h + 8 * fq), q1 = *(const bf16x8*)(QKV + tokq * NQKV + 1536 + 64 * h + 32 + 8 * fq);
        const LAS float* lut = (const LAS float*)(lds + SW_LUT_OFF) + hh * SW_LUT_LD + relbase;
        f32x4 S[9][2]; bf16x8 pk[9];
        const LAS unsigned char* kb0s = kb0 + s0 * 4096; const LAS unsigned char* kb1s = kb1 + s0 * 4096; const LAS float* luts = lut + 32 * s0;
#pragma unroll
        for (int s = 0; s < 9; ++s) {
            const bool bad = (s0 + s < 4 && first_bad) || (s0 + s >= 8 && last_bad);
            const LAS float* lp = luts + 32 * s + (bad ? (4 - hh) * SW_LUT_LD : 0);
#pragma unroll
            for (int hb = 0; hb < 2; ++hb) { const bf16x8 k0 = *(const LAS bf16x8*)(kb0s + s * 4096 + hb * 512), k1 = *(const LAS bf16x8*)(kb1s + s * 4096 + hb * 512);
                f32x4 a = (f32x4){lp[4 * hb], lp[4 * hb + 1], lp[4 * hb + 2], lp[4 * hb + 3]};
                a = __builtin_amdgcn_mfma_f32_16x16x32_bf16(k0, q0, a, 0, 0, 0); a = __builtin_amdgcn_mfma_f32_16x16x32_bf16(k1, q1, a, 0, 0, 0);
                S[s][hb] = a; }
            if ((s & 3) == 3) asm volatile("" ::: "memory"); }
        const float rl = softmax_pack<9>(S, pk, true, sink[h]);
        f32x4 O[4];
#pragma unroll
        for (int db = 0; db < 4; ++db) O[db] = (f32x4){0.f, 0.f, 0.f, 0.f};
        const LAS unsigned char* vbs = vb + s0 * 4096;
#pragma unroll
        for (int s = 0; s < 9; ++s) {
#pragma unroll
            for (int db = 0; db < 4; ++db) { const LAS unsigned char* p = vbs + s * 4096 + ((db ^ fVl) << 5); O[db] = __builtin_amdgcn_mfma_f32_16x16x32_bf16(tr_pair(p, p + 512), pk[s], O[db], 0, 0, 0); }
            if ((s & 3) == 3) asm volatile("" ::: "memory"); }
        bf16* dst = OSW + tokq * 512 + 64 * h + 4 * fq;
#pragma unroll
        for (int db = 0; db < 4; ++db) { u32x2 w; w.x = cvt_pk_bf16(O[db][0] * rl, O[db][1] * rl); w.y = cvt_pk_bf16(O[db][2] * rl, O[db][3] * rl); *(u32x2*)(dst + 16 * db) = w; }
    }
    __syncthreads();
}

constexpr int NA_V_OFF = 0, NA_TAB_OFF = 122880;
__device__ __forceinline__ int na_rowstart(int r) { int rs = r - 4; return rs < 0 ? 0 : (rs > ROWS - 8 ? ROWS - 8 : rs); }
__device__ __forceinline__ void na_unit(LAS unsigned char* lds, int b, int h, int rq, const bf16* QKV, const float* rpb, bf16* ONA) {
    int tid_ = threadIdx.x; asm volatile("" : "+v"(tid_));
    const int tid = tid_, lane = tid & 63, wid = __builtin_amdgcn_readfirstlane(tid >> 6), fr = lane & 15, fq = lane >> 4;
    const int kr_lo = na_rowstart(8 * rq), kr_hi = na_rowstart(8 * rq + 7) + 7;
    {
        const int nrows = kr_hi - kr_lo + 1, kloc = tid >> 3, c = tid & 7;
        const bf16* src = QKV + (size_t)(b * SEQ + kr_lo * GRID_W + kloc) * NQKV + 1024 + 64 * h + 8 * c;
        LAS unsigned char* dstp = lds + NA_V_OFF + kloc * 128 + (((c >> 1) ^ fV(kloc)) << 5) + ((c & 1) << 4);
        u32x4 vv[15];
#pragma unroll
        for (int r = 0; r < 15; ++r) if (r < nrows) vv[r] = *(const u32x4*)(src + (size_t)r * GRID_W * NQKV);
#pragma unroll
        for (int r = 0; r < 15; ++r) if (r < nrows) *(LAS u32x4*)(dstp + r * (GRID_W * 128)) = vv[r];
    }
    for (int idx = tid; idx < 15 * 32; idx += NTHREADS) { const int rr_ = idx >> 5, cc_ = idx & 31; ((LAS float*)(lds + NA_TAB_OFF))[idx] = cc_ < 31 ? rpb[h * 465 + rr_ * 31 + cc_] : NEGV; }
    __syncthreads();
    const LAS float* tab = (const LAS float*)(lds + NA_TAB_OFF);
    const int q4 = (lane & 15) >> 2, p4 = lane & 3;
    bf16x8 kf[8][2][2], q0, q1;
#define NA_LOADKQ(pp, slo, shi) do { const int r_ = 8 * rq + ((pp) >> 2), cb_ = (pp) & 3, rs_ = na_rowstart(r_); int kcs_ = 16 * cb_ - 8; kcs_ = kcs_ < 0 ? 0 : (kcs_ > 32 ? 32 : kcs_); \
        const size_t tq_ = (size_t)b * SEQ + r_ * GRID_W + 16 * cb_ + fr; \
        if ((slo) == 0) { q0 = *(const bf16x8*)(QKV + tq_ * NQKV + 64 * h + 8 * fq); q1 = *(const bf16x8*)(QKV + tq_ * NQKV + 64 * h + 32 + 8 * fq); } \
        const bf16* kb_ = QKV + ((size_t)b * SEQ + rs_ * GRID_W + kcs_ + 8 * (fr >> 2) + (fr & 3)) * NQKV + 512 + 64 * h + 8 * fq;     \
        _Pragma("unroll") for (int s_ = (slo); s_ < (shi); ++s_) _Pragma("unroll") for (int hb_ = 0; hb_ < 2; ++hb_) { const bf16* kp_ = kb_ + (size_t)(s_ * GRID_W + 4 * hb_) * NQKV; kf[s_][hb_][0] = *(const bf16x8*)kp_; kf[s_][hb_][1] = *(const bf16x8*)(kp_ + 32); } } while (0)
    for (int i = 0; i < 4; ++i) {
        const int p = wid + 8 * i, r = 8 * rq + (p >> 2), cb = p & 3, rs = na_rowstart(r);
        int kcs = 16 * cb - 8; kcs = kcs < 0 ? 0 : (kcs > 32 ? 32 : kcs);
        const int qcol = 16 * cb + fr; int qcs = qcol - 8; qcs = qcs < 0 ? 0 : (qcs > 48 ? 48 : qcs);
        const size_t tokq = (size_t)b * SEQ + r * GRID_W + qcol;
        f32x4 S[8][2]; bf16x8 pk[8];
        int cidx[2][4];
#pragma unroll
        for (int hb = 0; hb < 2; ++hb)
#pragma unroll
            for (int j = 0; j < 4; ++j) { const int kcol = kcs + 8 * fq + 4 * hb + j; const bool ok = kcol >= qcs && kcol < qcs + 16; cidx[hb][j] = ok ? kcol - qcol + 15 : 31; }
        const LAS float* trow = tab + (rs - r + 7) * 32;
        NA_LOADKQ(p, 0, 8); __builtin_amdgcn_sched_barrier(0);
#pragma unroll
        for (int s = 0; s < 8; ++s) {
#pragma unroll
            for (int hb = 0; hb < 2; ++hb) {
                f32x4 a = (f32x4){0.f, 0.f, 0.f, 0.f}; a = __builtin_amdgcn_mfma_f32_16x16x32_bf16(kf[s][hb][0], q0, a, 0, 0, 0); a = __builtin_amdgcn_mfma_f32_16x16x32_bf16(kf[s][hb][1], q1, a, 0, 0, 0);
#pragma unroll
                for (int j = 0; j < 4; ++j) a[j] += trow[s * 32 + cidx[hb][j]];
                S[s][hb] = a; }
            if ((s & 3) == 3) asm volatile("" ::: "memory"); }
        const float rl = softmax_pack<8>(S, pk, false, 0.f);
        const int fVl = ((q4 >> 1) & 1) | ((((kcs >> 3) + fq) & 1) << 1);
        const LAS unsigned char* vb = lds + NA_V_OFF + ((rs - kr_lo) * GRID_W + kcs + 8 * fq + q4) * 128 + p4 * 8;
        f32x4 O[4];
#pragma unroll
        for (int db = 0; db < 4; ++db) O[db] = (f32x4){0.f, 0.f, 0.f, 0.f};
#pragma unroll
        for (int s = 0; s < 8; ++s) {
#pragma unroll
            for (int db = 0; db < 4; ++db) { const LAS unsigned char* pp = vb + s * (GRID_W * 128) + ((db ^ fVl) << 5); O[db] = __builtin_amdgcn_mfma_f32_16x16x32_bf16(tr_pair(pp, pp + 512), pk[s], O[db], 0, 0, 0); }
            if ((s & 3) == 3) asm volatile("" ::: "memory"); }
        bf16* dst = ONA + tokq * 512 + 64 * h + 4 * fq;
#pragma unroll
        for (int db = 0; db < 4; ++db) { u32x2 w; w.x = cvt_pk_bf16(O[db][0] * rl, O[db][1] * rl); w.y = cvt_pk_bf16(O[db][2] * rl, O[db][3] * rl); *(u32x2*)(dst + 16 * db) = w; }
    }
    __syncthreads();
}

constexpr int NA2_K_OFF = 0, NA2_V_OFF = 61440, NA2_TAB_OFF = 122880;
__device__ __forceinline__ void na_quad(LAS unsigned char* lds, int b, int h, int cb, const bf16* QKV, const float* rpb, bf16* ONA) {
    int tid_ = threadIdx.x; asm volatile("" : "+v"(tid_));
    const int tid = tid_, lane = tid & 63, wid = __builtin_amdgcn_readfirstlane(tid >> 6), fr = lane & 15, fq = lane >> 4;
    int kcs = 16 * cb - 8; kcs = kcs < 0 ? 0 : (kcs > 32 ? 32 : kcs);
    const int isv = tid >> 8, t8 = tid & 255, kc = t8 >> 3, c = t8 & 7;
    const bf16* src0 = QKV + (size_t)(b * SEQ + kcs + kc) * NQKV + (isv ? 1024 : 512) + 64 * h + 8 * c;
    LAS unsigned char* dstp = isv ? lds + NA2_V_OFF + kc * 128 + (((c >> 1) ^ fV(kc)) << 5) + ((c & 1) << 4) : lds + NA2_K_OFF + kc * 128 + ((c ^ fK(kc)) << 4);
    u32x4 vv[15];
#define NA2_LOAD(rq_) do { const int lo_ = na_rowstart(8 * (rq_)), n_ = na_rowstart(8 * (rq_) + 7) + 8 - lo_; \
        _Pragma("unroll") for (int r_ = 0; r_ < 15; ++r_) if (r_ < n_) vv[r_] = *(const u32x4*)(src0 + (size_t)(lo_ + r_) * GRID_W * NQKV); } while (0)
    NA2_LOAD(0);
    for (int idx = tid; idx < 15 * 32; idx += NTHREADS) { const int rr_ = idx >> 5, cc_ = idx & 31; ((LAS float*)(lds + NA2_TAB_OFF))[idx] = cc_ < 31 ? rpb[h * 465 + rr_ * 31 + cc_] : NEGV; }
    const LAS float* tab = (const LAS float*)(lds + NA2_TAB_OFF);
    const int qcol = 16 * cb + fr; int qcs = qcol - 8; qcs = qcs < 0 ? 0 : (qcs > 48 ? 48 : qcs);
    const int fKl = ((fr >> 1) & 1) | ((fr >> 2) << 1);
    const int q4 = (lane & 15) >> 2, p4 = lane & 3, fVl = ((q4 >> 1) & 1) | ((fq & 1) << 1);
    int cidx[2][4];
#pragma unroll
    for (int hb = 0; hb < 2; ++hb)
#pragma unroll
        for (int j = 0; j < 4; ++j) { const int kcol = kcs + 8 * fq + 4 * hb + j; const bool ok = kcol >= qcs && kcol < qcs + 16; cidx[hb][j] = ok ? kcol - qcol + 15 : 31; }
    for (int rq = 0; rq < 4; ++rq) {
        const int kr_lo = na_rowstart(8 * rq), nrows = na_rowstart(8 * rq + 7) + 8 - kr_lo;
#pragma unroll
        for (int r_ = 0; r_ < 15; ++r_) if (r_ < nrows) *(LAS u32x4*)(dstp + r_ * 4096) = vv[r_];
        __syncthreads();
        const int r = 8 * rq + wid, rs = na_rowstart(r), ro = rs - kr_lo;
        const size_t tokq = (size_t)b * SEQ + r * GRID_W + qcol;
        const bf16x8 q0 = *(const bf16x8*)(QKV + tokq * NQKV + 64 * h + 8 * fq), q1 = *(const bf16x8*)(QKV + tokq * NQKV + 64 * h + 32 + 8 * fq);
        __builtin_amdgcn_sched_barrier(0);
        if (rq < 3) NA2_LOAD(rq + 1);
        const LAS unsigned char* kb0 = lds + NA2_K_OFF + ro * 4096 + (8 * (fr >> 2) + (fr & 3)) * 128 + ((fq ^ fKl) << 4);
        const LAS unsigned char* kb1 = lds + NA2_K_OFF + ro * 4096 + (8 * (fr >> 2) + (fr & 3)) * 128 + (((4 + fq) ^ fKl) << 4);
        const LAS unsigned char* vb = lds + NA2_V_OFF + ro * 4096 + (8 * fq + q4) * 128 + p4 * 8;
        const LAS float* trow = tab + (rs - r + 7) * 32;
        f32x4 S[8][2]; bf16x8 pk[8];
#pragma unroll
        for (int s = 0; s < 8; ++s) {
#pragma unroll
            for (int hb = 0; hb < 2; ++hb) { const bf16x8 k0 = *(const LAS bf16x8*)(kb0 + s * 4096 + hb * 512), k1 = *(const LAS bf16x8*)(kb1 + s * 4096 + hb * 512);
                f32x4 a = (f32x4){trow[s * 32 + cidx[hb][0]], trow[s * 32 + cidx[hb][1]], trow[s * 32 + cidx[hb][2]], trow[s * 32 + cidx[hb][3]]};
                a = __builtin_amdgcn_mfma_f32_16x16x32_bf16(k0, q0, a, 0, 0, 0); a = __builtin_amdgcn_mfma_f32_16x16x32_bf16(k1, q1, a, 0, 0, 0);
                S[s][hb] = a; }
            if ((s & 3) == 3) asm volatile("" ::: "memory"); }
        const float rl = softmax_pack<8>(S, pk, false, 0.f);
        f32x4 O[4];
#pragma unroll
        for (int db = 0; db < 4; ++db) O[db] = (f32x4){0.f, 0.f, 0.f, 0.f};
#pragma unroll
        for (int s = 0; s < 8; ++s) {
#pragma unroll
            for (int db = 0; db < 4; ++db) { const LAS unsigned char* pp = vb + s * 4096 + ((db ^ fVl) << 5); O[db] = __builtin_amdgcn_mfma_f32_16x16x32_bf16(tr_pair(pp, pp + 512), pk[s], O[db], 0, 0, 0); }
            if ((s & 3) == 3) asm volatile("" ::: "memory"); }
        bf16* dst = ONA + tokq * 512 + 64 * h + 4 * fq;
#pragma unroll
        for (int db = 0; db < 4; ++db) { u32x2 w; w.x = cvt_pk_bf16(O[db][0] * rl, O[db][1] * rl); w.y = cvt_pk_bf16(O[db][2] * rl, O[db][3] * rl); *(u32x2*)(dst + 16 * db) = w; }
        __syncthreads();
    }
#undef NA2_LOAD
}

#ifndef PG8_SP2
#define PG8_SP2 true
#endif
#ifndef PG8_ALIGN
#define PG8_ALIGN true
#endif
constexpr int N_PHASES = 9 * DEPTH;
struct PhaseBar { XcdBarrier xb; GrpBarrier gb; unsigned want; int mode;
    __device__ __forceinline__ void operator()() const { if (mode == 1) xcd_barrier(xb); else if (mode == 2) grp_barrier(gb, want); }
    template <class Hook> __device__ __forceinline__ void run(const Hook& h) const { if (mode == 2) grp_barrier(gb, want, h); else { h(); if (mode == 1) xcd_barrier(xb); } } };
struct Args { Inputs I; float* out; unsigned char* ws; int ph_lo, ph_hi, bar_region, pad; };

__global__ void __launch_bounds__(NTHREADS, 2) mega_fwd(Args args) {
    extern __shared__ __attribute__((aligned(16))) unsigned char lds_raw[];
    LAS unsigned char* lds = (LAS unsigned char*)lds_raw;
    volatile LAS unsigned* MISC = (volatile LAS unsigned*)(lds + MISC_OFF);
    const int tid = threadIdx.x, lane = tid & 63, wave = __builtin_amdgcn_readfirstlane(tid >> 6);
    const int G = gridDim.x, bx = blockIdx.x, vcu = (G % 8 == 0) ? (bx % 8) * (G / 8) + bx / 8 : bx;
    unsigned char* ws0 = args.ws;
    for (int u = tid; u < (LDS_BYTES - RING_BYTES) / 4; u += NTHREADS) ((LAS unsigned*)(lds + RING_BYTES))[u] = 0u;
    __syncthreads();
    const int lo = args.ph_lo, hi = args.ph_hi;
    XcdBarrier bar; bar.bar = (unsigned*)(ws0 + WS_CTL) + 4096 + args.bar_region * XCD_BAR_WORDS; bar.x = 0; bar.st = nullptr;
    if (hi - lo > 1) bar = xcd_barrier_post(bar.bar, MISC + 8);
    const bool use_groups0 = GROUPS && (G == 256) && lo == 0 && hi == N_PHASES;
    const int grp = bx & 7;
    GrpBarrier gbar; { unsigned* gw_ = (unsigned*)(ws0 + WS_CTL) + CW_GRP; gbar.cnt = gw_ + 512 + 64 * grp; gbar.gen = gw_ + 1024 + 64 * grp; gbar.tmo = bar.bar + XB_TMO; gbar.cheap = false;
        if (use_groups0 && tid == 0) atomicOr(gw_ + 64 * grp, 1u << (xb_xcc_id() & 15u)); }

    unsigned t_first = 0, t_prev = 0, t_sel = 0;
    if (PROBE_MASK || PROBE3 || PROBE4 || PROBE2_PHASE >= 0) t_first = t_prev = (unsigned)__builtin_amdgcn_s_memrealtime();
    for (int ph = lo; ph < hi; ++ph) {
        const int l = ph / 9, k = ph % 9;
        typedef const __attribute__((address_space(4))) Args* kargp; kargp ap = (kargp)__builtin_amdgcn_kernarg_segment_ptr(); asm volatile("" : "+s"(ap));
        const __attribute__((address_space(4))) Inputs& I = ap->I; unsigned char* ws = ap->ws; float* out = ap->out;
        int bxl = bx; asm volatile("" : "+s"(bxl));
        const bool use_groups = GROUPS && (G == 256) && ap->ph_lo == 0 && ap->ph_hi == N_PHASES;
        float* SS = (float*)(ws + WS_SS);
        bf16 *XB = (bf16*)(ws + WS_XB), *H, *QKV, *T, *MRG, *GT, *ONA, *OSW;
        if (use_groups) {
            unsigned char* sl = ws + WS_H + (size_t)grp * (21 * MiB); const size_t r0 = (size_t)grp * SEQ;
            QKV = (bf16*)sl - r0 * NQKV; GT = (bf16*)(sl + 9 * MiB) - r0 * NG; ONA = (bf16*)(sl + 17 * MiB) - r0 * 512; OSW = (bf16*)(sl + 19 * MiB) - r0 * 512;
            T = (bf16*)sl - r0 * DM; MRG = (bf16*)(sl + 4 * MiB) - r0 * DM; H = (bf16*)sl - r0 * FF;
        } else { H = (bf16*)(ws + WS_H); QKV = (bf16*)(ws + WS_QKV); T = (bf16*)(ws + WS_T); MRG = (bf16*)(ws + WS_MRG); GT = (bf16*)(ws + WS_G); ONA = (bf16*)(ws + WS_ONA); OSW = (bf16*)(ws + WS_OSW); }
        unsigned char* WB = ws + WS_W;
        unsigned p5c = 0, p5r = 0; if (PROBE5 >= 0 && ph == PROBE5) { p5c = (unsigned)__builtin_amdgcn_s_memtime(); p5r = (unsigned)__builtin_amdgcn_s_memrealtime(); }
        if (PROBE2_PHASE >= 0) { if (tid == 0) MISC[19] = (ph == PROBE2_PHASE) ? 1u : 0u; __syncthreads(); }
        float* ss0 = SS + (size_t)(3 * l + 0) * M; float* ss1 = SS + (size_t)(3 * l + 1) * M; float* ss2 = SS + (size_t)(3 * l + 2) * M; float* ss3 = SS + (size_t)(3 * l + 3) * M;
        if (k == 0 && (CODE_MASK & 1)) {
            int lane_ = tid & 63; asm volatile("" : "+v"(lane_)); const int lane = lane_;
            LAS float* scr = (LAS float*)(lds + wave * 16384);
            const int gw = vcu * NWAVES + wave, NGW = G * NWAVES;
#define PREP_GET(it_) prep_get(I, l, WB, it_)
            {   f32x4 va[8], vb[8];
                int it = gw;
                for (; it + NGW < NITEMS; it += 2 * NGW) { const PrepItem da = PREP_GET(it), db = PREP_GET(it + NGW); prep_load(da, va, lane); prep_load(db, vb, lane); prep_store(da, va, scr, lane); prep_store(db, vb, scr, lane); }
                if (it < NITEMS) { const PrepItem da = PREP_GET(it); prep_load(da, va, lane); prep_store(da, va, scr, lane); }
            }
#undef PREP_GET
            if (l == 0) {
                for (int m = gw; m < M; m += 2 * NGW) { const int m2 = m + NGW;
                    const f32x4* xr = (const f32x4*)(I.x + (size_t)m * DM) + lane; const f32x4* xr2 = (const f32x4*)(I.x + (size_t)m2 * DM) + lane; f32x4 v[4], v2[4];
#pragma unroll
                    for (int j = 0; j < 4; ++j) { v[j] = xr[64 * j]; v2[j] = xr2[64 * j]; }
                    float s = 0.f, s2 = 0.f; u32x2* o8 = (u32x2*)(XB + (size_t)m * DM) + lane; u32x2* o82 = (u32x2*)(XB + (size_t)m2 * DM) + lane;
#pragma unroll
                    for (int j = 0; j < 4; ++j) { s += (v[j][0] * v[j][0] + v[j][1] * v[j][1]) + (v[j][2] * v[j][2] + v[j][3] * v[j][3]); u32x2 w; w.x = pk2(v[j][0], v[j][1]); w.y = pk2(v[j][2], v[j][3]); o8[64 * j] = w;
                        s2 += (v2[j][0] * v2[j][0] + v2[j][1] * v2[j][1]) + (v2[j][2] * v2[j][2] + v2[j][3] * v2[j][3]); u32x2 w2; w2.x = pk2(v2[j][0], v2[j][1]); w2.y = pk2(v2[j][2], v2[j][3]); o82[64 * j] = w2; }
                    s = wave_sum64(s); s2 = wave_sum64(s2); if (lane == 0) { ss0[m] = s; ss0[m2] = s2; } }
            }
            __syncthreads();
        } else if ((k == 1 || k == 7) && (CODE_MASK & 2)) {
            pg8::Gemm g{XB, (const bf16*)(WB + (k == 1 ? WO_1C : WO_2C)), M, 2 * FF, DM, nullptr, nullptr}; pg8::StaticOrder S; S.init(M, 2 * FF, G, bxl, WGM_P1);
            pg8::EpiFfnUp E{H, k == 1 ? ss0 : ss2};
            if (RING4) pg8::gemm_ring4<pg8::EpiFfnUp, pg8::StaticOrder>(lds, g, S, E); else pg8::gemm_phase<pg8::EpiFfnUp, PG8_ALIGN, PG8_SP2>(lds, g, S, E);
        } else if ((k == 2 || k == 8) && (CODE_MASK & 4)) {
            pg8::Gemm g{H, (const bf16*)(WB + (k == 2 ? WO_1D : WO_2D)), M, DM, FF, nullptr, nullptr}; pg8::StaticOrder S; S.init(M, DM, G, bxl);
            const bool fin = (k == 8 && l == DEPTH - 1);
            const PhaseBar pb{bar, gbar, (unsigned)(7 * ((ph - 1) / 9) + (ph - 1) % 9), ph > lo ? (use_groups ? 2 : 1) : 0};
            if (k == 2 && l == 0) { pg8::EpiResidT<true> E{I.x, nullptr, XB, ss1, 0.5f}; pg8::gemm_phase<pg8::EpiResidT<true>, false, PG8_SP2, pg8::StaticOrder, PhaseBar>(lds, g, S, E, pb); }
            else { pg8::EpiResidT<false> E{nullptr, fin ? out : nullptr, XB, fin ? nullptr : (k == 2 ? ss1 : ss3), 0.5f}; pg8::gemm_phase<pg8::EpiResidT<false>, false, PG8_SP2, pg8::StaticOrder, PhaseBar>(lds, g, S, E, pb); }
        } else if (k == 3 && (CODE_MASK & 8)) {
            LAS float* wtab = (LAS float*)(lds + RING_BYTES + 1024);
            int tl_ = tid; asm volatile("" : "+v"(tl_));
            for (int idx = tl_; idx < NG; idx += NTHREADS) wtab[idx] = I.b_gate[l * NG + idx];
            if (tl_ < 256) { const int t = tl_ >> 6, d = tl_ & 63; wtab[2048 + tl_] = (t == 0 ? I.na_q_norm : t == 1 ? I.na_k_norm : t == 2 ? I.sw_q_norm : I.sw_k_norm)[l * 64 + d]; }
            __syncthreads();
            pg8::Gemm g{XB, (const bf16*)(WB + WO_IN), M, INW, DM, nullptr, nullptr}; pg8::StaticOrder S; S.init(M, INW, G, bxl, WGM_P3);
            pg8::EpiWin E{QKV, GT, ss1, wtab};
            if (RING4) pg8::gemm_ring4<pg8::EpiWin, pg8::StaticOrder>(lds, g, S, E); else pg8::gemm_phase<pg8::EpiWin, PG8_ALIGN, PG8_SP2>(lds, g, S, E);
        } else if (k == 4 && (CODE_MASK & 48)) {
            unsigned a_t0 = 0, a_t1 = 0; if (PROBE3) a_t0 = (unsigned)__builtin_amdgcn_s_memrealtime();
            if (CODE_MASK & 16) {
                if (NA_V2) { for (int u4 = 4 * vcu; u4 < 1024; u4 += 4 * G) na_quad(lds, u4 >> 7, (u4 >> 4) & 7, (u4 >> 2) & 3, QKV, I.na_rpb + (size_t)l * 8 * 465, ONA); }
                else for (int u = vcu; u < 256; u += G) na_unit(lds, u >> 5, (u >> 2) & 7, u & 3, QKV, I.na_rpb + (size_t)l * 8 * 465, ONA);
            }
            if (PROBE3) a_t1 = (unsigned)__builtin_amdgcn_s_memrealtime();
            if (CODE_MASK & 32) for (int u = vcu; u < 256; u += G) swa_unit(lds, u >> 5, (u >> 4) & 1, u & 15, QKV, I.t5, I.sw_sink + l * 8, OSW);
            if (PROBE3) { const unsigned a_t2 = (unsigned)__builtin_amdgcn_s_memrealtime(); if (tid == 0) { MISC[24] += a_t1 - a_t0; MISC[25] += a_t2 - a_t1; } }
        } else if (k == 5 && (CODE_MASK & 64)) {
            pg8::DualOrder S; S.S.init(M, DM, G, bxl);
            pg8::Gemm g{ONA, (const bf16*)(WB + WO_PA), M, DM, 512, OSW, (const bf16*)(WB + WO_PB)}; pg8::EpiBranch E{MRG, GT};
            pg8::gemm_phase<pg8::EpiBranch, false, PG8_SP2, pg8::DualOrder>(lds, g, S, E);
        } else if (k == 6 && (CODE_MASK & 128)) {
            pg8::Gemm g{MRG, (const bf16*)(WB + WO_OUT), M, DM, DM, nullptr, nullptr}; pg8::StaticOrder S; S.init(M, DM, G, bxl);
            pg8::EpiResidT<false> E{nullptr, nullptr, XB, ss2, 1.0f};
            const PhaseBar pb{bar, gbar, (unsigned)(7 * ((ph - 1) / 9) + (ph - 1) % 9), ph > lo ? (use_groups ? 2 : 1) : 0};
            pg8::gemm_phase<pg8::EpiResidT<false>, false, PG8_SP2, pg8::StaticOrder, PhaseBar>(lds, g, S, E, pb);
        }
        if (PROBE5 >= 0 && ph == PROBE5) { const unsigned c1 = (unsigned)__builtin_amdgcn_s_memtime(), r1 = (unsigned)__builtin_amdgcn_s_memrealtime(); if (tid == 0) { MISC[26] = c1 - p5c; MISC[27] = r1 - p5r; } }
        unsigned b_t0 = 0; if (PROBE4) b_t0 = (unsigned)__builtin_amdgcn_s_memrealtime();
        const int kn_ = (ph + 1) % 9; const bool next_resid = (ph + 1 < hi) && (kn_ == 2 || kn_ == 6 || kn_ == 8);
        if ((ph + 1 < hi || PROBE_MASK) && !next_resid) {
            const bool global = !use_groups || (ph % 9 == 0) || ((ph + 1) % 9 == 0) || ph + 1 == hi;
            if (global) { xcd_barrier(bar);
                if (use_groups && ph == 0) { const unsigned mk = xb_ld((unsigned*)(ws0 + WS_CTL) + CW_GRP + 64 * grp); gbar.cheap = !FORCE_FULL_RELEASE && __builtin_popcount(mk) == 1; }
                if (use_groups && STAGGER_TICKS > 0 && (ph % 9) == 0 && ph + 1 < hi) { const unsigned long long t0_ = __builtin_amdgcn_s_memrealtime(); const unsigned long long dl_ = (unsigned long long)(STAGGER_TICKS) * (unsigned)grp;
                    while (__builtin_amdgcn_s_memrealtime() - t0_ < dl_) __builtin_amdgcn_s_sleep(4); } }
            else grp_barrier(gbar, (unsigned)(7 * (ph / 9) + ph % 9));
        }
        if (PROBE4) t_sel += (unsigned)__builtin_amdgcn_s_memrealtime() - b_t0;
        if (PROBE_MASK) { const unsigned t = (unsigned)__builtin_amdgcn_s_memrealtime(); if ((PROBE_MASK >> ph) & 1) t_sel += t - t_prev; t_prev = t; }
    }
    if (PROBE_MASK && bx == 0 && tid == 0) args.out[0] += 100.f * (float)t_sel / (float)(t_prev - t_first);
    if (PROBE5 >= 0) { xcd_barrier(bar); if (bx == 0 && tid == 0) { const float rt_ = (float)MISC[26] / (float)MISC[27]; args.out[0] += rt_ < 15.f ? 20.f : rt_ < 17.f ? 40.f : rt_ < 19.f ? 60.f : rt_ < 21.f ? 80.f : 100.f; } }
    if (PROBE4) { const unsigned t_end = (unsigned)__builtin_amdgcn_s_memrealtime(); xcd_barrier(bar); if (bx == PROBE4 - 1 && tid == 0) args.out[0] += 100.f * (float)t_sel / (float)(t_end - t_first); }
    if (PROBE3) { const unsigned t_end = (unsigned)__builtin_amdgcn_s_memrealtime(); xcd_barrier(bar); if (bx == 0 && tid == 0) args.out[0] += 100.f * (float)MISC[23 + PROBE3] / (float)(t_end - t_first); }
    if (PROBE2_PHASE >= 0) { const unsigned t_end = (unsigned)__builtin_amdgcn_s_memrealtime(); xcd_barrier(bar); if (bx == 0 && tid == 0) args.out[0] += PROBE2_SEL == 9 ? ({ const float c_ = (float)MISC[20] / (float)MISC[22]; c_ < 2300.f ? 20.f : c_ < 2500.f ? 30.f : c_ < 2700.f ? 40.f : c_ < 2900.f ? 50.f : c_ < 3100.f ? 60.f : c_ < 3300.f ? 70.f : 80.f; }) : 1000.f * (float)MISC[(PROBE2_SEL >= 5 ? 21 : 20 + (PROBE2_SEL & 3))] / (float)(t_end - t_first); }
}
#ifndef FAST_MASK
#define FAST_MASK 0x3ffffu
#endif
#ifndef MERGE_LAUNCHES
#define MERGE_LAUNCHES 1
#endif
static void launch_slow_phase(const Inputs& I, int ph, unsigned char* ws, float* out, hipStream_t stream) {
    const int l = ph / 9, k = ph % 9;
    float* SS = (float*)(ws + WS_SS);
    bf16 *XB = (bf16*)(ws + WS_XB), *H = (bf16*)(ws + WS_H), *QKV = (bf16*)(ws + WS_QKV), *T = (bf16*)(ws + WS_T), *MRG = (bf16*)(ws + WS_MRG), *G = (bf16*)(ws + WS_G),
         *ONA = (bf16*)(ws + WS_ONA), *OSW = (bf16*)(ws + WS_OSW);
    float* ss0 = SS + (size_t)(3 * l + 0) * M; float* ss1 = SS + (size_t)(3 * l + 1) * M; float* ss2 = SS + (size_t)(3 * l + 2) * M; float* ss3 = SS + (size_t)(3 * l + 3) * M;
    switch (k) {
    case 0: if (l == 0) hipLaunchKernelGGL(slow::prep_x, dim3(M), dim3(256), 0, stream, I.x, XB, SS); break;
    case 1: { slow::OpFfnUp op{DM, 0, XB, I.ffn1_wg + (size_t)l * DM * FF, I.ffn1_wu + (size_t)l * DM * FF, I.ffn1_norm + l * DM, ss0, H};
              hipLaunchKernelGGL(slow::gemm<slow::OpFfnUp>, dim3(FF / 64, M / 64), dim3(256), 0, stream, op); } break;
    case 2: { slow::OpResid op{FF, 0.5f, H, I.ffn1_wd + (size_t)l * FF * DM, l == 0 ? I.x : out, out, XB, ss1};
              hipLaunchKernelGGL(slow::gemm<slow::OpResid>, dim3(DM / 64, M / 64), dim3(256), 0, stream, op); } break;
    case 3: { slow::OpWin op{DM, 0, XB, I.w_in + (size_t)l * DM * INW, I.mix_norm + l * DM, ss1, I.b_gate + l * NG, I.na_q_norm + l * 64, I.na_k_norm + l * 64, I.sw_q_norm + l * 64, I.sw_k_norm + l * 64, QKV, G};
              hipLaunchKernelGGL(slow::gemm<slow::OpWin>, dim3(INW / 64, M / 64), dim3(256), 0, stream, op); } break;
    case 4: hipLaunchKernelGGL(slow::attn_na, dim3(M * 8 / 4), dim3(256), 0, stream, QKV, I.na_rpb + (size_t)l * 8 * 15 * 31, ONA);
            hipLaunchKernelGGL(slow::attn_sw, dim3(M * 8 / 4), dim3(256), 0, stream, QKV, I.t5, I.sw_sink + l * 8, OSW); break;
    case 5: { slow::OpBranch op{512, 0, ONA, OSW, G, I.w_br_na + (size_t)l * 512 * DM, I.w_br_sw + (size_t)l * 512 * DM, T, MRG};
              hipLaunchKernelGGL(slow::gemm<slow::OpBranch>, dim3(DM / 64, M / 64), dim3(256), 0, stream, op); } break;
    case 6: { slow::OpResid op{DM, 1.0f, MRG, I.w_out + (size_t)l * DM * DM, out, out, XB, ss2};
              hipLaunchKernelGGL(slow::gemm<slow::OpResid>, dim3(DM / 64, M / 64), dim3(256), 0, stream, op); } break;
    case 7: { slow::OpFfnUp op{DM, 0, XB, I.ffn2_wg + (size_t)l * DM * FF, I.ffn2_wu + (size_t)l * DM * FF, I.ffn2_norm + l * DM, ss2, H};
              hipLaunchKernelGGL(slow::gemm<slow::OpFfnUp>, dim3(FF / 64, M / 64), dim3(256), 0, stream, op); } break;
    default: { const bool last = (l == DEPTH - 1);
              slow::OpResid op{FF, 0.5f, H, I.ffn2_wd + (size_t)l * FF * DM, out, out, last ? nullptr : XB, last ? nullptr : ss3};
              hipLaunchKernelGGL(slow::gemm<slow::OpResid>, dim3(DM / 64, M / 64), dim3(256), 0, stream, op); } break;
    }
}

extern "C" void kernel_launch(void* const* d_in, const int* in_sizes, int n_in, void* d_out, int out_size, void* d_ws, size_t ws_size, hipStream_t stream) {
    static int grid = 0;
    if (grid == 0) {
        if (n_in != 22 || in_sizes[0] != M * DM || out_size != M * DM || ws_size < WS_END) { fprintf(stderr, "kernel_launch: unexpected shapes (n_in %d, in0 %d, out %d, ws %zu)\n", n_in, n_in > 0 ? in_sizes[0] : -1, out_size, ws_size); grid = -1; return; }
        int dev = 0, cus = 0, per_cu = 0;
        if (hipGetDevice(&dev) != hipSuccess || hipDeviceGetAttribute(&cus, hipDeviceAttributeMultiprocessorCount, dev) != hipSuccess) { grid = -1; return; }
        if (hipFuncSetAttribute((const void*)mega_fwd, hipFuncAttributeMaxDynamicSharedMemorySize, LDS_BYTES) != hipSuccess) { fprintf(stderr, "kernel_launch: hipFuncSetAttribute failed\n"); grid = -1; return; }
        if (hipOccupancyMaxActiveBlocksPerMultiprocessor(&per_cu, (const void*)mega_fwd, NTHREADS, LDS_BYTES) != hipSuccess || per_cu < 1) fprintf(stderr, "kernel_launch: occupancy query says %d blocks/CU\n", per_cu);
        (void)hipGetLastError();
        grid = cus;
    }
    if (grid < 0) return;
    Inputs I;
    { const float** p = (const float**)&I; for (int i = 0; i < 22; ++i) p[i] = (const float*)d_in[i]; }
    unsigned char* ws = (unsigned char*)d_ws; float* out = (float*)d_out;
    (void)hipMemsetAsync(ws + WS_CTL, 0, CTL_ZERO_BYTES, stream);
    int region = 0;
#ifndef HOST_PH_END
#define HOST_PH_END N_PHASES
#endif
    for (int ph = 0; ph < HOST_PH_END;) {
        if (!((FAST_MASK >> ph) & 1u)) { launch_slow_phase(I, ph, ws, out, stream); ++ph; continue; }
        int hi = ph + 1;
        if (MERGE_LAUNCHES) while (hi < HOST_PH_END && ((FAST_MASK >> hi) & 1u)) ++hi;
        Args a{};
        a.I = I; a.out = out; a.ws = ws; a.ph_lo = ph; a.ph_hi = hi; a.bar_region = region++; a.pad = 0;
        hipLaunchKernelGGL(mega_fwd, dim3(grid), dim3(NTHREADS), LDS_BYTES, stream, a);
        ph = hi;
    }
}
```

```cpp
#include <hip/hip_runtime.h>
#include <cstdio>
#include <cstdint>

constexpr int BATCH = 8, SEQ = 2048, DM = 1024, DEPTH = 2, FF = 2816;
constexpr int M = BATCH * SEQ;
constexpr int GRID_W = 64, ROWS = SEQ / GRID_W;
constexpr int NQKV = 2304, NG = 2048, INW = NQKV + NG;
constexpr float EPS = 1e-6f;
constexpr float NEGV = -1e30f;

typedef unsigned short bf16;

constexpr size_t MiB = 1u << 20;
constexpr size_t WS_CTL = 0;
constexpr size_t WS_SS = 512 * 1024;
constexpr size_t CTL_ZERO_BYTES = 1 * MiB;
constexpr size_t WS_W = 1 * MiB;
constexpr size_t WS_XB = 47 * MiB;
constexpr size_t WS_H = 79 * MiB;
constexpr size_t WS_QKV = 79 * MiB;
constexpr size_t WS_T = 79 * MiB;
constexpr size_t WS_MRG = 111 * MiB;
constexpr size_t WS_G = 151 * MiB;
constexpr size_t WS_ONA = 215 * MiB;
constexpr size_t WS_OSW = 231 * MiB;
constexpr size_t WS_W2D1 = 247 * MiB;
constexpr size_t WS_END = 253 * MiB;

__device__ __forceinline__ unsigned f2bf(float f) { unsigned u = __builtin_bit_cast(unsigned, f); return (u + 0x7fffu + ((u >> 16) & 1u)) >> 16; }
__device__ __forceinline__ float bf2f(unsigned b) { return __builtin_bit_cast(float, b << 16); }
__device__ __forceinline__ float bfr(float f) { return bf2f(f2bf(f)); }

struct Inputs {
    const float *x, *ffn1_norm, *ffn1_wg, *ffn1_wu, *ffn1_wd, *mix_norm, *w_in, *b_gate, *na_q_norm, *na_k_norm, *na_rpb, *sw_q_norm, *sw_k_norm, *sw_sink, *t5,
                *w_br_na, *w_br_sw, *w_out, *ffn2_norm, *ffn2_wg, *ffn2_wu, *ffn2_wd;
};

namespace slow {
template <class Op> __global__ void __launch_bounds__(256) gemm(Op op) {
    constexpr int NS = Op::NSEL;
    __shared__ float As[NS][16][68];
    __shared__ float Bs[NS][16][68];
    __shared__ float Cs[NS][64][65];
    const int tid = threadIdx.x, tx = tid & 15, ty = tid >> 4;
    const int m0 = blockIdx.y * 64, n0 = blockIdx.x * 64;
    float acc[NS][4][4];
#pragma unroll
    for (int s = 0; s < NS; ++s)
#pragma unroll
        for (int i = 0; i < 4; ++i)
#pragma unroll
            for (int j = 0; j < 4; ++j) acc[s][i][j] = 0.f;
    for (int k0 = 0; k0 < op.K; k0 += 16) {
#pragma unroll
        for (int s = 0; s < NS; ++s) {
#pragma unroll
            for (int e = 0; e < 4; ++e) {
                const int idx = tid + e * 256;
                { const int kk = idx & 15, mm = idx >> 4; As[s][kk][mm] = op.a(s, m0 + mm, k0 + kk); }
                { const int nn = idx & 63, kk = idx >> 6; Bs[s][kk][nn] = op.b(s, k0 + kk, n0 + nn); }
            }
        }
        __syncthreads();
#pragma unroll
        for (int kk = 0; kk < 16; ++kk) {
#pragma unroll
            for (int s = 0; s < NS; ++s) {
                float av[4], bv[4];
#pragma unroll
                for (int i = 0; i < 4; ++i) { av[i] = As[s][kk][ty * 4 + i]; bv[i] = Bs[s][kk][tx * 4 + i]; }
#pragma unroll
                for (int i = 0; i < 4; ++i)
#pragma unroll
                    for (int j = 0; j < 4; ++j) acc[s][i][j] += av[i] * bv[j];
            }
        }
        __syncthreads();
    }
#pragma unroll
    for (int s = 0; s < NS; ++s)
#pragma unroll
        for (int i = 0; i < 4; ++i)
#pragma unroll
            for (int j = 0; j < 4; ++j) Cs[s][ty * 4 + i][tx * 4 + j] = acc[s][i][j];
    __syncthreads();
    op.epi(m0, n0, Cs, tid);
}

struct OpFfnUp {
    static constexpr int NSEL = 2; int K, pad_;
    const bf16* xb; const float *wg, *wu, *gn, *ss; bf16* H;
    __device__ float a(int, int m, int k) const { return bf2f(xb[(size_t)m * DM + k]); }
    __device__ float b(int s, int k, int n) const { return bfr(gn[k] * (s ? wu : wg)[(size_t)k * FF + n]); }
    __device__ void epi(int m0, int n0, float (*Cs)[64][65], int tid) const {
        for (int e = tid; e < 4096; e += 256) { const int i = e >> 6, j = e & 63, m = m0 + i;
            const float r = rsqrtf(ss[m] * (1.f / DM) + EPS), zg = r * Cs[0][i][j], zu = r * Cs[1][i][j];
            const float h = zg / (1.f + __expf(-zg)) * zu;
            H[(size_t)m * FF + n0 + j] = (bf16)f2bf(h); }
    }
};
struct OpResid {
    static constexpr int NSEL = 1; int K; float alpha;
    const bf16* A; const float* w; const float* base; float* out; bf16* xb; float* ss;
    __device__ float a(int, int m, int k) const { return bf2f(A[(size_t)m * K + k]); }
    __device__ float b(int, int k, int n) const { return bfr(w[(size_t)k * DM + n]); }
    __device__ void epi(int m0, int n0, float (*Cs)[64][65], int tid) const {
        for (int e = tid; e < 4096; e += 256) { const int i = e >> 6, j = e & 63; const size_t o = (size_t)(m0 + i) * DM + n0 + j;
            const float v = base[o] + alpha * Cs[0][i][j]; out[o] = v; Cs[0][i][j] = v; if (xb) xb[o] = (bf16)f2bf(v); }
        __syncthreads();
        if (ss && tid < 64) { float s = 0.f; for (int j = 0; j < 64; ++j) s += Cs[0][tid][j] * Cs[0][tid][j]; atomicAdd(ss + m0 + tid, s); }
    }
};
struct OpWin {
    static constexpr int NSEL = 1; int K, pad_;
    const bf16* xb; const float *w, *gn, *ss, *bg, *naq, *nak, *swq, *swk; bf16 *QKV, *G;
    __device__ float a(int, int m, int k) const { return bf2f(xb[(size_t)m * DM + k]); }
    __device__ float b(int, int k, int n) const { return bfr(gn[k] * w[(size_t)k * INW + n]); }
    __device__ void epi(int m0, int n0, float (*Cs)[64][65], int tid) const {
        __shared__ float hn[64];
        const int hg = n0 >> 6;
        const float* gain = hg < 8 ? naq : hg < 16 ? nak : (hg >= 24 && hg < 32) ? swq : (hg >= 32 && hg < 34) ? swk : nullptr;
        const float qs = (hg < 8 || (hg >= 24 && hg < 32)) ? 0.125f : 1.f;
        for (int e = tid; e < 4096; e += 256) { const int i = e >> 6, j = e & 63; Cs[0][i][j] *= rsqrtf(ss[m0 + i] * (1.f / DM) + EPS); }
        __syncthreads();
        if (tid < 64) { float s = 0.f; for (int j = 0; j < 64; ++j) s += Cs[0][tid][j] * Cs[0][tid][j]; hn[tid] = rsqrtf(s * (1.f / 64.f) + EPS); }
        __syncthreads();
        for (int e = tid; e < 4096; e += 256) { const int i = e >> 6, j = e & 63, m = m0 + i; float z = Cs[0][i][j];
            if (hg < 36) { if (gain) z = z * hn[i] * gain[j] * qs; QKV[(size_t)m * NQKV + n0 + j] = (bf16)f2bf(z); }
            else { const int c = n0 - NQKV + j; z = 1.f / (1.f + __expf(-(z + bg[c]))); G[(size_t)m * NG + c] = (bf16)f2bf(z); } }
    }
};
struct OpBranch {
    static constexpr int NSEL = 2; int K, pad_;
    const bf16 *ONA, *OSW, *G; const float *pa, *pb; bf16 *T, *MRG;
    __device__ float a(int s, int m, int k) const { return bf2f((s ? OSW : ONA)[(size_t)m * 512 + k]); }
    __device__ float b(int s, int k, int n) const { return bfr((s ? pb : pa)[(size_t)k * DM + n]); }
    __device__ void epi(int m0, int n0, float (*Cs)[64][65], int tid) const {
        for (int e = tid; e < 4096; e += 256) { const int i = e >> 6, j = e & 63, m = m0 + i, n = n0 + j;
            const float gA = bf2f(G[(size_t)m * NG + n]), gB = bf2f(G[(size_t)m * NG + DM + n]);
            const float t = bfr(gA * Cs[0][i][j]); T[(size_t)m * DM + n] = (bf16)f2bf(t);
            MRG[(size_t)m * DM + n] = (bf16)f2bf(t + gB * Cs[1][i][j]); }
    }
};

__global__ void __launch_bounds__(256) prep_x(const float* x, bf16* xb, float* ss) {
    __shared__ float red[256];
    const int m = blockIdx.x, tid = threadIdx.x; float s = 0.f;
    for (int c = tid; c < DM; c += 256) { const float v = x[(size_t)m * DM + c]; xb[(size_t)m * DM + c] = (bf16)f2bf(v); s += v * v; }
    red[tid] = s; __syncthreads();
    for (int o = 128; o > 0; o >>= 1) { if (tid < o) red[tid] += red[tid + o]; __syncthreads(); }
    if (tid == 0) ss[m] = red[0];
}

__device__ __forceinline__ float wave_sum(float v) {
#pragma unroll
    for (int o = 1; o < 64; o <<= 1) v += __shfl_xor(v, o);
    return v;
}
__device__ __forceinline__ float wave_max(float v) {
#pragma unroll
    for (int o = 1; o < 64; o <<= 1) v = fmaxf(v, __shfl_xor(v, o));
    return v;
}
__global__ void __launch_bounds__(256) attn_na(const bf16* QKV, const float* rpb  , bf16* ONA) {
    __shared__ float sc[4][128];
    const int w = threadIdx.x >> 6, lane = threadIdx.x & 63;
    const int item = blockIdx.x * 4 + w;
    const int h = item & 7, tok = item >> 3, b = tok / SEQ, t = tok % SEQ, r = t / GRID_W, c = t % GRID_W;
    int rs = r - 4; rs = rs < 0 ? 0 : (rs > ROWS - 8 ? ROWS - 8 : rs);
    int cs = c - 8; cs = cs < 0 ? 0 : (cs > GRID_W - 16 ? GRID_W - 16 : cs);
    const float q = bf2f(QKV[(size_t)tok * NQKV + h * 64 + lane]);
    for (int j = 0; j < 128; ++j) { const int kr = rs + (j >> 4), kc = cs + (j & 15); const size_t kt = (size_t)b * SEQ + kr * GRID_W + kc;
        float s = wave_sum(q * bf2f(QKV[kt * NQKV + 512 + h * 64 + lane]));
        s += rpb[(h * 15 + (kr - r + 7)) * 31 + (kc - c + 15)];
        if (lane == 0) sc[w][j] = s; }
    __syncthreads();
    const float s0 = sc[w][lane], s1 = sc[w][lane + 64];
    const float mx = wave_max(fmaxf(s0, s1));
    const float e0 = __expf(s0 - mx), e1 = __expf(s1 - mx);
    const float l = wave_sum(e0 + e1);
    __syncthreads();
    sc[w][lane] = bfr(e0); sc[w][lane + 64] = bfr(e1);
    __syncthreads();
    float o = 0.f;
    for (int j = 0; j < 128; ++j) { const int kr = rs + (j >> 4), kc = cs + (j & 15); const size_t kt = (size_t)b * SEQ + kr * GRID_W + kc;
        o += sc[w][j] * bf2f(QKV[kt * NQKV + 1024 + h * 64 + lane]); }
    ONA[(size_t)tok * 512 + h * 64 + lane] = (bf16)f2bf(o / l);
}
__device__ __forceinline__ int t5_bucket(int rel) {
    const int n = rel < 0 ? -rel : rel; int v;
    if (n < 8) v = n; else { int k = 0; while (64 * (2 << k) <= n * n) ++k; v = 8 + k; v = v > 15 ? 15 : v; }
    return (rel > 0 ? 16 : 0) + v;
}
__global__ void __launch_bounds__(256) attn_sw(const bf16* QKV, const float* t5  , const float* sink  , bf16* OSW) {
    __shared__ float sc[4][320];
    const int w = threadIdx.x >> 6, lane = threadIdx.x & 63;
    const int item = blockIdx.x * 4 + w;
    const int h = item & 7, tok = item >> 3, b = tok / SEQ, t = tok % SEQ, g = h >> 2;
    const int k0 = t - 128 < 0 ? 0 : t - 128, k1 = t + 128 > SEQ - 1 ? SEQ - 1 : t + 128, nk = k1 - k0 + 1;
    const float q = bf2f(QKV[(size_t)tok * NQKV + 1536 + h * 64 + lane]);
    for (int j = 0; j < nk; ++j) { const size_t kt = (size_t)b * SEQ + k0 + j;
        float s = wave_sum(q * bf2f(QKV[kt * NQKV + 2048 + g * 64 + lane]));
        s += t5[t5_bucket(k0 + j - t) * 8 + h];
        if (lane == 0) sc[w][j] = s; }
    __syncthreads();
    const float snk = sink[h];
    float mx = snk; for (int j = lane; j < nk; j += 64) mx = fmaxf(mx, sc[w][j]);
    mx = wave_max(mx);
    float l = 0.f; for (int j = lane; j < nk; j += 64) { const float e = __expf(sc[w][j] - mx); l += e; sc[w][j] = bfr(e); }
    l = wave_sum(l) + __expf(snk - mx);
    __syncthreads();
    float o = 0.f;
    for (int j = 0; j < nk; ++j) { const size_t kt = (size_t)b * SEQ + k0 + j; o += sc[w][j] * bf2f(QKV[kt * NQKV + 2176 + g * 64 + lane]); }
    OSW[(size_t)tok * 512 + h * 64 + lane] = (bf16)f2bf(o / l);
}
}

#ifndef CODE_MASK
#define CODE_MASK 255
#endif
#ifndef PROBE2_PHASE
#define PROBE2_PHASE -1
#endif
#ifndef NA_STAGGER
#define NA_STAGGER 0
#endif
#ifndef PAD_NOPS
#define PAD_NOPS 0
#endif
#define PAD_STR_(x) #x
#define PAD_STR(x) PAD_STR_(x)
#ifndef DYN_PREP
#define DYN_PREP 1
#endif
#ifndef PROBE2_SEL
#define PROBE2_SEL 0
#endif
#ifndef PROBE3
#define PROBE3 0
#endif
#ifndef GROUPS
#define GROUPS 1
#endif
#ifndef PROBE5
#define PROBE5 -1
#endif
#ifndef RELAX_WAITS
#define RELAX_WAITS 1
#endif
#ifndef NA_V2
#define NA_V2 1
#endif
#ifndef RING4
#define RING4 0
#endif
#ifndef FULL_LINES
#define FULL_LINES 0
#endif
#ifndef NT_BASE
#define NT_BASE 0
#endif
#ifndef FORCE_FULL_RELEASE
#define FORCE_FULL_RELEASE 0
#endif
#ifndef WGM_P3
#define WGM_P3 PG8_WGM
#endif
#ifndef WGM_P1
#define WGM_P1 PG8_WGM
#endif
#ifndef STAGGER_TICKS
#define STAGGER_TICKS 0
#endif
#ifndef PROBE4
#define PROBE4 0
#endif
#ifndef PROBE_MASK
#define PROBE_MASK 0
#endif
#define LAS __attribute__((address_space(3)))
#define GAS __attribute__((address_space(1)))
typedef short bf16x8 __attribute__((ext_vector_type(8)));
typedef short s16x4 __attribute__((ext_vector_type(4)));
typedef float f32x4 __attribute__((ext_vector_type(4)));
typedef unsigned u32x4 __attribute__((ext_vector_type(4)));
typedef unsigned u32x2 __attribute__((ext_vector_type(2)));
typedef GAS unsigned gu32;

constexpr int NWAVES = 8, NTHREADS = 512;
constexpr int LDS_BYTES = 147456;
constexpr int RING_BYTES = 131072;
constexpr int MISC_OFF = RING_BYTES + 320;

constexpr size_t WO_1C = 0;
constexpr size_t WO_1D = WO_1C + (size_t)2 * FF * DM * 2;
constexpr size_t WO_IN = WO_1D + (size_t)DM * FF * 2;
constexpr size_t WO_PA = WO_IN + (size_t)INW * DM * 2;
constexpr size_t WO_PB = WO_PA + (size_t)DM * 512 * 2;
constexpr size_t WO_OUT = WO_PB + (size_t)DM * 512 * 2;
constexpr size_t WO_2C = WO_OUT + (size_t)DM * DM * 2;
constexpr size_t WO_2D = WO_2C + (size_t)2 * FF * DM * 2;
constexpr size_t WO_END = WO_2D + (size_t)DM * FF * 2;
static_assert(WS_W + WO_END <= WS_XB, "weight region");

typedef float f32x2_t __attribute__((ext_vector_type(2))); typedef __bf16 bf16x2_t __attribute__((ext_vector_type(2)));
__device__ __forceinline__ unsigned cvt_pk_bf16(float lo, float hi) { const f32x2_t v = {lo, hi}; const bf16x2_t b = __builtin_convertvector(v, bf16x2_t); return __builtin_bit_cast(unsigned, b); }
#ifndef WT_STORES
#define WT_STORES 0
#endif
typedef __amdgpu_buffer_rsrc_t rsrc_t;
__device__ __forceinline__ rsrc_t mk_rsrc(const void* p) { return __builtin_amdgcn_make_buffer_rsrc((void*)p, 0, 0x7fffffff, 0x00020000); }
__device__ __forceinline__ void st16(rsrc_t r, unsigned byteoff, u32x4 v) { __builtin_amdgcn_raw_buffer_store_b128(v, r, (int)byteoff, 0, (WT_STORES & 1) ? 16 : 0); }
__device__ __forceinline__ void st8(rsrc_t r, unsigned byteoff, u32x2 v) { __builtin_amdgcn_raw_buffer_store_b64(v, r, (int)byteoff, 0, 0); }
__device__ __forceinline__ unsigned pack_u8x4(f32x4 v) {
    unsigned w = __builtin_amdgcn_cvt_pk_u8_f32(v[0] * 255.f, 0u, 0u); w = __builtin_amdgcn_cvt_pk_u8_f32(v[1] * 255.f, 1u, w); w = __builtin_amdgcn_cvt_pk_u8_f32(v[2] * 255.f, 2u, w); return __builtin_amdgcn_cvt_pk_u8_f32(v[3] * 255.f, 3u, w); }
__device__ __forceinline__ float u8f(u32x2 w, int e) { return (float)((w[e >> 2] >> (8 * (e & 3))) & 0xffu); }
__device__ __forceinline__ void st16o(rsrc_t r, unsigned byteoff, u32x4 v) { __builtin_amdgcn_raw_buffer_store_b128(v, r, (int)byteoff, 0, (WT_STORES & 2) ? 16 : (WT_STORES & 4) ? 2 : 0); }
__device__ __forceinline__ float fast_sigmoid(float z) { return __builtin_amdgcn_rcpf(1.f + __builtin_amdgcn_exp2f(-1.4426950408889634f * z)); }
__device__ __forceinline__ float rs_row(const float* ss, int row) { return __builtin_amdgcn_rsqf(ss[row] * (1.f / DM) + EPS); }

namespace pg8 {
#ifndef PG8_WGM
#define PG8_WGM 4
#endif
constexpr int BM = 256, BK = 64, HALF = 128, HTB = HALF * BK * 2, STAGE_BYTES = 8 * HTB, NXCD = 8, WGM = PG8_WGM;
__host__ __device__ __forceinline__ int lds_byte(int r, int c) { const int st = (r >> 4) * 2 + (c >> 5), rr = r & 15, cc = c & 31, ob = rr * 64 + cc * 2; return st * 1024 + (ob ^ (((ob >> 9) & 1) << 5)); }
__host__ __device__ __forceinline__ void stage_rc(int b, int& R, int& C) { const int st = b / 1024, sb = b % 1024, swz = sb ^ (((sb >> 9) & 1) << 5); R = (st >> 1) * 16 + swz / 64; C = (st & 1) * 32 + (swz % 64) / 2; }
struct Unit { int pm, pn, hf, sel; };
struct Gemm { const bf16* A; const bf16* Bt; int M, N, K; const bf16* A2; const bf16* Bt2; };
struct StaticOrder {
    int nM, nN, nwg, G, c, nfull, ntot, wgm;
    __device__ void init(int M_, int N_, int G_, int c_, int wgm_ = WGM) { nM = M_ / BM; nN = N_ / BM; nwg = nM * nN; G = G_; c = c_; wgm = wgm_;
        const int rem = nwg % G; const bool split = rem > 0 && 2 * rem <= G && (nwg % NXCD) == 0 && (rem % NXCD) == 0 && (G % NXCD) == 0;
        nfull = split ? nwg - rem : nwg; ntot = split ? nfull + 2 * rem : nwg; }
    __device__ bool next(int i, Unit& u) const {
        const long L = (long)i * G + c; if (L >= ntot) return false;
        const int q = nwg / NXCD, r = nwg % NXCD; int wgid;
        if (L < nfull) { const int xcd = (int)L % NXCD, off = (int)L / NXCD; wgid = (xcd < r ? xcd * (q + 1) : r * (q + 1) + (xcd - r) * q) + off; u.hf = 0; }
        else { const int Lp = (int)L - nfull, xcd = Lp % NXCD, idx = Lp / NXCD; wgid = xcd * q + nfull / NXCD + (idx >> 1); u.hf = 1 + (idx & 1); }
        const int nig = wgm * nN, gid = wgid / nig, fm = gid * wgm, gsz = (nM - fm) < wgm ? (nM - fm) : wgm;
        u.pm = fm + ((wgid % nig) % gsz); u.pn = (wgid % nig) / gsz; u.sel = 0; return true;
    }
};
struct DualOrder { StaticOrder S;
    __device__ bool next(int i, Unit& u) const { if (!S.next(i >> 1, u)) return false; u.sel = i & 1; return true; } };
struct NoBar { __device__ __forceinline__ void operator()() const {} template <class Hook> __device__ __forceinline__ void run(const Hook& h) const { h(); } };
template <class Epi, class AccT> struct PreloadHook { const Epi& E; AccT& acc; const Unit& u; int wr, wc, fr, fq; __device__ __forceinline__ void operator()() const { E.preload(acc, u, wr, wc, fr, fq); } };
template <class Epi, bool ALIGN_EPI, bool SP2, class Sched = StaticOrder, class Bar = NoBar>
__device__ __forceinline__ void gemm_phase(LAS unsigned char* lds, const Gemm g, const Sched& S, const Epi& E, const Bar& PB = Bar()) {
    int tid_ = threadIdx.x; asm volatile("" : "+v"(tid_));
    const int tid = tid_, wid = __builtin_amdgcn_readfirstlane(tid >> 6), lane = tid & 63, wr = wid >> 2, wc = wid & 3, fr = lane & 15, fq = lane >> 4;
    const int K = g.K, nt = K / BK;
    unsigned voff[2];
#pragma unroll
    for (int i = 0; i < 2; ++i) { int R, C; if (FULL_LINES) { R = 8 * (wid + 8 * i) + (lane >> 3); C = 8 * ((lane & 7) ^ (lane >> 3)); } else stage_rc(tid * 16 + i * 8192, R, C); voff[i] = (unsigned)(R * K + C) * 2u; }
    const size_t kstep = (size_t)(BK * 2), hstep = (size_t)HALF * K * 2, tstep = 2 * hstep;
    const unsigned ldsw = (unsigned)wid * 1024u;
    const int aoff = FULL_LINES ? (8 * wr + (fr >> 3)) * 1024 + (fr & 7) * 128 + ((fq ^ (fr & 7)) << 4) : lds_byte(wr * 64 + fr, fq * 8);
    const int boff = FULL_LINES ? (4 * wc + (fr >> 3)) * 1024 + (fr & 7) * 128 + ((fq ^ (fr & 7)) << 4) : lds_byte(wc * 32 + fr, fq * 8);
    const int aoff1 = FULL_LINES ? (aoff ^ 64) : aoff + 1024, boff1 = FULL_LINES ? (boff ^ 64) : boff + 1024;
#define PG8_SA(b, h) (((b) * 2 + (h)) * HTB)
#define PG8_SB(b, h) ((4 + (b) * 2 + (h)) * HTB)
#define PG8_STAGE(bufoff, gbase) do { _Pragma("unroll") for (int _i = 0; _i < 2; ++_i) \
        __builtin_amdgcn_global_load_lds((const unsigned*)((const char*)(gbase) + voff[_i]), (LAS unsigned*)(lds + (bufoff) + ldsw + _i * 8192), 16, 0, 0); } while (0)
#define PG8_STAGEH(bufoff, gbase, hflag) do { _Pragma("unroll") for (int _i = 0; _i < 2; ++_i) \
        __builtin_amdgcn_global_load_lds((const unsigned*)((const char*)(gbase) + ((hflag) ? 0u : voff[_i])), (LAS unsigned*)(lds + (bufoff) + ldsw + _i * 8192), 16, 0, 0); } while (0)
#define PG8_LDA(dst, b, h) do { _Pragma("unroll") for (int m = 0; m < 4; ++m) _Pragma("unroll") for (int k = 0; k < 2; ++k) dst[m][k] = *(const LAS bf16x8*)(lds + PG8_SA(b, h) + (k ? aoff1 : aoff) + m * 2048); } while (0)
#define PG8_LDB(dst, b, h) do { _Pragma("unroll") for (int n = 0; n < 2; ++n) _Pragma("unroll") for (int k = 0; k < 2; ++k) dst[n][k] = *(const LAS bf16x8*)(lds + PG8_SB(b, h) + (k ? boff1 : boff) + n * 2048); } while (0)
#define PG8_MMA(ai, bj, At, Bt) do { __builtin_amdgcn_s_setprio(1); _Pragma("unroll") for (int m = 0; m < 4; ++m) _Pragma("unroll") for (int n = 0; n < 2; ++n) _Pragma("unroll") for (int k = 0; k < 2; ++k) \
        acc[ai][bj][m][n] = __builtin_amdgcn_mfma_f32_16x16x32_bf16(Bt[n][k], At[m][k], acc[ai][bj][m][n], 0, 0, 0); __builtin_amdgcn_s_setprio(0); } while (0)
#define PG8_WAIT_V(n) asm volatile("s_waitcnt vmcnt(" #n ")" ::: "memory")
#define PG8_WAIT_L(n) asm volatile("s_waitcnt lgkmcnt(" #n ")" ::: "memory")
#define PG8_BAR __builtin_amdgcn_s_barrier()
#define PG8_SCHED __builtin_amdgcn_sched_barrier(0)
#define PG8_TRIP(W12) do { \
            const bool last = (t == nt - 2); \
            const char* a1 = cA + (size_t)(t + 1) * kstep; \
            const char* a2 = last ? nA : cA + (size_t)(t + 2) * kstep; const char* b2 = last ? nB : cB + (size_t)(t + 2) * kstep; \
            const char* a3 = a2 + kstep; const char* b3 = b2 + kstep; const size_t hs2 = last ? nhs : chs; \
            PG8_LDB(B0, 0, 0); PG8_LDB(B1, 0, 1); PG8_SCHED; PG8_LDA(At, 0, 0); PG8_STAGEH(PG8_SA(1, 1), a1 + chs, chalf_st); \
            W12; PG8_WAIT_L(0); PG8_BAR; PG8_MMA(0, 0, At, B0); PG8_MMA(0, 1, At, B1); PG8_BAR; PG8_SCHED; \
            if (!chalf) { PG8_LDA(At, 0, 1); } PG8_STAGE(PG8_SB(0, 0), b2); PG8_STAGE(PG8_SB(0, 1), b2 + hstep); PG8_STAGE(PG8_SA(0, 0), a2); \
            W12; PG8_WAIT_L(0); PG8_BAR; if (!chalf) { PG8_MMA(1, 0, At, B0); PG8_MMA(1, 1, At, B1); } PG8_BAR; PG8_SCHED; \
            PG8_LDB(B0, 1, 0); PG8_LDB(B1, 1, 1); PG8_SCHED; PG8_LDA(At, 1, 0); if (last) chalf_st = nhalf_st; PG8_STAGEH(PG8_SA(0, 1), a2 + hs2, chalf_st); \
            PG8_WAIT_V(8); PG8_WAIT_L(0); PG8_BAR; PG8_MMA(0, 0, At, B0); PG8_MMA(0, 1, At, B1); PG8_BAR; PG8_SCHED; \
            if (!chalf) { PG8_LDA(At, 1, 1); } PG8_STAGE(PG8_SB(1, 0), b3); PG8_STAGE(PG8_SB(1, 1), b3 + hstep); PG8_STAGE(PG8_SA(1, 0), a3); \
            PG8_WAIT_V(8); PG8_WAIT_L(0); PG8_BAR; if (!chalf) { PG8_MMA(1, 0, At, B0); PG8_MMA(1, 1, At, B1); } PG8_BAR; PG8_SCHED; \
        } while (0)
    unsigned pe0 = 0, pe1 = 0; if (PROBE2_PHASE >= 0 && Epi::PROBE && PROBE2_SEL == 6) pe0 = (unsigned)__builtin_amdgcn_s_memrealtime();
    Unit cur, nxt; int ui = 0;
    if (!S.next(0, cur)) { PB(); return; }
    unsigned pa0 = 0, pa1 = 0, pa2 = 0;
    f32x4 acc[2][2][4][2];
    if constexpr (Epi::PRELOAD) { PB.run(PreloadHook<Epi, decltype(acc)>{E, acc, cur, wr, wc, fr, fq}); E.prescale(acc); }
    else { PB();
#pragma unroll
    for (int a = 0; a < 2; ++a)
#pragma unroll
        for (int b = 0; b < 2; ++b)
#pragma unroll
            for (int m = 0; m < 4; ++m)
#pragma unroll
                for (int n = 0; n < 2; ++n) acc[a][b][m][n] = (f32x4){0.f, 0.f, 0.f, 0.f};
    }
    bf16x8 At[4][2], B0[2][2], B1[2][2];
    const char* cA = (const char*)(cur.sel ? g.A2 : g.A) + (size_t)cur.pm * tstep + (cur.hf == 2 ? hstep : 0); const char* cB = (const char*)(cur.sel ? g.Bt2 : g.Bt) + (size_t)cur.pn * tstep;
    size_t chs = cur.hf ? 0 : hstep;
    bool chalf_st = cur.hf != 0;
    if constexpr (SP2) {
        PG8_STAGE(PG8_SB(0, 0), cB); PG8_STAGE(PG8_SB(0, 1), cB + hstep); PG8_STAGE(PG8_SA(0, 0), cA); PG8_STAGEH(PG8_SA(0, 1), cA + chs, chalf_st);
        if (wr == 1) PG8_BAR;
        PG8_WAIT_V(2); PG8_BAR;
        PG8_STAGE(PG8_SB(1, 0), cB + kstep); PG8_STAGE(PG8_SA(1, 0), cA + kstep); PG8_STAGE(PG8_SB(1, 1), cB + hstep + kstep);
        PG8_WAIT_V(6); PG8_BAR;
    } else {
        PG8_STAGE(PG8_SB(0, 0), cB); PG8_STAGE(PG8_SA(0, 0), cA); PG8_STAGE(PG8_SB(0, 1), cB + hstep); PG8_STAGEH(PG8_SA(0, 1), cA + chs, chalf_st);
        if (wr == 1) PG8_BAR;
        PG8_WAIT_V(4); PG8_BAR;
        PG8_STAGE(PG8_SB(1, 0), cB + kstep); PG8_STAGE(PG8_SA(1, 0), cA + kstep); PG8_STAGE(PG8_SB(1, 1), cB + hstep + kstep);
        PG8_WAIT_V(6); PG8_BAR;
    }
    for (;;) {
        const bool has_next = S.next(ui + 1, nxt);
        if (PROBE2_PHASE >= 0 && Epi::PROBE && PROBE2_SEL == 6 && ui == 0) pe1 = (unsigned)__builtin_amdgcn_s_memrealtime();
        unsigned p_t0 = 0; if (PROBE2_PHASE >= 0 && Epi::PROBE) p_t0 = PROBE2_SEL == 9 ? (unsigned)__builtin_amdgcn_s_memtime() : (unsigned)__builtin_amdgcn_s_memrealtime();
        const char* nA = has_next ? (const char*)(nxt.sel ? g.A2 : g.A) + (size_t)nxt.pm * tstep + (nxt.hf == 2 ? hstep : 0) : cA; const char* nB = has_next ? (const char*)(nxt.sel ? g.Bt2 : g.Bt) + (size_t)nxt.pn * tstep : cB;
        const size_t nhs = has_next ? (nxt.hf ? 0 : hstep) : chs; const bool chalf = cur.hf != 0;
        const bool nhalf_st = has_next ? (nxt.hf != 0) : chalf_st;
        static_assert(SP2, "only the two-super-phase loop is kept");
        { int t = 0;
          if constexpr (RELAX_WAITS && Epi::MULTI) { if (ui > 0) { PG8_TRIP((void)0); t = 2; } }
          for (; t < nt; t += 2) { PG8_TRIP(PG8_WAIT_V(8)); } }
        unsigned p_t1 = 0; if (PROBE2_PHASE >= 0 && Epi::PROBE) p_t1 = PROBE2_SEL == 9 ? (unsigned)__builtin_amdgcn_s_memtime() : (unsigned)__builtin_amdgcn_s_memrealtime();
        if constexpr (ALIGN_EPI) { if (wr == 0) PG8_BAR; }
        E(acc, cur, wr, wc, fr, fq);
        if (PROBE2_PHASE >= 0 && Epi::PROBE) { const unsigned p_t3 = (unsigned)__builtin_amdgcn_s_memrealtime(); pa0 += p_t1 - p_t0; if (ui == 0 && PROBE2_SEL < 5) pa1 = p_t1 - p_t0; pa2 += (PROBE2_SEL == 9) ? (unsigned)(cur.hf ? 0 : nt) : p_t3 - p_t1; }
        if (!has_next) break;
        if (!Epi::CHAIN || cur.sel != 0) {
#pragma unroll
        for (int a = 0; a < 2; ++a)
#pragma unroll
            for (int b = 0; b < 2; ++b)
#pragma unroll
                for (int m = 0; m < 4; ++m)
#pragma unroll
                    for (int n = 0; n < 2; ++n) acc[a][b][m][n] = (f32x4){0.f, 0.f, 0.f, 0.f};
        }
        cur = nxt; cA = nA; cB = nB; chs = nhs; ++ui;
        if constexpr (ALIGN_EPI) { if (wr == 1) PG8_BAR; }
    }
    unsigned pd0 = 0; if (PROBE2_PHASE >= 0 && Epi::PROBE && PROBE2_SEL == 5) pd0 = (unsigned)__builtin_amdgcn_s_memrealtime();
    if constexpr (Epi::PRELOAD) E.tail_prefetch(lds, wid);
    PG8_WAIT_V(0);
    if constexpr (!ALIGN_EPI) { if (wr == 0) PG8_BAR; }
    PG8_BAR;
    if (PROBE2_PHASE >= 0 && Epi::PROBE && PROBE2_SEL == 5) pa1 = (unsigned)__builtin_amdgcn_s_memrealtime() - pd0;
    if (PROBE2_PHASE >= 0 && Epi::PROBE && PROBE2_SEL == 6) pa1 = pe1 - pe0;
    if (PROBE2_PHASE >= 0 && Epi::PROBE) { volatile LAS unsigned* PM = (volatile LAS unsigned*)(lds + MISC_OFF); if (tid == 0 && PM[19]) { PM[20] = pa0; PM[21] = pa1; PM[22] = pa2; } }
#undef PG8_TRIP
#undef PG8_SA
#undef PG8_SB
#undef PG8_STAGE
#undef PG8_LDA
#undef PG8_LDB
#undef PG8_MMA
#undef PG8_WAIT_V
#undef PG8_WAIT_L
#undef PG8_BAR
#undef PG8_SCHED
}

typedef f32x4 Acc[2][2][4][2];
struct EpiFfnUp {
    static constexpr bool PROBE = (PROBE2_PHASE % 9 == 1) || (PROBE2_PHASE % 9 == 7), MULTI = true, PRELOAD = false, CHAIN = false;
    bf16* H; const float* ss;
    __device__ __forceinline__ void operator()(const Acc& acc, const Unit& u, int wr, int wc, int fr, int fq) const {
        const int row0 = u.pm * BM + (u.hf == 2 ? HALF : 0) + wr * 64 + fr, col0 = u.pn * 128 + wc * 32 + 8 * fq; const int nai = u.hf ? 1 : 2;
        const rsrc_t rH = mk_rsrc(H);
        float rr[2][4];
#pragma unroll
        for (int ai = 0; ai < 2; ++ai)
#pragma unroll
            for (int m = 0; m < 4; ++m) rr[ai][m] = ss[row0 + (ai < nai ? ai : 0) * HALF + m * 16];
#pragma unroll
        for (int ai = 0; ai < 2; ++ai) if (ai < nai)
#pragma unroll
            for (int m = 0; m < 4; ++m) { const int row = row0 + ai * HALF + m * 16; const float r = __builtin_amdgcn_rsqf(rr[ai][m] * (1.f / DM) + EPS); float h[8];
#pragma unroll
                for (int n = 0; n < 2; ++n)
#pragma unroll
                    for (int j = 0; j < 4; ++j) { const float zg = r * acc[ai][0][m][n][j], zu = r * acc[ai][1][m][n][j]; h[4 * n + j] = zg * fast_sigmoid(zg) * zu; }
                u32x4 w; w.x = cvt_pk_bf16(h[0], h[1]); w.y = cvt_pk_bf16(h[2], h[3]); w.z = cvt_pk_bf16(h[4], h[5]); w.w = cvt_pk_bf16(h[6], h[7]);
                st16(rH, (unsigned)(row * FF + col0) * 2u, w); }
    }
};
template <bool FB> struct EpiResidT {
    static constexpr bool PROBE = (PROBE2_PHASE % 9 == 2) || (PROBE2_PHASE % 9 == 6) || (PROBE2_PHASE % 9 == 8), MULTI = false, PRELOAD = true, CHAIN = false;
    const float* basef; float* out; bf16* xb; float* ss; float alpha; int tpf_l;
    __device__ __forceinline__ void tail_prefetch(LAS unsigned char* lds, int wid) const { if (tpf_l >= 0) {
        typedef const __attribute__((address_space(4))) Inputs* ipt; ipt ip = (ipt)__builtin_amdgcn_kernarg_segment_ptr(); asm volatile("" : "+s"(ip));
        const int lane_ = (int)__builtin_amdgcn_mbcnt_hi(~0u, __builtin_amdgcn_mbcnt_lo(~0u, 0u));
        LAS float* wt = (LAS float*)(lds + RING_BYTES + 1024); const float* bg = ip->b_gate + tpf_l * NG;
#pragma unroll
        for (int i = 0; i < 4; ++i) { const int blk = wid * 4 + i; __builtin_amdgcn_global_load_lds((const unsigned*)(bg + blk * 64 + lane_), (LAS unsigned*)(wt + blk * 64), 4, 0, 0); }
        if (wid < 4) { const float* gp = (wid == 0 ? ip->na_q_norm : wid == 1 ? ip->na_k_norm : wid == 2 ? ip->sw_q_norm : ip->sw_k_norm) + tpf_l * 64;
            __builtin_amdgcn_global_load_lds((const unsigned*)(gp + lane_), (LAS unsigned*)(wt + 2048 + 64 * wid), 4, 0, 0); } } }
    __device__ __forceinline__ void preload(Acc& acc, const Unit& u, int wr, int wc, int fr, int fq) const {
        const int row0 = u.pm * BM + wr * 64 + fr, col0 = u.pn * BM + wc * 64 + 8 * fq;
        const unsigned o0 = (unsigned)(row0 * DM + col0);
        if constexpr (FB) { const rsrc_t rB = mk_rsrc(basef);
#pragma unroll
            for (int ai = 0; ai < 2; ++ai)
#pragma unroll
                for (int m = 0; m < 4; ++m)
#pragma unroll
                    for (int bj = 0; bj < 2; ++bj) { const unsigned o = o0 + (unsigned)((ai * HALF + m * 16) * DM + bj * 32);
                        acc[ai][bj][m][0] = __builtin_bit_cast(f32x4, __builtin_amdgcn_raw_buffer_load_b128(rB, (int)(o * 4u), 0, 0)); acc[ai][bj][m][1] = __builtin_bit_cast(f32x4, __builtin_amdgcn_raw_buffer_load_b128(rB, (int)(o * 4u + 16u), 0, 0)); }
        } else { const rsrc_t rX = mk_rsrc(xb);
#pragma unroll
            for (int ai = 0; ai < 2; ++ai)
#pragma unroll
                for (int m = 0; m < 4; ++m)
#pragma unroll
                    for (int bj = 0; bj < 2; ++bj) { const unsigned o = o0 + (unsigned)((ai * HALF + m * 16) * DM + bj * 32);
                        acc[ai][bj][m][0] = __builtin_bit_cast(f32x4, __builtin_amdgcn_raw_buffer_load_b128(rX, (int)(o * 2u), 0, 0)); }
        }
    }
    __device__ __forceinline__ void prescale(Acc& acc) const {
        const float ia = 1.0f / alpha;
#pragma unroll
        for (int ai = 0; ai < 2; ++ai)
#pragma unroll
            for (int bj = 0; bj < 2; ++bj)
#pragma unroll
                for (int m = 0; m < 4; ++m) {
                    if constexpr (!FB) { const u32x4 q = __builtin_bit_cast(u32x4, acc[ai][bj][m][0]);
                        acc[ai][bj][m][0] = (f32x4){__builtin_bit_cast(float, q.x << 16), __builtin_bit_cast(float, q.x & 0xffff0000u), __builtin_bit_cast(float, q.y << 16), __builtin_bit_cast(float, q.y & 0xffff0000u)};
                        acc[ai][bj][m][1] = (f32x4){__builtin_bit_cast(float, q.z << 16), __builtin_bit_cast(float, q.z & 0xffff0000u), __builtin_bit_cast(float, q.w << 16), __builtin_bit_cast(float, q.w & 0xffff0000u)}; }
                    acc[ai][bj][m][0] = acc[ai][bj][m][0] * ia; acc[ai][bj][m][1] = acc[ai][bj][m][1] * ia; }
    }
    __device__ __forceinline__ void operator()(const Acc& acc, const Unit& u, int wr, int wc, int fr, int fq) const {
        const int row0 = u.pm * BM + wr * 64 + fr, col0 = u.pn * BM + wc * 64 + 8 * fq;
        const rsrc_t rO = mk_rsrc(out), rX = mk_rsrc(xb);
#pragma unroll
        for (int ai = 0; ai < 2; ++ai) {
#pragma unroll
            for (int m = 0; m < 4; ++m) { const int row = row0 + ai * HALF + m * 16; float part = 0.f;
#pragma unroll
                for (int bj = 0; bj < 2; ++bj) { const size_t o = (size_t)row * DM + col0 + bj * 32;
                    const f32x4 v0 = alpha * acc[ai][bj][m][0], v1 = alpha * acc[ai][bj][m][1];
                    if (out) { st16o(rO, (unsigned)o * 4u, __builtin_bit_cast(u32x4, v0)); st16o(rO, (unsigned)o * 4u + 16u, __builtin_bit_cast(u32x4, v1)); }
                    else { u32x4 w; w.x = cvt_pk_bf16(v0[0], v0[1]); w.y = cvt_pk_bf16(v0[2], v0[3]); w.z = cvt_pk_bf16(v1[0], v1[1]); w.w = cvt_pk_bf16(v1[2], v1[3]); st16(rX, (unsigned)o * 2u, w);
                        const float r0 = __builtin_bit_cast(float, w.x << 16), r1 = __builtin_bit_cast(float, w.x & 0xffff0000u), r2 = __builtin_bit_cast(float, w.y << 16), r3 = __builtin_bit_cast(float, w.y & 0xffff0000u),
                                    r4 = __builtin_bit_cast(float, w.z << 16), r5 = __builtin_bit_cast(float, w.z & 0xffff0000u), r6 = __builtin_bit_cast(float, w.w << 16), r7 = __builtin_bit_cast(float, w.w & 0xffff0000u);
                        part += (r0 * r0 + r1 * r1) + (r2 * r2 + r3 * r3) + (r4 * r4 + r5 * r5) + (r6 * r6 + r7 * r7); } }
                if (ss) { part += __shfl_xor(part, 16); part += __shfl_xor(part, 32); if (fq == 0) atomicAdd(ss + row, part); }
                __builtin_amdgcn_sched_barrier(0); }
            asm volatile("" ::: "memory"); }
    }
};
struct EpiWin {
    static constexpr bool PROBE = (PROBE2_PHASE % 9 == 3), MULTI = true, PRELOAD = false, CHAIN = false;
    bf16* QKV; unsigned char* G8; const float* ss; const LAS float* tab;
    __device__ __forceinline__ void operator()(const Acc& acc, const Unit& u, int wr, int wc, int fr, int fq) const {
        const int hg = __builtin_amdgcn_readfirstlane(4 * u.pn + wc);
        const int row0 = u.pm * BM + (u.hf == 2 ? HALF : 0) + wr * 64 + fr; const int nai = u.hf ? 1 : 2;
        const int gt = hg < 8 ? 0 : hg < 16 ? 1 : (hg >= 24 && hg < 32) ? 2 : (hg >= 32 && hg < 34) ? 3 : -1;
        const float qs = (hg < 8 || (hg >= 24 && hg < 32)) ? 0.125f : 1.f;
        const bool gate = hg >= 36;
        const LAS float* gsrc = tab + (gate ? 64 * (hg - 36) : 2048 + 64 * (gt < 0 ? 0 : gt)) + 8 * fq;
        const rsrc_t rD = mk_rsrc(gate ? (const void*)G8 : (const void*)QKV);
        const unsigned dst0 = gate ? (unsigned)(row0 * NG + 64 * (hg - 36) + 8 * fq) : (unsigned)(row0 * NQKV + 64 * hg + 8 * fq) * 2u;
        const int pitchb = gate ? NG : NQKV * 2;
#pragma unroll
        for (int ai = 0; ai < 2; ++ai) if (ai < nai) {
            float rr[4];
#pragma unroll
            for (int m = 0; m < 4; ++m) rr[m] = ss[row0 + ai * HALF + m * 16];
#pragma unroll
            for (int m = 0; m < 4; ++m) { const int ro = ai * HALF + m * 16; const float r = __builtin_amdgcn_rsqf(rr[m] * (1.f / DM) + EPS);
                f32x4 z[2][2]; float q = 0.f;
#pragma unroll
                for (int bj = 0; bj < 2; ++bj)
#pragma unroll
                    for (int n = 0; n < 2; ++n) { z[bj][n] = r * acc[ai][bj][m][n]; const f32x4 t = z[bj][n]; q += (t[0] * t[0] + t[1] * t[1]) + (t[2] * t[2] + t[3] * t[3]); }
                if (gate) {
#pragma unroll
                    for (int bj = 0; bj < 2; ++bj)
#pragma unroll
                        for (int n = 0; n < 2; ++n) { const f32x4 gv = *(const LAS f32x4*)(gsrc + 32 * bj + 4 * n);
#pragma unroll
                            for (int j = 0; j < 4; ++j) z[bj][n][j] = fast_sigmoid(z[bj][n][j] + gv[j]); }
                } else if (gt >= 0) {
                    q += __shfl_xor(q, 16); q += __shfl_xor(q, 32);
                    const float hn = __builtin_amdgcn_rsqf(q * (1.f / 64.f) + EPS) * qs;
#pragma unroll
                    for (int bj = 0; bj < 2; ++bj)
#pragma unroll
                        for (int n = 0; n < 2; ++n) { const f32x4 gv = *(const LAS f32x4*)(gsrc + 32 * bj + 4 * n); z[bj][n] = z[bj][n] * hn * gv; }
                }
                const unsigned dst = dst0 + (unsigned)(ro * pitchb);
                if (gate) {
#pragma unroll
                    for (int bj = 0; bj < 2; ++bj) { u32x2 w8; w8.x = pack_u8x4(z[bj][0]); w8.y = pack_u8x4(z[bj][1]); st8(rD, dst + 32u * bj, w8); }
                } else {
#pragma unroll
                for (int bj = 0; bj < 2; ++bj) { u32x4 w; w.x = cvt_pk_bf16(z[bj][0][0], z[bj][0][1]); w.y = cvt_pk_bf16(z[bj][0][2], z[bj][0][3]); w.z = cvt_pk_bf16(z[bj][1][0], z[bj][1][1]); w.w = cvt_pk_bf16(z[bj][1][2], z[bj][1][3]);
                    st16(rD, dst + 64u * bj, w); }
                }
                } }
    }
};
struct EpiBranch {
    static constexpr bool PROBE = (PROBE2_PHASE % 9 == 5), MULTI = false, PRELOAD = false, CHAIN = true;
    bf16* MRG; const unsigned char* G8;
    __device__ __forceinline__ void operator()(Acc& acc, const Unit& u, int wr, int wc, int fr, int fq) const {
        const int row0 = u.pm * BM + (u.hf == 2 ? HALF : 0) + wr * 64 + fr, col0 = u.pn * BM + wc * 64 + 8 * fq; const int nai = u.hf ? 1 : 2;
        const float GBMIN = 255.f * 9.5367431640625e-07f;
        if (u.sel != 0) {
            u32x2 gb[2][4][2];
#pragma unroll
            for (int ai = 0; ai < 2; ++ai) if (ai < nai)
#pragma unroll
                for (int m = 0; m < 4; ++m)
#pragma unroll
                    for (int bj = 0; bj < 2; ++bj) gb[ai][m][bj] = *(const u32x2*)(G8 + (size_t)(row0 + ai * HALF + m * 16) * NG + DM + col0 + 32 * bj);
#pragma unroll
            for (int ai = 0; ai < 2; ++ai) if (ai < nai)
#pragma unroll
                for (int m = 0; m < 4; ++m)
#pragma unroll
                    for (int bj = 0; bj < 2; ++bj) { const size_t o = (size_t)(row0 + ai * HALF + m * 16) * DM + col0 + 32 * bj;
                        float v[8];
#pragma unroll
                        for (int e = 0; e < 8; ++e) v[e] = (fmaxf(u8f(gb[ai][m][bj], e), GBMIN) * (1.f / 255.f)) * acc[ai][bj][m][e >> 2][e & 3];
                        u32x4 w; w.x = cvt_pk_bf16(v[0], v[1]); w.y = cvt_pk_bf16(v[2], v[3]); w.z = cvt_pk_bf16(v[4], v[5]); w.w = cvt_pk_bf16(v[6], v[7]);
                        *(u32x4*)(MRG + o) = w;
                        __builtin_amdgcn_sched_barrier(0); }
        } else {
            u32x2 ga[2][4][2], gb[2][4][2];
#pragma unroll
            for (int ai = 0; ai < 2; ++ai) if (ai < nai)
#pragma unroll
                for (int m = 0; m < 4; ++m)
#pragma unroll
                    for (int bj = 0; bj < 2; ++bj) { const unsigned char* gp = G8 + (size_t)(row0 + ai * HALF + m * 16) * NG + col0 + 32 * bj;
                        ga[ai][m][bj] = *(const u32x2*)gp; gb[ai][m][bj] = *(const u32x2*)(gp + DM); }
#pragma unroll
            for (int ai = 0; ai < 2; ++ai) if (ai < nai)
#pragma unroll
                for (int m = 0; m < 4; ++m)
#pragma unroll
                    for (int bj = 0; bj < 2; ++bj) {
#pragma unroll
                        for (int e = 0; e < 8; ++e) acc[ai][bj][m][e >> 2][e & 3] *= u8f(ga[ai][m][bj], e) * __builtin_amdgcn_rcpf(fmaxf(u8f(gb[ai][m][bj], e), GBMIN));
                        __builtin_amdgcn_sched_barrier(0); }
        }
    }
};
}

namespace pg8 {
template <class Epi, class Sched>
__device__ __forceinline__ void gemm_ring4(LAS unsigned char* lds, const Gemm g, const Sched& S, const Epi& E) {
    int tid_ = threadIdx.x; asm volatile("" : "+v"(tid_));
    const int tid = tid_, wid = __builtin_amdgcn_readfirstlane(tid >> 6), lane = tid & 63, wr = wid >> 2, wc = wid & 3, fr = lane & 15, fq = lane >> 4;
    const int K = g.K, ns = K / 32;
    unsigned voff0;
    { const int p = lane * 16, ob = p ^ (((p >> 9) & 1) << 5), R = ob >> 6, C = (ob & 63) >> 1; voff0 = (unsigned)((32 * wid + R) * K + C) * 2u; }
    const size_t pstep = (size_t)16 * K * 2;
    const size_t hstep = (size_t)HALF * K * 2, tstep = 2 * hstep;
    const unsigned ldsw = (unsigned)wid * 2048u;
    const int loff = (fr * 64 + fq * 16) ^ ((((fr * 64 + fq * 16) >> 9) & 1) << 5);
    const int a_base = 4 * wr * 1024 + loff, b_base = 16384 + 2 * wc * 1024 + loff;
#define R4_STAGE(bufoff, gA, gB, khalf) do { _Pragma("unroll") for (int _i = 0; _i < 2; ++_i) { \
        __builtin_amdgcn_global_load_lds((const unsigned*)((const char*)(gA) + (((khalf) && wid >= 4) ? (size_t)0 : _i * pstep + voff0)), (LAS unsigned*)(lds + (bufoff) + ldsw + _i * 1024), 16, 0, 0); \
        __builtin_amdgcn_global_load_lds((const unsigned*)((const char*)(gB) + _i * pstep + voff0), (LAS unsigned*)(lds + (bufoff) + 16384 + ldsw + _i * 1024), 16, 0, 0); } } while (0)
#define R4_READ(FA, FB, bufoff, half) do { _Pragma("unroll") for (int m = 0; m < 4; ++m) { FA[0][m] = *(const LAS bf16x8*)(lds + (bufoff) + a_base + m * 1024); FA[1][m] = *(const LAS bf16x8*)(lds + (bufoff) + a_base + 8192 + m * 1024); } \
        _Pragma("unroll") for (int bj = 0; bj < 2; ++bj) _Pragma("unroll") for (int n = 0; n < 2; ++n) FB[bj][n] = *(const LAS bf16x8*)(lds + (bufoff) + b_base + bj * 8192 + n * 1024); } while (0)
#define R4_MMA(FA, FB, half) do { __builtin_amdgcn_s_setprio(1); _Pragma("unroll") for (int ai = 0; ai < 2; ++ai) if (ai == 0 || !(half)) { _Pragma("unroll") for (int bj = 0; bj < 2; ++bj) _Pragma("unroll") for (int m = 0; m < 4; ++m) _Pragma("unroll") for (int n = 0; n < 2; ++n) \
        acc[ai][bj][m][n] = __builtin_amdgcn_mfma_f32_16x16x32_bf16(FB[bj][n], FA[ai][m], acc[ai][bj][m][n], 0, 0, 0); } __builtin_amdgcn_s_setprio(0); } while (0)
    Unit cur, pun; int ui = 0, pui = 0;
    if (!S.next(0, cur)) return;
    pun = cur;
    const char* pA = (const char*)(pun.sel ? g.A2 : g.A) + (size_t)pun.pm * tstep + (pun.hf == 2 ? hstep : 0); const char* pB = (const char*)(pun.sel ? g.Bt2 : g.Bt) + (size_t)pun.pn * tstep;
    int pk = 0; bool phalf = pun.hf != 0;
#define R4_ISSUE(bufoff) do { R4_STAGE(bufoff, pA + (size_t)pk * 64, pB + (size_t)pk * 64, phalf); if (++pk == ns) { pk = 0; Unit nx_; if (S.next(pui + 1, nx_)) { ++pui; pun = nx_; \
        pA = (const char*)(pun.sel ? g.A2 : g.A) + (size_t)pun.pm * tstep + (pun.hf == 2 ? hstep : 0); pB = (const char*)(pun.sel ? g.Bt2 : g.Bt) + (size_t)pun.pn * tstep; phalf = pun.hf != 0; } } } while (0)
    f32x4 acc[2][2][4][2];
#pragma unroll
    for (int a = 0; a < 2; ++a)
#pragma unroll
        for (int b = 0; b < 2; ++b)
#pragma unroll
            for (int m = 0; m < 4; ++m)
#pragma unroll
                for (int n = 0; n < 2; ++n) acc[a][b][m][n] = (f32x4){0.f, 0.f, 0.f, 0.f};
    bf16x8 FA[2][4], FB[2][2];
    R4_ISSUE(0); R4_ISSUE(32768); R4_ISSUE(65536);
    asm volatile("s_waitcnt vmcnt(8)" ::: "memory"); __builtin_amdgcn_s_barrier();
    if (wr == 1) __builtin_amdgcn_s_barrier();
    unsigned sb = 0;
    bool chalf = cur.hf != 0;
    for (;;) {
        for (int ks = 0; ks < ns; ++ks) {
            R4_READ(FA, FB, sb, chalf); __builtin_amdgcn_sched_barrier(0); R4_ISSUE((sb + 98304u) & 131071u); sb = (sb + 32768u) & 131071u;
            asm volatile("s_waitcnt vmcnt(8)" ::: "memory"); asm volatile("s_waitcnt lgkmcnt(0)" ::: "memory");
            __builtin_amdgcn_s_barrier(); __builtin_amdgcn_sched_barrier(0);
            R4_MMA(FA, FB, chalf);
            __builtin_amdgcn_s_barrier(); __builtin_amdgcn_sched_barrier(0);
        }
        if (wr == 0) __builtin_amdgcn_s_barrier();
        E(acc, cur, wr, wc, fr, fq);
        Unit nxt; if (!S.next(ui + 1, nxt)) break;
#pragma unroll
        for (int a = 0; a < 2; ++a)
#pragma unroll
            for (int b = 0; b < 2; ++b)
#pragma unroll
                for (int m = 0; m < 4; ++m)
#pragma unroll
                    for (int n = 0; n < 2; ++n) acc[a][b][m][n] = (f32x4){0.f, 0.f, 0.f, 0.f};
        cur = nxt; ++ui; chalf = cur.hf != 0;
        if (wr == 1) __builtin_amdgcn_s_barrier();
    }
    asm volatile("s_waitcnt vmcnt(0) lgkmcnt(0)" ::: "memory");
    __builtin_amdgcn_s_barrier();
#undef R4_STAGE
#undef R4_READ
#undef R4_MMA
#undef R4_ISSUE
}
}

#define XB_TMO      128
#define XB_XCNT(j)  (256  + 64 * (j))
#define XB_XSUB(j)  (1280 + 64 * (j))
#define XB_XGEN(j)  (2304 + 64 * (j))
#define XB_TOP      3328
#define XB_TOPGEN   3392
#define XCD_BAR_WORDS 3456
#define XB_SPIN_CAP (1u << 18)
__device__ __forceinline__ unsigned xb_ld(unsigned* p)              { return __hip_atomic_load(p, __ATOMIC_RELAXED, __HIP_MEMORY_SCOPE_AGENT); }
__device__ __forceinline__ unsigned xb_add(unsigned* p, unsigned v) { return __hip_atomic_fetch_add(p, v, __ATOMIC_RELAXED, __HIP_MEMORY_SCOPE_AGENT); }
__device__ __forceinline__ unsigned xb_xcc_id() { return (unsigned)__builtin_amdgcn_s_getreg((3 << 11) | 20) & 0xFu; }
#define XB_SPIN(cond, bar) do { unsigned _sp = 0; while (cond) { __builtin_amdgcn_s_sleep(1); \
    if ((++_sp & 255u) == 0u) { if (xb_ld(&(bar)[XB_TMO])) break; if (_sp > XB_SPIN_CAP) { atomicAdd(&(bar)[XB_TMO], 1u); break; } } } } while (0)
struct XcdBarrier { unsigned* bar; unsigned x; volatile LAS unsigned* st; };
__device__ __forceinline__ XcdBarrier xcd_barrier_post(unsigned* bar, volatile LAS unsigned* st) {
    XcdBarrier b; b.bar = bar; b.x = xb_xcc_id(); b.st = st;
    if (threadIdx.x == 0) (void)xb_add(&bar[XB_XCNT(b.x)], 1u);
    return b;
}
__device__ __forceinline__ void xcd_barrier_complete(unsigned* bar, unsigned x, unsigned& nloc, unsigned& nx) {
    const unsigned G = gridDim.x * gridDim.y * gridDim.z;
    unsigned sum, cnt, mine, sp = 0u;
    for (;;) {
        sum = 0u; cnt = 0u; mine = 0u;
#pragma unroll
        for (unsigned j = 0; j < 16; ++j) { const unsigned c = xb_ld(&bar[XB_XCNT(j)]); sum += c; cnt += (c > 0u) ? 1u : 0u; mine = (j == x) ? c : mine; }
        if (sum == G) break;
        __builtin_amdgcn_s_sleep(1);
        if ((++sp & 255u) == 0u) { if (xb_ld(&bar[XB_TMO])) break; if (sp > XB_SPIN_CAP) { atomicAdd(&bar[XB_TMO], 1u); break; } }
    }
    nloc = mine > 0u ? mine : 1u; nx = cnt > 0u ? cnt : 1u;
}
__device__ __forceinline__ void xcd_barrier(const XcdBarrier& b) {
    asm volatile("s_waitcnt vmcnt(0)" ::: "memory");
    __syncthreads();
    if (threadIdx.x == 0) {
        unsigned* bar = b.bar;
        __builtin_amdgcn_s_waitcnt(0);
        unsigned nloc = b.st[0], nx = b.st[1];
        if (nloc == 0u) { xcd_barrier_complete(bar, b.x, nloc, nx); b.st[0] = nloc; b.st[1] = nx; }
        const unsigned old = xb_add(&bar[XB_XSUB(b.x)], 1u);
        const unsigned gen = old / nloc;
        if (old + 1u == (gen + 1u) * nloc) {
            __builtin_amdgcn_fence(__ATOMIC_RELEASE, "agent");
            asm volatile("s_waitcnt vmcnt(0)" ::: "memory");
            const unsigned og = xb_add(&bar[XB_TOP], 1u);
            const unsigned tg = og / nx;
            if (og + 1u == (tg + 1u) * nx) xb_add(&bar[XB_TOPGEN], 1u);
            else XB_SPIN(xb_ld(&bar[XB_TOPGEN]) == tg, bar);
            __builtin_amdgcn_fence(__ATOMIC_ACQUIRE, "agent");
            xb_add(&bar[XB_XGEN(b.x)], 1u);
            asm volatile("s_waitcnt vmcnt(0)" ::: "memory");
        } else {
            XB_SPIN(xb_ld(&bar[XB_XGEN(b.x)]) == gen, bar);
            __builtin_amdgcn_fence(__ATOMIC_ACQUIRE, "agent");
            asm volatile("s_waitcnt vmcnt(0)" ::: "memory");
        }
    }
    __syncthreads();
}

constexpr int CW_GRP = 65536;
struct GrpBarrier { unsigned* cnt; unsigned* gen; unsigned* tmo; bool cheap; };
struct NoHook { __device__ __forceinline__ void operator()() const {} };
template <class Hook = NoHook>
__device__ __forceinline__ void grp_barrier(const GrpBarrier& b, unsigned want, const Hook& hook = Hook()) {
    asm volatile("s_waitcnt vmcnt(0)" ::: "memory");
    __syncthreads();
    if (threadIdx.x == 0) {
        __builtin_amdgcn_s_waitcnt(0);
        if (!b.cheap) { __builtin_amdgcn_fence(__ATOMIC_RELEASE, "agent"); asm volatile("s_waitcnt vmcnt(0)" ::: "memory"); }
        (void)xb_add(b.cnt, 1u);
    }
    hook();
    if (threadIdx.x == 0) {
        if (b.cheap) __builtin_amdgcn_fence(__ATOMIC_ACQUIRE, "agent");
        XB_SPIN(xb_ld(b.cnt) < 32u * want, b.tmo - XB_TMO);
        if (!b.cheap) __builtin_amdgcn_fence(__ATOMIC_ACQUIRE, "agent");
        asm volatile("s_waitcnt vmcnt(0)" ::: "memory");
    }
    __syncthreads();
}

__device__ __forceinline__ unsigned pk2(float lo, float hi) { return f2bf(lo) | (f2bf(hi) << 16); }
__device__ __forceinline__ int perm32(int rho) { const int n = rho >> 4, i = rho & 15; return 8 * (i >> 2) + 4 * n + (i & 3); }
struct PrepItem { const float* src; const float* gn; bf16* dst; int ldw, K; };
__device__ __forceinline__ PrepItem prep_head(const float* W, int K, int N, const float* gn, bf16* WT, int it) {
    const int nsg = N / 32, kb = it / nsg, sg = it % nsg, pn = sg >> 3, bj = (sg >> 2) & 1, wc = sg & 3;
    PrepItem d; d.src = W + (size_t)(64 * kb) * N + 256 * pn + 64 * wc + 32 * bj; d.gn = gn ? gn + 64 * kb : nullptr; d.dst = WT + (size_t)(32 * sg) * K + 64 * kb; d.ldw = N; d.K = K; return d;
}
__device__ __forceinline__ PrepItem prep_gateup(const float* Wg, const float* Wu, const float* gn, bf16* WT, int it) {
    const int nsg = 2 * FF / 32, kb = it / nsg, sg = it % nsg, pn = sg >> 3, bj = (sg >> 2) & 1, wc = sg & 3;
    PrepItem d; d.src = (bj ? Wu : Wg) + (size_t)(64 * kb) * FF + 128 * pn + 32 * wc; d.gn = gn + 64 * kb; d.dst = WT + (size_t)(32 * sg) * DM + 64 * kb; d.ldw = FF; d.K = DM; return d;
}
__device__ __forceinline__ void prep_load(const PrepItem& d, f32x4 (&v)[8], int lane) {
#pragma unroll
    for (int i = 0; i < 8; ++i) v[i] = __builtin_nontemporal_load((const f32x4*)(d.src + (size_t)(8 * i + (lane >> 3)) * d.ldw + 4 * (lane & 7)));
}
__device__ __forceinline__ void prep_store(const PrepItem& d, const f32x4 (&v)[8], LAS float* scr, int lane) {
#pragma unroll
    for (int i = 0; i < 8; ++i)
#pragma unroll
        for (int j = 0; j < 4; ++j) scr[(8 * i + (lane >> 3)) * 33 + 4 * (lane & 7) + j] = v[i][j];
    const int c = lane & 7;
    f32x4 g0 = (f32x4){1.f, 1.f, 1.f, 1.f}, g1 = g0; if (d.gn) { g0 = *(const f32x4*)(d.gn + 8 * c); g1 = *(const f32x4*)(d.gn + 8 * c + 4); }
    asm volatile("s_waitcnt lgkmcnt(0)" ::: "memory");
#pragma unroll
    for (int j = 0; j < 4; ++j) { const int rr = (lane >> 3) + 8 * j; const LAS float* s = scr + (8 * c) * 33 + perm32(rr);
        u32x4 o; o.x = pk2(s[0 * 33] * g0[0], s[1 * 33] * g0[1]); o.y = pk2(s[2 * 33] * g0[2], s[3 * 33] * g0[3]); o.z = pk2(s[4 * 33] * g1[0], s[5 * 33] * g1[1]); o.w = pk2(s[6 * 33] * g1[2], s[7 * 33] * g1[3]);
        *(u32x4*)(d.dst + (size_t)rr * d.K + 8 * c) = o; }
    asm volatile("s_waitcnt lgkmcnt(0)" ::: "memory");
}
constexpr int I_1C = (DM / 64) * (2 * FF / 32), I_1D = (FF / 64) * (DM / 32), I_IN = (DM / 64) * (INW / 32), I_P = (512 / 64) * (DM / 32), I_O = (DM / 64) * (DM / 32);
constexpr int NITEMS = 2 * I_1C + 2 * I_1D + I_IN + 2 * I_P + I_O;
__device__ __forceinline__ PrepItem prep_get(const __attribute__((address_space(4))) Inputs& I, int l, unsigned char* WB, unsigned char* W2D, int r) {
    if (r < I_1C) return prep_gateup(I.ffn1_wg + (size_t)l * DM * FF, I.ffn1_wu + (size_t)l * DM * FF, I.ffn1_norm + l * DM, (bf16*)(WB + WO_1C), r); r -= I_1C;
    if (r < I_1C) return prep_gateup(I.ffn2_wg + (size_t)l * DM * FF, I.ffn2_wu + (size_t)l * DM * FF, I.ffn2_norm + l * DM, (bf16*)(WB + WO_2C), r); r -= I_1C;
    if (r < I_1D) return prep_head(I.ffn1_wd + (size_t)l * FF * DM, FF, DM, nullptr, (bf16*)(WB + WO_1D), r); r -= I_1D;
    if (r < I_1D) return prep_head(I.ffn2_wd + (size_t)l * FF * DM, FF, DM, nullptr, (bf16*)W2D, r); r -= I_1D;
    if (r < I_IN) return prep_head(I.w_in + (size_t)l * DM * INW, DM, INW, I.mix_norm + l * DM, (bf16*)(WB + WO_IN), r); r -= I_IN;
    if (r < I_P) return prep_head(I.w_br_na + (size_t)l * 512 * DM, 512, DM, nullptr, (bf16*)(WB + WO_PA), r); r -= I_P;
    if (r < I_P) return prep_head(I.w_br_sw + (size_t)l * 512 * DM, 512, DM, nullptr, (bf16*)(WB + WO_PB), r); r -= I_P;
    return prep_head(I.w_out + (size_t)l * DM * DM, DM, DM, nullptr, (bf16*)(WB + WO_OUT), r);
}
__device__ __forceinline__ float wave_sum64(float v) {
#pragma unroll
    for (int o = 1; o < 64; o <<= 1) v += __shfl_xor(v, o);
    return v;
}

__device__ __forceinline__ bf16x8 tr_pair(const LAS unsigned char* p0, const LAS unsigned char* p1) {
    typedef short v4i16 __attribute__((ext_vector_type(4)));
    const v4i16 lo = __builtin_amdgcn_ds_read_tr16_b64_v4i16((LAS v4i16*)p0), hi = __builtin_amdgcn_ds_read_tr16_b64_v4i16((LAS v4i16*)p1);
    return (bf16x8){lo[0], lo[1], lo[2], lo[3], hi[0], hi[1], hi[2], hi[3]};
}
__device__ __forceinline__ int fK(int key) { return ((key >> 1) & 1) | (((key >> 3) & 3) << 1); }
__device__ __forceinline__ int fV(int key) { return ((key >> 1) & 1) | (((key >> 3) & 1) << 1); }

template <int NS> __device__ __forceinline__ float softmax_pack(f32x4 (&S)[NS][2], bf16x8 (&pk)[NS], bool has_sink, float sink) {
    float mx = has_sink ? sink : -3.0e38f;
#pragma unroll
    for (int s = 0; s < NS; ++s)
#pragma unroll
        for (int hb = 0; hb < 2; ++hb) mx = fmaxf(mx, fmaxf(fmaxf(S[s][hb][0], S[s][hb][1]), fmaxf(S[s][hb][2], S[s][hb][3])));
    mx = fmaxf(mx, __shfl_xor(mx, 16)); mx = fmaxf(mx, __shfl_xor(mx, 32));
    const float mb = mx * 1.4426950408889634f; float l = 0.f;
#pragma unroll
    for (int s = 0; s < NS; ++s) {
#pragma unroll
        for (int hb = 0; hb < 2; ++hb)
#pragma unroll
            for (int j = 0; j < 4; ++j) { const float e = __builtin_amdgcn_exp2f(S[s][hb][j] * 1.4426950408889634f - mb); S[s][hb][j] = e; l += e; }
        u32x4 w; w.x = cvt_pk_bf16(S[s][0][0], S[s][0][1]); w.y = cvt_pk_bf16(S[s][0][2], S[s][0][3]); w.z = cvt_pk_bf16(S[s][1][0], S[s][1][1]); w.w = cvt_pk_bf16(S[s][1][2], S[s][1][3]);
        pk[s] = __builtin_bit_cast(bf16x8, w);
    }
    l += __shfl_xor(l, 16); l += __shfl_xor(l, 32);
    if (has_sink) l += __builtin_amdgcn_exp2f(sink * 1.4426950408889634f - mb);
    return 1.f / l;
}

constexpr int SW_K_OFF = 0, SW_V_OFF = 49152, SW_LUT_OFF = 98304, SW_LUT_LD = 512;
__device__ __forceinline__ void swa_unit(LAS unsigned char* lds, int b, int g, int nb, const bf16* QKV, const float* t5, const float* sink, bf16* OSW) {
    int tid_ = threadIdx.x; asm volatile("" : "+v"(tid_));
    const int tid = tid_, lane = tid & 63, wid = __builtin_amdgcn_readfirstlane(tid >> 6), fr = lane & 15, fq = lane >> 4;
#pragma unroll
    for (int i = 0; i < 6; ++i) { const int cid = tid + NTHREADS * i, key = cid >> 3, c = cid & 7, kp = 128 * (nb - 1) + key; const bool ok = kp >= 0 && kp < SEQ;
        const bf16* src = QKV + (size_t)(b * SEQ + (ok ? kp : 0)) * NQKV + 64 * g + 8 * c;
        u32x4 kv = (u32x4){0u, 0u, 0u, 0u}, vv = kv; if (ok) { kv = *(const u32x4*)(src + 2048); vv = *(const u32x4*)(src + 2176); }
        *(LAS u32x4*)(lds + SW_K_OFF + key * 128 + ((c ^ fK(key)) << 4)) = kv;
        *(LAS u32x4*)(lds + SW_V_OFF + key * 128 + (((c >> 1) ^ fV(key)) << 5) + ((c & 1) << 4)) = vv; }
    for (int idx = tid; idx < 5 * 512; idx += NTHREADS) { const int hh = idx >> 9, rel = (idx & 511) - 255;
        ((LAS float*)(lds + SW_LUT_OFF))[idx] = (hh < 4 && rel >= -128 && rel <= 128) ? t5[slow::t5_bucket(rel) * 8 + 4 * g + hh] : NEGV; }
    __syncthreads();
    const int fKl = ((fr >> 1) & 1) | ((fr >> 2) << 1);
    const LAS unsigned char* kb0 = lds + SW_K_OFF + (8 * (fr >> 2) + (fr & 3)) * 128 + ((fq ^ fKl) << 4);
    const LAS unsigned char* kb1 = lds + SW_K_OFF + (8 * (fr >> 2) + (fr & 3)) * 128 + (((4 + fq) ^ fKl) << 4);
    const int q4 = (lane & 15) >> 2, p4 = lane & 3, fVl = ((q4 >> 1) & 1) | ((fq & 1) << 1);
    const LAS unsigned char* vb = lds + SW_V_OFF + (8 * fq + q4) * 128 + p4 * 8;
    const int relbase = 8 * fq - 128 - 16 * wid - fr + 255;
    const bool first_bad = (nb == 0), last_bad = (nb == SEQ / 128 - 1);
    const size_t tokq = (size_t)b * SEQ + 128 * nb + 16 * wid + fr; const int s0 = wid >> 1;
    const bf16* qsrc = QKV + tokq * NQKV + 1536 + 256 * g + 8 * fq;
    bf16x8 q0n = *(const bf16x8*)qsrc, q1n = *(const bf16x8*)(qsrc + 32);
    for (int hh = 0; hh < 4; ++hh) {
        const int h = 4 * g + hh;
        const bf16x8 q0 = q0n, q1 = q1n;
        if (hh < 3) { q0n = *(const bf16x8*)(qsrc + 64 * (hh + 1)); q1n = *(const bf16x8*)(qsrc + 64 * (hh + 1) + 32); }
        __builtin_amdgcn_sched_barrier(0);
        const LAS float* lut = (const LAS float*)(lds + SW_LUT_OFF) + hh * SW_LUT_LD + relbase;
        f32x4 S[9][2]; bf16x8 pk[9];
        const LAS unsigned char* kb0s = kb0 + s0 * 4096; const LAS unsigned char* kb1s = kb1 + s0 * 4096; const LAS float* luts = lut + 32 * s0;
#pragma unroll
        for (int s = 0; s < 9; ++s) {
            const bool bad = (s0 + s < 4 && first_bad) || (s0 + s >= 8 && last_bad);
            const LAS float* lp = luts + 32 * s + (bad ? (4 - hh) * SW_LUT_LD : 0);
#pragma unroll
            for (int hb = 0; hb < 2; ++hb) { const bf16x8 k0 = *(const LAS bf16x8*)(kb0s + s * 4096 + hb * 512), k1 = *(const LAS bf16x8*)(kb1s + s * 4096 + hb * 512);
                f32x4 a = (f32x4){lp[4 * hb], lp[4 * hb + 1], lp[4 * hb + 2], lp[4 * hb + 3]};
                a = __builtin_amdgcn_mfma_f32_16x16x32_bf16(k0, q0, a, 0, 0, 0); a = __builtin_amdgcn_mfma_f32_16x16x32_bf16(k1, q1, a, 0, 0, 0);
                S[s][hb] = a; }
            if ((s & 3) == 3) asm volatile("" ::: "memory"); }
        const float rl = softmax_pack<9>(S, pk, true, sink[h]);
        f32x4 O[4];
#pragma unroll
        for (int db = 0; db < 4; ++db) O[db] = (f32x4){0.f, 0.f, 0.f, 0.f};
        const LAS unsigned char* vbs = vb + s0 * 4096;
#pragma unroll
        for (int s = 0; s < 9; ++s) {
#pragma unroll
            for (int db = 0; db < 4; ++db) { const LAS unsigned char* p = vbs + s * 4096 + ((db ^ fVl) << 5); O[db] = __builtin_amdgcn_mfma_f32_16x16x32_bf16(tr_pair(p, p + 512), pk[s], O[db], 0, 0, 0); }
            if ((s & 3) == 3) asm volatile("" ::: "memory"); }
        bf16* dst = OSW + tokq * 512 + 64 * h + 4 * fq;
#pragma unroll
        for (int db = 0; db < 4; ++db) { u32x2 w; w.x = cvt_pk_bf16(O[db][0] * rl, O[db][1] * rl); w.y = cvt_pk_bf16(O[db][2] * rl, O[db][3] * rl); *(u32x2*)(dst + 16 * db) = w; }
    }
    __syncthreads();
}

constexpr int NA_V_OFF = 0, NA_TAB_OFF = 122880;
__device__ __forceinline__ int na_rowstart(int r) { int rs = r - 4; return rs < 0 ? 0 : (rs > ROWS - 8 ? ROWS - 8 : rs); }
__device__ __forceinline__ void na_unit(LAS unsigned char* lds, int b, int h, int rq, const bf16* QKV, const float* rpb, bf16* ONA) {
    int tid_ = threadIdx.x; asm volatile("" : "+v"(tid_));
    const int tid = tid_, lane = tid & 63, wid = __builtin_amdgcn_readfirstlane(tid >> 6), fr = lane & 15, fq = lane >> 4;
    const int kr_lo = na_rowstart(8 * rq), kr_hi = na_rowstart(8 * rq + 7) + 7;
    {
        const int nrows = kr_hi - kr_lo + 1, kloc = tid >> 3, c = tid & 7;
        const bf16* src = QKV + (size_t)(b * SEQ + kr_lo * GRID_W + kloc) * NQKV + 1024 + 64 * h + 8 * c;
        LAS unsigned char* dstp = lds + NA_V_OFF + kloc * 128 + (((c >> 1) ^ fV(kloc)) << 5) + ((c & 1) << 4);
        u32x4 vv[15];
#pragma unroll
        for (int r = 0; r < 15; ++r) if (r < nrows) vv[r] = *(const u32x4*)(src + (size_t)r * GRID_W * NQKV);
#pragma unroll
        for (int r = 0; r < 15; ++r) if (r < nrows) *(LAS u32x4*)(dstp + r * (GRID_W * 128)) = vv[r];
    }
    for (int idx = tid; idx < 15 * 32; idx += NTHREADS) { const int rr_ = idx >> 5, cc_ = idx & 31; ((LAS float*)(lds + NA_TAB_OFF))[idx] = cc_ < 31 ? rpb[h * 465 + rr_ * 31 + cc_] : NEGV; }
    __syncthreads();
    const LAS float* tab = (const LAS float*)(lds + NA_TAB_OFF);
    const int q4 = (lane & 15) >> 2, p4 = lane & 3;
    bf16x8 kf[8][2][2], q0, q1;
#define NA_LOADKQ(pp, slo, shi) do { const int r_ = 8 * rq + ((pp) >> 2), cb_ = (pp) & 3, rs_ = na_rowstart(r_); int kcs_ = 16 * cb_ - 8; kcs_ = kcs_ < 0 ? 0 : (kcs_ > 32 ? 32 : kcs_); \
        const size_t tq_ = (size_t)b * SEQ + r_ * GRID_W + 16 * cb_ + fr; \
        if ((slo) == 0) { q0 = *(const bf16x8*)(QKV + tq_ * NQKV + 64 * h + 8 * fq); q1 = *(const bf16x8*)(QKV + tq_ * NQKV + 64 * h + 32 + 8 * fq); } \
        const bf16* kb_ = QKV + ((size_t)b * SEQ + rs_ * GRID_W + kcs_ + 8 * (fr >> 2) + (fr & 3)) * NQKV + 512 + 64 * h + 8 * fq;     \
        _Pragma("unroll") for (int s_ = (slo); s_ < (shi); ++s_) _Pragma("unroll") for (int hb_ = 0; hb_ < 2; ++hb_) { const bf16* kp_ = kb_ + (size_t)(s_ * GRID_W + 4 * hb_) * NQKV; kf[s_][hb_][0] = *(const bf16x8*)kp_; kf[s_][hb_][1] = *(const bf16x8*)(kp_ + 32); } } while (0)
    for (int i = 0; i < 4; ++i) {
        const int p = wid + 8 * i, r = 8 * rq + (p >> 2), cb = p & 3, rs = na_rowstart(r);
        int kcs = 16 * cb - 8; kcs = kcs < 0 ? 0 : (kcs > 32 ? 32 : kcs);
        const int qcol = 16 * cb + fr; int qcs = qcol - 8; qcs = qcs < 0 ? 0 : (qcs > 48 ? 48 : qcs);
        const size_t tokq = (size_t)b * SEQ + r * GRID_W + qcol;
        f32x4 S[8][2]; bf16x8 pk[8];
        int cidx[2][4];
#pragma unroll
        for (int hb = 0; hb < 2; ++hb)
#pragma unroll
            for (int j = 0; j < 4; ++j) { const int kcol = kcs + 8 * fq + 4 * hb + j; const bool ok = kcol >= qcs && kcol < qcs + 16; cidx[hb][j] = ok ? kcol - qcol + 15 : 31; }
        const LAS float* trow = tab + (rs - r + 7) * 32;
        NA_LOADKQ(p, 0, 8); __builtin_amdgcn_sched_barrier(0);
#pragma unroll
        for (int s = 0; s < 8; ++s) {
#pragma unroll
            for (int hb = 0; hb < 2; ++hb) {
                f32x4 a = (f32x4){0.f, 0.f, 0.f, 0.f}; a = __builtin_amdgcn_mfma_f32_16x16x32_bf16(kf[s][hb][0], q0, a, 0, 0, 0); a = __builtin_amdgcn_mfma_f32_16x16x32_bf16(kf[s][hb][1], q1, a, 0, 0, 0);
#pragma unroll
                for (int j = 0; j < 4; ++j) a[j] += trow[s * 32 + cidx[hb][j]];
                S[s][hb] = a; }
            if ((s & 3) == 3) asm volatile("" ::: "memory"); }
        const float rl = softmax_pack<8>(S, pk, false, 0.f);
        const int fVl = ((q4 >> 1) & 1) | ((((kcs >> 3) + fq) & 1) << 1);
        const LAS unsigned char* vb = lds + NA_V_OFF + ((rs - kr_lo) * GRID_W + kcs + 8 * fq + q4) * 128 + p4 * 8;
        f32x4 O[4];
#pragma unroll
        for (int db = 0; db < 4; ++db) O[db] = (f32x4){0.f, 0.f, 0.f, 0.f};
#pragma unroll
        for (int s = 0; s < 8; ++s) {
#pragma unroll
            for (int db = 0; db < 4; ++db) { const LAS unsigned char* pp = vb + s * (GRID_W * 128) + ((db ^ fVl) << 5); O[db] = __builtin_amdgcn_mfma_f32_16x16x32_bf16(tr_pair(pp, pp + 512), pk[s], O[db], 0, 0, 0); }
            if ((s & 3) == 3) asm volatile("" ::: "memory"); }
        bf16* dst = ONA + tokq * 512 + 64 * h + 4 * fq;
#pragma unroll
        for (int db = 0; db < 4; ++db) { u32x2 w; w.x = cvt_pk_bf16(O[db][0] * rl, O[db][1] * rl); w.y = cvt_pk_bf16(O[db][2] * rl, O[db][3] * rl); *(u32x2*)(dst + 16 * db) = w; }
    }
    __syncthreads();
}

constexpr int NA2_K_OFF = 0, NA2_V_OFF = 65536, NA2_TAB_OFF = RING_BYTES + 1024;
__device__ __forceinline__ int na_newlo(int rq) { return rq == 0 ? 0 : na_rowstart(8 * (rq - 1) + 7) + 8; }
__device__ __forceinline__ int na_newn(int rq) { return na_rowstart(8 * rq + 7) + 8 - na_newlo(rq); }
__device__ __forceinline__ void na_quad(LAS unsigned char* lds, int b, int h, int cb, const bf16* QKV, const float* rpb, bf16* ONA) {
    int tid_ = threadIdx.x; asm volatile("" : "+v"(tid_));
    const int tid = tid_, lane = tid & 63, wid = __builtin_amdgcn_readfirstlane(tid >> 6), fr = lane & 15, fq = lane >> 4;
    int kcs = 16 * cb - 8; kcs = kcs < 0 ? 0 : (kcs > 32 ? 32 : kcs);
    const int isv = tid >> 8, t8 = tid & 255, kc = t8 >> 3, c = t8 & 7;
    const bf16* src0 = QKV + (size_t)(b * SEQ + kcs + kc) * NQKV + (isv ? 1024 : 512) + 64 * h + 8 * c;
    LAS unsigned char* dstp = isv ? lds + NA2_V_OFF + kc * 128 + (((c >> 1) ^ fV(kc)) << 5) + ((c & 1) << 4) : lds + NA2_K_OFF + kc * 128 + ((c ^ fK(kc)) << 4);
    u32x4 vv[11];
#define NA2_LOAD(rq_) do { const int lo_ = na_newlo(rq_), n_ = na_newn(rq_); \
        _Pragma("unroll") for (int r_ = 0; r_ < 11; ++r_) if (r_ < n_) vv[r_] = *(const u32x4*)(src0 + (size_t)(lo_ + r_) * GRID_W * NQKV); } while (0)
    NA2_LOAD(0);
    bf16x8 q0n, q1n; { const bf16* qn = QKV + ((size_t)b * SEQ + wid * GRID_W + 16 * cb + (lane & 15)) * NQKV + 64 * h + 8 * (lane >> 4); q0n = *(const bf16x8*)qn; q1n = *(const bf16x8*)(qn + 32); }
    for (int idx = tid; idx < 15 * 32; idx += NTHREADS) { const int rr_ = idx >> 5, cc_ = idx & 31; ((LAS float*)(lds + NA2_TAB_OFF))[idx] = cc_ < 31 ? rpb[h * 465 + rr_ * 31 + cc_] : NEGV; }
    const LAS float* tab = (const LAS float*)(lds + NA2_TAB_OFF);
    const int qcol = 16 * cb + fr; int qcs = qcol - 8; qcs = qcs < 0 ? 0 : (qcs > 48 ? 48 : qcs);
    const int fKl = ((fr >> 1) & 1) | ((fr >> 2) << 1);
    const int q4 = (lane & 15) >> 2, p4 = lane & 3, fVl = ((q4 >> 1) & 1) | ((fq & 1) << 1);
    int cidx[2][4];
#pragma unroll
    for (int hb = 0; hb < 2; ++hb)
#pragma unroll
        for (int j = 0; j < 4; ++j) { const int kcol = kcs + 8 * fq + 4 * hb + j; const bool ok = kcol >= qcs && kcol < qcs + 16; cidx[hb][j] = ok ? kcol - qcol + 15 : 31; }
    for (int rq = 0; rq < 4; ++rq) {
        const int nlo = na_newlo(rq), nrows = na_newn(rq);
#pragma unroll
        for (int r_ = 0; r_ < 11; ++r_) if (r_ < nrows) *(LAS u32x4*)(dstp + ((nlo + r_) & 15) * 4096) = vv[r_];
        __syncthreads();
        if (NA_STAGGER > 0 && wid >= 4) __builtin_amdgcn_s_sleep(NA_STAGGER);
        const int r = 8 * rq + wid, rs = na_rowstart(r);
        int so[8];
#pragma unroll
        for (int s = 0; s < 8; ++s) so[s] = ((rs + s) & 15) * 4096;
        const size_t tokq = (size_t)b * SEQ + r * GRID_W + qcol;
        const bf16x8 q0 = q0n, q1 = q1n;
        if (rq < 3) { const bf16* qn = QKV + (tokq + 8 * GRID_W) * NQKV + 64 * h + 8 * fq; q0n = *(const bf16x8*)qn; q1n = *(const bf16x8*)(qn + 32); NA2_LOAD(rq + 1); }
        const LAS unsigned char* kb0 = lds + NA2_K_OFF + (8 * (fr >> 2) + (fr & 3)) * 128 + ((fq ^ fKl) << 4);
        const LAS unsigned char* kb1 = lds + NA2_K_OFF + (8 * (fr >> 2) + (fr & 3)) * 128 + (((4 + fq) ^ fKl) << 4);
        const LAS unsigned char* vb = lds + NA2_V_OFF + (8 * fq + q4) * 128 + p4 * 8;
        const LAS float* trow = tab + (rs - r + 7) * 32;
        f32x4 S[8][2]; bf16x8 pk[8];
#pragma unroll
        for (int s = 0; s < 8; ++s) {
#pragma unroll
            for (int hb = 0; hb < 2; ++hb) { const bf16x8 k0 = *(const LAS bf16x8*)(kb0 + so[s] + hb * 512), k1 = *(const LAS bf16x8*)(kb1 + so[s] + hb * 512);
                f32x4 a = (f32x4){trow[s * 32 + cidx[hb][0]], trow[s * 32 + cidx[hb][1]], trow[s * 32 + cidx[hb][2]], trow[s * 32 + cidx[hb][3]]};
                a = __builtin_amdgcn_mfma_f32_16x16x32_bf16(k0, q0, a, 0, 0, 0); a = __builtin_amdgcn_mfma_f32_16x16x32_bf16(k1, q1, a, 0, 0, 0);
                S[s][hb] = a; }
            if ((s & 3) == 3) asm volatile("" ::: "memory"); }
        const float rl = softmax_pack<8>(S, pk, false, 0.f);
        f32x4 O[4];
#pragma unroll
        for (int db = 0; db < 4; ++db) O[db] = (f32x4){0.f, 0.f, 0.f, 0.f};
#pragma unroll
        for (int s = 0; s < 8; ++s) {
#pragma unroll
            for (int db = 0; db < 4; ++db) { const LAS unsigned char* pp = vb + so[s] + ((db ^ fVl) << 5); O[db] = __builtin_amdgcn_mfma_f32_16x16x32_bf16(tr_pair(pp, pp + 512), pk[s], O[db], 0, 0, 0); }
            if ((s & 3) == 3) asm volatile("" ::: "memory"); }
        bf16* dst = ONA + tokq * 512 + 64 * h + 4 * fq;
#pragma unroll
        for (int db = 0; db < 4; ++db) { u32x2 w; w.x = cvt_pk_bf16(O[db][0] * rl, O[db][1] * rl); w.y = cvt_pk_bf16(O[db][2] * rl, O[db][3] * rl); *(u32x2*)(dst + 16 * db) = w; }
        __syncthreads();
    }
#undef NA2_LOAD
}

#ifndef PG8_SP2
#define PG8_SP2 true
#endif
#ifndef PG8_ALIGN
#define PG8_ALIGN true
#endif
constexpr int N_PHASES = 9 * DEPTH;
struct PhaseBar { XcdBarrier xb; GrpBarrier gb; unsigned want; int mode;
    __device__ __forceinline__ void operator()() const { if (mode == 1) xcd_barrier(xb); else if (mode == 2) grp_barrier(gb, want); }
    template <class Hook> __device__ __forceinline__ void run(const Hook& h) const { if (mode == 2) grp_barrier(gb, want, h); else { h(); if (mode == 1) xcd_barrier(xb); } } };
struct Args { Inputs I; float* out; unsigned char* ws; int ph_lo, ph_hi, bar_region, pad; };

__global__ void __launch_bounds__(NTHREADS, 2) mega_fwd(Args args) {
    extern __shared__ __attribute__((aligned(16))) unsigned char lds_raw[];
    LAS unsigned char* lds = (LAS unsigned char*)lds_raw;
#if PAD_NOPS > 0
    asm volatile(".rept " PAD_STR(PAD_NOPS) "\n s_nop 0\n .endr" ::: "memory");
#endif
    volatile LAS unsigned* MISC = (volatile LAS unsigned*)(lds + MISC_OFF);
    const int tid = threadIdx.x, lane = tid & 63, wave = __builtin_amdgcn_readfirstlane(tid >> 6);
    const int G = gridDim.x, bx = blockIdx.x, vcu = (G % 8 == 0) ? (bx % 8) * (G / 8) + bx / 8 : bx;
    unsigned char* ws0 = args.ws;
    for (int u = tid; u < (LDS_BYTES - RING_BYTES) / 4; u += NTHREADS) ((LAS unsigned*)(lds + RING_BYTES))[u] = 0u;
    __syncthreads();
    const int lo = args.ph_lo, hi = args.ph_hi;
    XcdBarrier bar; bar.bar = (unsigned*)(ws0 + WS_CTL) + 4096 + args.bar_region * XCD_BAR_WORDS; bar.x = 0; bar.st = nullptr;
    if (hi - lo > 1) bar = xcd_barrier_post(bar.bar, MISC + 8);
    const bool use_groups0 = GROUPS && (G == 256) && lo == 0 && hi == N_PHASES;
    const int grp = bx & 7;
    GrpBarrier gbar; { unsigned* gw_ = (unsigned*)(ws0 + WS_CTL) + CW_GRP; gbar.cnt = gw_ + 512 + 64 * grp; gbar.gen = gw_ + 1024 + 64 * grp; gbar.tmo = bar.bar + XB_TMO; gbar.cheap = false;
        if (use_groups0 && tid == 0) atomicOr(gw_ + 64 * grp, 1u << (xb_xcc_id() & 15u)); }

    unsigned t_first = 0, t_prev = 0, t_sel = 0;
    if (PROBE_MASK || PROBE3 || PROBE4 || PROBE2_PHASE >= 0) t_first = t_prev = (unsigned)__builtin_amdgcn_s_memrealtime();
    for (int ph = lo; ph < hi; ++ph) {
        const int l = ph / 9, k = ph % 9;
        typedef const __attribute__((address_space(4))) Args* kargp; kargp ap = (kargp)__builtin_amdgcn_kernarg_segment_ptr(); asm volatile("" : "+s"(ap));
        const __attribute__((address_space(4))) Inputs& I = ap->I; unsigned char* ws = ap->ws; float* out = ap->out;
        int bxl = bx; asm volatile("" : "+s"(bxl));
        const bool use_groups = GROUPS && (G == 256) && ap->ph_lo == 0 && ap->ph_hi == N_PHASES;
        float* SS = (float*)(ws + WS_SS);
        bf16 *XB = (bf16*)(ws + WS_XB), *H, *QKV, *T, *MRG, *GT, *ONA, *OSW; unsigned char* G8;
        if (use_groups) {
            unsigned char* sl = ws + WS_H + (size_t)grp * (21 * MiB); const size_t r0 = (size_t)grp * SEQ;
            G8 = sl + 9 * MiB - r0 * NG; QKV = (bf16*)sl - r0 * NQKV; GT = (bf16*)(sl + 9 * MiB) - r0 * NG; ONA = (bf16*)(sl + 17 * MiB) - r0 * 512; OSW = (bf16*)(sl + 19 * MiB) - r0 * 512;
            T = (bf16*)sl - r0 * DM; MRG = (bf16*)(sl + 4 * MiB) - r0 * DM; H = (bf16*)sl - r0 * FF;
        } else { G8 = ws + WS_G; H = (bf16*)(ws + WS_H); QKV = (bf16*)(ws + WS_QKV); T = (bf16*)(ws + WS_T); MRG = (bf16*)(ws + WS_MRG); GT = (bf16*)(ws + WS_G); ONA = (bf16*)(ws + WS_ONA); OSW = (bf16*)(ws + WS_OSW); }
        unsigned char* WB = ws + WS_W;
        unsigned char* W2Dl = (use_groups && (l & 1)) ? ws + WS_W2D1 : WB + WO_2D;
        unsigned p5c = 0, p5r = 0; if (PROBE5 >= 0 && ph == PROBE5) { p5c = (unsigned)__builtin_amdgcn_s_memtime(); p5r = (unsigned)__builtin_amdgcn_s_memrealtime(); }
        if (PROBE2_PHASE >= 0) { if (tid == 0) MISC[19] = (ph == PROBE2_PHASE) ? 1u : 0u; __syncthreads(); }
        float* ss0 = SS + (size_t)(3 * l + 0) * M; float* ss1 = SS + (size_t)(3 * l + 1) * M; float* ss2 = SS + (size_t)(3 * l + 2) * M; float* ss3 = SS + (size_t)(3 * l + 3) * M;
        if (k == 0 && (CODE_MASK & 1)) {
            int lane_ = tid & 63; asm volatile("" : "+v"(lane_)); const int lane = lane_;
            LAS float* scr = (LAS float*)(lds + wave * 16384);
            const int gw = vcu * NWAVES + wave, NGW = G * NWAVES;
#define PREP_GET(it_) prep_get(I, l, WB, W2Dl, it_)
            if (use_groups && (l > 0 || DYN_PREP > 1)) {
                static_assert(NITEMS % 16 == 0, "chunks of 16 items");
                unsigned* q = (unsigned*)(ws0 + WS_CTL) + CW_GRP + 4096 + 64 * l;
                f32x4 va[8], vb[8];
                if (tid == 0) MISC[30] = xb_add(q, 1u);
                __syncthreads();
                for (;;) {
                    const unsigned ch = MISC[30];
                    __syncthreads();
                    if (ch >= (unsigned)(NITEMS / 16)) break;
                    unsigned nxt_ = 0; if (tid == 0) nxt_ = xb_add(q, 1u);
                    const int it = (int)ch * 16 + wave * 2; const PrepItem da = PREP_GET(it), db = PREP_GET(it + 1);
                    prep_load(da, va, lane); prep_load(db, vb, lane); prep_store(da, va, scr, lane); prep_store(db, vb, scr, lane);
                    if (tid == 0) MISC[30] = nxt_;
                    __syncthreads();
                }
            } else
            {   f32x4 va[8], vb[8];
                int it = gw;
                for (; it + NGW < NITEMS; it += 2 * NGW) { const PrepItem da = PREP_GET(it), db = PREP_GET(it + NGW); prep_load(da, va, lane); prep_load(db, vb, lane); prep_store(da, va, scr, lane); prep_store(db, vb, scr, lane); }
                if (it < NITEMS) { const PrepItem da = PREP_GET(it); prep_load(da, va, lane); prep_store(da, va, scr, lane); }
            }
#undef PREP_GET
            if (l == 0) {
                for (int m = gw; m < M; m += 2 * NGW) { const int m2 = m + NGW;
                    const f32x4* xr = (const f32x4*)(I.x + (size_t)m * DM) + lane; const f32x4* xr2 = (const f32x4*)(I.x + (size_t)m2 * DM) + lane; f32x4 v[4], v2[4];
#pragma unroll
                    for (int j = 0; j < 4; ++j) { v[j] = xr[64 * j]; v2[j] = xr2[64 * j]; }
                    float s = 0.f, s2 = 0.f; u32x2* o8 = (u32x2*)(XB + (size_t)m * DM) + lane; u32x2* o82 = (u32x2*)(XB + (size_t)m2 * DM) + lane;
#pragma unroll
                    for (int j = 0; j < 4; ++j) { s += (v[j][0] * v[j][0] + v[j][1] * v[j][1]) + (v[j][2] * v[j][2] + v[j][3] * v[j][3]); u32x2 w; w.x = pk2(v[j][0], v[j][1]); w.y = pk2(v[j][2], v[j][3]); o8[64 * j] = w;
                        s2 += (v2[j][0] * v2[j][0] + v2[j][1] * v2[j][1]) + (v2[j][2] * v2[j][2] + v2[j][3] * v2[j][3]); u32x2 w2; w2.x = pk2(v2[j][0], v2[j][1]); w2.y = pk2(v2[j][2], v2[j][3]); o82[64 * j] = w2; }
                    s = wave_sum64(s); s2 = wave_sum64(s2); if (lane == 0) { ss0[m] = s; ss0[m2] = s2; } }
            }
            __syncthreads();
        } else if ((k == 1 || k == 7) && (CODE_MASK & 2)) {
            pg8::Gemm g{XB, (const bf16*)(WB + (k == 1 ? WO_1C : WO_2C)), M, 2 * FF, DM, nullptr, nullptr}; pg8::StaticOrder S; S.init(M, 2 * FF, G, bxl, WGM_P1);
            pg8::EpiFfnUp E{H, k == 1 ? ss0 : ss2};
            if (RING4) pg8::gemm_ring4<pg8::EpiFfnUp, pg8::StaticOrder>(lds, g, S, E); else pg8::gemm_phase<pg8::EpiFfnUp, PG8_ALIGN, PG8_SP2>(lds, g, S, E);
        } else if ((k == 2 || k == 8) && (CODE_MASK & 4)) {
            pg8::Gemm g{H, k == 2 ? (const bf16*)(WB + WO_1D) : (const bf16*)W2Dl, M, DM, FF, nullptr, nullptr}; pg8::StaticOrder S; S.init(M, DM, G, bxl);
            const bool fin = (k == 8 && l == DEPTH - 1);
            const PhaseBar pb{bar, gbar, (unsigned)(7 * ((ph - 1) / 9) + (ph - 1) % 9), ph > lo ? (use_groups ? 2 : 1) : 0};
            { pg8::EpiResidT<false> E{nullptr, fin ? out : nullptr, XB, fin ? nullptr : (k == 2 ? ss1 : ss3), 0.5f, k == 2 ? l : -1}; pg8::gemm_phase<pg8::EpiResidT<false>, false, PG8_SP2, pg8::StaticOrder, PhaseBar>(lds, g, S, E, pb); }
        } else if (k == 3 && (CODE_MASK & 8)) {
            LAS float* wtab = (LAS float*)(lds + RING_BYTES + 1024);
            int tl_ = tid; asm volatile("" : "+v"(tl_));
            if (!(ph > lo)) {
            for (int idx = tl_; idx < NG; idx += NTHREADS) wtab[idx] = I.b_gate[l * NG + idx];
            if (tl_ < 256) { const int t = tl_ >> 6, d = tl_ & 63; wtab[2048 + tl_] = (t == 0 ? I.na_q_norm : t == 1 ? I.na_k_norm : t == 2 ? I.sw_q_norm : I.sw_k_norm)[l * 64 + d]; }
            }
            __syncthreads();
            pg8::Gemm g{XB, (const bf16*)(WB + WO_IN), M, INW, DM, nullptr, nullptr}; pg8::StaticOrder S; S.init(M, INW, G, bxl, WGM_P3);
            pg8::EpiWin E{QKV, G8, ss1, wtab};
            if (RING4) pg8::gemm_ring4<pg8::EpiWin, pg8::StaticOrder>(lds, g, S, E); else pg8::gemm_phase<pg8::EpiWin, PG8_ALIGN, PG8_SP2>(lds, g, S, E);
        } else if (k == 4 && (CODE_MASK & 48)) {
            unsigned a_t0 = 0, a_t1 = 0; if (PROBE3) a_t0 = (unsigned)__builtin_amdgcn_s_memrealtime();
            if (CODE_MASK & 16) {
                if (NA_V2) { for (int u4 = 4 * vcu; u4 < 1024; u4 += 4 * G) na_quad(lds, u4 >> 7, (u4 >> 4) & 7, (u4 >> 2) & 3, QKV, I.na_rpb + (size_t)l * 8 * 465, ONA); }
                else for (int u = vcu; u < 256; u += G) na_unit(lds, u >> 5, (u >> 2) & 7, u & 3, QKV, I.na_rpb + (size_t)l * 8 * 465, ONA);
            }
            if (PROBE3) a_t1 = (unsigned)__builtin_amdgcn_s_memrealtime();
            if (CODE_MASK & 32) for (int u = vcu; u < 256; u += G) swa_unit(lds, u >> 5, (u >> 4) & 1, u & 15, QKV, I.t5, I.sw_sink + l * 8, OSW);
            if (PROBE3) { const unsigned a_t2 = (unsigned)__builtin_amdgcn_s_memrealtime(); if (tid == 0) { MISC[24] += a_t1 - a_t0; MISC[25] += a_t2 - a_t1; } }
        } else if (k == 5 && (CODE_MASK & 64)) {
            pg8::DualOrder S; S.S.init(M, DM, G, bxl);
            pg8::Gemm g{ONA, (const bf16*)(WB + WO_PA), M, DM, 512, OSW, (const bf16*)(WB + WO_PB)}; pg8::EpiBranch E{MRG, G8};
            pg8::gemm_phase<pg8::EpiBranch, false, PG8_SP2, pg8::DualOrder>(lds, g, S, E);
        } else if (k == 6 && (CODE_MASK & 128)) {
            pg8::Gemm g{MRG, (const bf16*)(WB + WO_OUT), M, DM, DM, nullptr, nullptr}; pg8::StaticOrder S; S.init(M, DM, G, bxl);
            pg8::EpiResidT<false> E{nullptr, nullptr, XB, ss2, 1.0f, -1};
            const PhaseBar pb{bar, gbar, (unsigned)(7 * ((ph - 1) / 9) + (ph - 1) % 9), ph > lo ? (use_groups ? 2 : 1) : 0};
            pg8::gemm_phase<pg8::EpiResidT<false>, false, PG8_SP2, pg8::StaticOrder, PhaseBar>(lds, g, S, E, pb);
        }
        if (PROBE5 >= 0 && ph == PROBE5) { const unsigned c1 = (unsigned)__builtin_amdgcn_s_memtime(), r1 = (unsigned)__builtin_amdgcn_s_memrealtime(); if (tid == 0) { MISC[26] = c1 - p5c; MISC[27] = r1 - p5r; } }
        unsigned b_t0 = 0; if (PROBE4) b_t0 = (unsigned)__builtin_amdgcn_s_memrealtime();
        const int kn_ = (ph + 1) % 9; const bool next_resid = (ph + 1 < hi) && (kn_ == 2 || kn_ == 6 || kn_ == 8);
        if ((ph + 1 < hi || PROBE_MASK) && !next_resid) {
            const bool global = !use_groups || (ph % 9 == 0) || ((ph + 1) % 9 == 0) || ph + 1 == hi;
            if (use_groups && (ph + 1) % 9 == 0 && ph + 1 < hi && !PROBE_MASK) {
                __syncthreads();
                if (wave == 0) { const int l8 = (int)__builtin_amdgcn_mbcnt_hi(~0u, __builtin_amdgcn_mbcnt_lo(~0u, 0u));
                    if (l8 < 8) { unsigned* gw_ = (unsigned*)(ws0 + WS_CTL) + CW_GRP; const unsigned need = 32u * (unsigned)(7 * (ph / 9) + 7);
                        XB_SPIN(xb_ld(gw_ + 512 + 64 * l8) < need, bar.bar); } }
                __syncthreads();
            } else
            if (global) { xcd_barrier(bar);
                if (use_groups && ph == 0) { const unsigned mk = xb_ld((unsigned*)(ws0 + WS_CTL) + CW_GRP + 64 * grp); gbar.cheap = !FORCE_FULL_RELEASE && __builtin_popcount(mk) == 1; }
                if (use_groups && STAGGER_TICKS > 0 && (ph % 9) == 0 && ph + 1 < hi) { const unsigned long long t0_ = __builtin_amdgcn_s_memrealtime(); const unsigned long long dl_ = (unsigned long long)(STAGGER_TICKS) * (unsigned)grp;
                    while (__builtin_amdgcn_s_memrealtime() - t0_ < dl_) __builtin_amdgcn_s_sleep(4); } }
            else grp_barrier(gbar, (unsigned)(7 * (ph / 9) + ph % 9));
        }
        if (PROBE4) t_sel += (unsigned)__builtin_amdgcn_s_memrealtime() - b_t0;
        if (PROBE_MASK) { const unsigned t = (unsigned)__builtin_amdgcn_s_memrealtime(); if ((PROBE_MASK >> ph) & 1) t_sel += t - t_prev; t_prev = t; }
    }
    if (PROBE_MASK && bx == 0 && tid == 0) args.out[0] += 100.f * (float)t_sel / (float)(t_prev - t_first);
    if (PROBE5 >= 0) { xcd_barrier(bar); if (bx == 0 && tid == 0) { const float rt_ = (float)MISC[26] / (float)MISC[27]; args.out[0] += rt_ < 15.f ? 20.f : rt_ < 17.f ? 40.f : rt_ < 19.f ? 60.f : rt_ < 21.f ? 80.f : 100.f; } }
    if (PROBE4) { const unsigned t_end = (unsigned)__builtin_amdgcn_s_memrealtime(); xcd_barrier(bar); if (bx == PROBE4 - 1 && tid == 0) args.out[0] += 100.f * (float)t_sel / (float)(t_end - t_first); }
    if (PROBE3) { const unsigned t_end = (unsigned)__builtin_amdgcn_s_memrealtime(); xcd_barrier(bar); if (bx == 0 && tid == 0) args.out[0] += 100.f * (float)MISC[23 + PROBE3] / (float)(t_end - t_first); }
    if (PROBE2_PHASE >= 0) { const unsigned t_end = (unsigned)__builtin_amdgcn_s_memrealtime(); xcd_barrier(bar); if (bx == 0 && tid == 0) args.out[0] += PROBE2_SEL == 9 ? ({ const float c_ = (float)MISC[20] / (float)MISC[22]; c_ < 2300.f ? 20.f : c_ < 2500.f ? 30.f : c_ < 2700.f ? 40.f : c_ < 2900.f ? 50.f : c_ < 3100.f ? 60.f : c_ < 3300.f ? 70.f : 80.f; }) : 1000.f * (float)MISC[(PROBE2_SEL >= 5 ? 21 : 20 + (PROBE2_SEL & 3))] / (float)(t_end - t_first); }
}
#ifndef FAST_MASK
#define FAST_MASK 0x3ffffu
#endif
#ifndef MERGE_LAUNCHES
#define MERGE_LAUNCHES 1
#endif
static void launch_slow_phase(const Inputs& I, int ph, unsigned char* ws, float* out, hipStream_t stream) {
    const int l = ph / 9, k = ph % 9;
    float* SS = (float*)(ws + WS_SS);
    bf16 *XB = (bf16*)(ws + WS_XB), *H = (bf16*)(ws + WS_H), *QKV = (bf16*)(ws + WS_QKV), *T = (bf16*)(ws + WS_T), *MRG = (bf16*)(ws + WS_MRG), *G = (bf16*)(ws + WS_G),
         *ONA = (bf16*)(ws + WS_ONA), *OSW = (bf16*)(ws + WS_OSW);
    float* ss0 = SS + (size_t)(3 * l + 0) * M; float* ss1 = SS + (size_t)(3 * l + 1) * M; float* ss2 = SS + (size_t)(3 * l + 2) * M; float* ss3 = SS + (size_t)(3 * l + 3) * M;
    switch (k) {
    case 0: if (l == 0) hipLaunchKernelGGL(slow::prep_x, dim3(M), dim3(256), 0, stream, I.x, XB, SS); break;
    case 1: { slow::OpFfnUp op{DM, 0, XB, I.ffn1_wg + (size_t)l * DM * FF, I.ffn1_wu + (size_t)l * DM * FF, I.ffn1_norm + l * DM, ss0, H};
              hipLaunchKernelGGL(slow::gemm<slow::OpFfnUp>, dim3(FF / 64, M / 64), dim3(256), 0, stream, op); } break;
    case 2: { slow::OpResid op{FF, 0.5f, H, I.ffn1_wd + (size_t)l * FF * DM, l == 0 ? I.x : out, out, XB, ss1};
              hipLaunchKernelGGL(slow::gemm<slow::OpResid>, dim3(DM / 64, M / 64), dim3(256), 0, stream, op); } break;
    case 3: { slow::OpWin op{DM, 0, XB, I.w_in + (size_t)l * DM * INW, I.mix_norm + l * DM, ss1, I.b_gate + l * NG, I.na_q_norm + l * 64, I.na_k_norm + l * 64, I.sw_q_norm + l * 64, I.sw_k_norm + l * 64, QKV, G};
              hipLaunchKernelGGL(slow::gemm<slow::OpWin>, dim3(INW / 64, M / 64), dim3(256), 0, stream, op); } break;
    case 4: hipLaunchKernelGGL(slow::attn_na, dim3(M * 8 / 4), dim3(256), 0, stream, QKV, I.na_rpb + (size_t)l * 8 * 15 * 31, ONA);
            hipLaunchKernelGGL(slow::attn_sw, dim3(M * 8 / 4), dim3(256), 0, stream, QKV, I.t5, I.sw_sink + l * 8, OSW); break;
    case 5: { slow::OpBranch op{512, 0, ONA, OSW, G, I.w_br_na + (size_t)l * 512 * DM, I.w_br_sw + (size_t)l * 512 * DM, T, MRG};
              hipLaunchKernelGGL(slow::gemm<slow::OpBranch>, dim3(DM / 64, M / 64), dim3(256), 0, stream, op); } break;
    case 6: { slow::OpResid op{DM, 1.0f, MRG, I.w_out + (size_t)l * DM * DM, out, out, XB, ss2};
              hipLaunchKernelGGL(slow::gemm<slow::OpResid>, dim3(DM / 64, M / 64), dim3(256), 0, stream, op); } break;
    case 7: { slow::OpFfnUp op{DM, 0, XB, I.ffn2_wg + (size_t)l * DM * FF, I.ffn2_wu + (size_t)l * DM * FF, I.ffn2_norm + l * DM, ss2, H};
              hipLaunchKernelGGL(slow::gemm<slow::OpFfnUp>, dim3(FF / 64, M / 64), dim3(256), 0, stream, op); } break;
    default: { const bool last = (l == DEPTH - 1);
              slow::OpResid op{FF, 0.5f, H, I.ffn2_wd + (size_t)l * FF * DM, out, out, last ? nullptr : XB, last ? nullptr : ss3};
              hipLaunchKernelGGL(slow::gemm<slow::OpResid>, dim3(DM / 64, M / 64), dim3(256), 0, stream, op); } break;
    }
}

extern "C" void kernel_launch(void* const* d_in, const int* in_sizes, int n_in, void* d_out, int out_size, void* d_ws, size_t ws_size, hipStream_t stream) {
    static int grid = 0;
    if (grid == 0) {
        if (n_in != 22 || in_sizes[0] != M * DM || out_size != M * DM || ws_size < WS_END) { fprintf(stderr, "kernel_launch: unexpected shapes (n_in %d, in0 %d, out %d, ws %zu)\n", n_in, n_in > 0 ? in_sizes[0] : -1, out_size, ws_size); grid = -1; return; }
        int dev = 0, cus = 0, per_cu = 0;
        if (hipGetDevice(&dev) != hipSuccess || hipDeviceGetAttribute(&cus, hipDeviceAttributeMultiprocessorCount, dev) != hipSuccess) { grid = -1; return; }
        if (hipFuncSetAttribute((const void*)mega_fwd, hipFuncAttributeMaxDynamicSharedMemorySize, LDS_BYTES) != hipSuccess) { fprintf(stderr, "kernel_launch: hipFuncSetAttribute failed\n"); grid = -1; return; }
        if (hipOccupancyMaxActiveBlocksPerMultiprocessor(&per_cu, (const void*)mega_fwd, NTHREADS, LDS_BYTES) != hipSuccess || per_cu < 1) fprintf(stderr, "kernel_launch: occupancy query says %d blocks/CU\n", per_cu);
        (void)hipGetLastError();
        grid = cus;
    }
    if (grid < 0) return;
    Inputs I;
    { const float** p = (const float**)&I; for (int i = 0; i < 22; ++i) p[i] = (const float*)d_in[i]; }
    unsigned char* ws = (unsigned char*)d_ws; float* out = (float*)d_out;
    (void)hipMemsetAsync(ws + WS_CTL, 0, CTL_ZERO_BYTES, stream);
    int region = 0;
#ifndef HOST_PH_END
#define HOST_PH_END N_PHASES
#endif
    for (int ph = 0; ph < HOST_PH_END;) {
        if (!((FAST_MASK >> ph) & 1u)) { launch_slow_phase(I, ph, ws, out, stream); ++ph; continue; }
        int hi = ph + 1;
        if (MERGE_LAUNCHES) while (hi < HOST_PH_END && ((FAST_MASK >> hi) & 1u)) ++hi;
        Args a{};
        a.I = I; a.out = out; a.ws = ws; a.ph_lo = ph; a.ph_hi = hi; a.bar_region = region++; a.pad = 0;
        hipLaunchKernelGGL(mega_fwd, dim3(grid), dim3(NTHREADS), LDS_BYTES, stream, a);
        ph = hi;
    }
}
```
